# Optimizing an MI355X kernel written in HIP

```python
import math
import jax, jax.numpy as jnp
from jax import lax
import numpy as np

D_MODEL = 1024
BATCH = 16
SEQ = 4096
DEPTH = 2

A_HEADS = 8
A_KV_HEADS = 2
A_HEAD_DIM = 64
A_REP = A_HEADS // A_KV_HEADS
A_WIDTH = A_HEADS * A_HEAD_DIM
WINDOW = 128
BLOCK = 128
REL_BUCKETS = 32
REL_MAX_DIST = 128
B_HEADS = 8
Q_LORA = 256
KV_LORA = 128
NOPE_DIM = 64
ROPE_DIM = 32
B_QK_DIM = NOPE_DIM + ROPE_DIM
B_V_DIM = 64
B_WIDTH = B_HEADS * B_V_DIM
ROPE_THETA = 10000.0
IN_SIZES = (A_HEADS * A_HEAD_DIM, A_KV_HEADS * A_HEAD_DIM, A_KV_HEADS * A_HEAD_DIM,
            Q_LORA, KV_LORA, ROPE_DIM, 2 * D_MODEL)
IN_COLS = sum(IN_SIZES)
N_GROUPS = 4
EXPERTS_PER_GROUP = 8
N_EXPERTS = N_GROUPS * EXPERTS_PER_GROUP
TOP_K = 2
D_EXPERT = 256
MOE_BLOCK = 128
EPS = 1e-6

kernel_name = "hybrid_swa_mla_hier_moe"


def rmsnorm(x, g):
    xf = x.astype(jnp.float32)
    y = xf * lax.rsqrt(jnp.mean(xf * xf, axis=-1, keepdims=True) + EPS)
    return (y * g.astype(jnp.float32)).astype(x.dtype)


def t5_bucket(dist):
    max_exact = REL_BUCKETS // 2
    d = jnp.maximum(dist, 0)
    ratio = jnp.maximum(d, 1).astype(jnp.float32) / max_exact
    large = max_exact + (jnp.log(ratio) / math.log(REL_MAX_DIST / max_exact)
                         * (REL_BUCKETS - max_exact)).astype(jnp.int32)
    large = jnp.minimum(large, REL_BUCKETS - 1)
    return jnp.where(d < max_exact, d, large)


def apply_rope(x, positions):
    half = ROPE_DIM // 2
    inv_freq = ROPE_THETA ** (-jnp.arange(half, dtype=jnp.float32) / half)
    ang = positions.astype(jnp.float32)[:, None] * inv_freq[None, :]
    cos = jnp.cos(ang)[None, :, None, :]
    sin = jnp.sin(ang)[None, :, None, :]
    xf = x.astype(jnp.float32)
    x1, x2 = xf[..., :half], xf[..., half:]
    out = jnp.concatenate([x1 * cos - x2 * sin, x1 * sin + x2 * cos], axis=-1)
    return out.astype(x.dtype)


def sliding_window_attention(q, k, v, sinks, rel_table):
    Bsz, S = q.shape[0], q.shape[1]
    nb = S // BLOCK
    scale = A_HEAD_DIM ** -0.5
    qb = q.reshape(Bsz, nb, BLOCK, A_KV_HEADS, A_REP, A_HEAD_DIM)

    def band(t):
        tb = t.reshape(Bsz, nb, BLOCK, A_KV_HEADS, A_HEAD_DIM)
        prev = jnp.concatenate([jnp.zeros_like(tb[:, :1]), tb[:, :-1]], axis=1)
        return jnp.concatenate([prev, tb], axis=2)

    kb, vb = band(k), band(v)
    s = jnp.einsum('bnqgrd,bnkgd->bngrqk', qb, kb).astype(jnp.float32) * scale
    qi = jnp.arange(BLOCK)[:, None]
    kj = jnp.arange(2 * BLOCK)[None, :]
    dist = qi + BLOCK - kj
    bias = rel_table[t5_bucket(dist)]
    bias = bias.astype(jnp.float32).transpose(2, 0, 1).reshape(A_KV_HEADS, A_REP, BLOCK, 2 * BLOCK)
    kpos = jnp.arange(nb)[:, None, None] * BLOCK - BLOCK + kj[None]
    mask = (dist >= 0) & (dist < WINDOW) & (kpos >= 0)
    s = jnp.where(mask[None, :, None, None], s + bias, -jnp.inf)
    sink = sinks.astype(jnp.float32).reshape(A_KV_HEADS, A_REP)[None, None, :, :, None, None]
    m = jnp.maximum(jnp.max(s, axis=-1, keepdims=True), sink)
    p = jnp.exp(s - m)
    denom = jnp.sum(p, axis=-1, keepdims=True) + jnp.exp(sink - m)
    p = (p / denom).astype(v.dtype)
    o = jnp.einsum('bngrqk,bnkgd->bnqgrd', p, vb)
    return o.reshape(Bsz, S, A_WIDTH)


def causal_block_attention(q, k, v):
    Bsz, S, H, dq = q.shape
    nb = S // BLOCK
    scale = dq ** -0.5
    qblocks = q.reshape(Bsz, nb, BLOCK, H, dq).transpose(1, 0, 2, 3, 4)
    kpos = jnp.arange(S)

    def one_block(args):
        qb, n = args
        s = jnp.einsum('bqhd,bkhd->bhqk', qb, k).astype(jnp.float32) * scale
        qpos = n * BLOCK + jnp.arange(BLOCK)
        s = jnp.where(kpos[None, :] <= qpos[:, None], s, -jnp.inf)
        p = jax.nn.softmax(s, axis=-1).astype(v.dtype)
        return jnp.einsum('bhqk,bkhd->bqhd', p, v)

    o = lax.map(one_block, (qblocks, jnp.arange(nb)))
    return o.transpose(1, 0, 2, 3, 4).reshape(Bsz, S, H * v.shape[-1])


def mixer_block(x, attn_norm, w_in, b_gate, a_q_norm, a_k_norm, a_sinks, rel_table, w_oa,
                q_a_norm, w_qb, kv_a_norm, w_kvb, b_q_norm, b_k_norm, w_ob, w_o, positions):
    Bsz, S, _ = x.shape
    h = rmsnorm(x, attn_norm)
    proj = h @ w_in
    cuts = [int(c) for c in np.cumsum(IN_SIZES)[:-1]]
    qa, ka, va, cq, ckv, kpe, glog = jnp.split(proj, cuts, axis=-1)

    qa = rmsnorm(qa.reshape(Bsz, S, A_HEADS, A_HEAD_DIM), a_q_norm)
    ka = rmsnorm(ka.reshape(Bsz, S, A_KV_HEADS, A_HEAD_DIM), a_k_norm)
    va = va.reshape(Bsz, S, A_KV_HEADS, A_HEAD_DIM)
    ya = sliding_window_attention(qa, ka, va, a_sinks, rel_table) @ w_oa

    qb = (rmsnorm(cq, q_a_norm) @ w_qb).reshape(Bsz, S, B_HEADS, B_QK_DIM)
    kv = (rmsnorm(ckv, kv_a_norm) @ w_kvb).reshape(Bsz, S, B_HEADS, NOPE_DIM + B_V_DIM)
    k_nope, vb = kv[..., :NOPE_DIM], kv[..., NOPE_DIM:]
    k_pe = jnp.broadcast_to(kpe[:, :, None, :], (Bsz, S, B_HEADS, ROPE_DIM))
    kb = jnp.concatenate([k_nope, k_pe], axis=-1)
    qb = rmsnorm(qb, b_q_norm)
    kb = rmsnorm(kb, b_k_norm)
    qb = jnp.concatenate([qb[..., :NOPE_DIM], apply_rope(qb[..., NOPE_DIM:], positions)], axis=-1)
    kb = jnp.concatenate([kb[..., :NOPE_DIM], apply_rope(kb[..., NOPE_DIM:], positions)], axis=-1)
    yb = causal_block_attention(qb, kb, vb) @ w_ob

    gates = jax.nn.sigmoid((glog + b_gate).astype(jnp.float32)).astype(x.dtype)
    ga, gb = gates[..., :D_MODEL], gates[..., D_MODEL:]
    return (ga * ya + gb * yb) @ w_o


def hier_moe(h, w_rg, b_rg, w_re, b_re, w_gate, w_up, w_down):
    Bsz, S, D = h.shape
    T = Bsz * S
    A = T * TOP_K
    xf = h.reshape(T, D)
    g_prob = jax.nn.softmax((xf @ w_rg + b_rg).astype(jnp.float32), axis=-1)
    g_p, g_idx = lax.top_k(g_prob, 1)
    e_logits = (xf @ w_re + b_re).astype(jnp.float32).reshape(T, N_GROUPS, EXPERTS_PER_GROUP)
    e_in_group = e_logits[jnp.arange(T), g_idx[:, 0]]
    e_top, e_loc = lax.top_k(e_in_group, TOP_K)
    weights = g_p * jax.nn.softmax(e_top, axis=-1)
    expert = g_idx * EXPERTS_PER_GROUP + e_loc

    flat_e = expert.reshape(A)
    flat_w = weights.reshape(A)
    flat_t = jnp.repeat(jnp.arange(T, dtype=jnp.int32), TOP_K)
    order = jnp.argsort(flat_e)
    se, st, sw = flat_e[order], flat_t[order], flat_w[order]
    counts = jnp.zeros((N_EXPERTS,), jnp.int32).at[flat_e].add(1)
    starts = jnp.cumsum(counts) - counts
    padded = ((counts + MOE_BLOCK - 1) // MOE_BLOCK) * MOE_BLOCK
    pends = jnp.cumsum(padded)
    pstarts = pends - padded
    dest = pstarts[se] + (jnp.arange(A, dtype=jnp.int32) - starts[se])
    n_rows = A + N_EXPERTS * MOE_BLOCK
    n_blocks = n_rows // MOE_BLOCK
    row_tok = jnp.zeros((n_rows,), jnp.int32).at[dest].set(st)
    row_w = jnp.zeros((n_rows,), jnp.float32).at[dest].set(sw)
    blk_exp = jnp.minimum(jnp.searchsorted(pends, jnp.arange(n_blocks) * MOE_BLOCK, side='right'),
                          N_EXPERTS - 1)
    xr = xf[row_tok].reshape(n_blocks, MOE_BLOCK, D)

    def expert_block(args):
        xb, e = args
        return (jax.nn.silu(xb @ w_gate[e]) * (xb @ w_up[e])) @ w_down[e]

    yr = lax.map(expert_block, (xr, blk_exp)).reshape(n_rows, D)
    y = jax.ops.segment_sum(yr * row_w[:, None].astype(yr.dtype), row_tok, num_segments=T)
    return y.reshape(Bsz, S, D)


def setup_inputs(seed: int = 0) -> dict:
    key = jax.random.key(seed)
    ks = jax.random.split(key, 32)

    def nrm(k, shape, scale):
        return jax.random.normal(k, shape, jnp.float32) * scale

    def gain(k, shape):
        return 1.0 + 0.02 * jax.random.normal(k, shape, jnp.float32)

    L = DEPTH
    return {
        "x": nrm(ks[0], (BATCH, SEQ, D_MODEL), 1.0),
        "attn_norm": gain(ks[1], (L, D_MODEL)),
        "w_in": nrm(ks[2], (L, D_MODEL, IN_COLS), D_MODEL ** -0.5),
        "b_gate": nrm(ks[3], (L, 2 * D_MODEL), 0.02),
        "a_q_norm": gain(ks[4], (L, A_HEAD_DIM)),
        "a_k_norm": gain(ks[5], (L, A_HEAD_DIM)),
        "a_sinks": nrm(ks[6], (L, A_HEADS), 0.5),
        "rel_bias": nrm(ks[7], (REL_BUCKETS, A_HEADS), 0.5),
        "w_oa": nrm(ks[8], (L, A_WIDTH, D_MODEL), A_WIDTH ** -0.5),
        "q_a_norm": gain(ks[9], (L, Q_LORA)),
        "w_qb": nrm(ks[10], (L, Q_LORA, B_HEADS * B_QK_DIM), Q_LORA ** -0.5),
        "kv_a_norm": gain(ks[11], (L, KV_LORA)),
        "w_kvb": nrm(ks[12], (L, KV_LORA, B_HEADS * (NOPE_DIM + B_V_DIM)), KV_LORA ** -0.5),
        "b_q_norm": gain(ks[13], (L, B_QK_DIM)),
        "b_k_norm": gain(ks[14], (L, B_QK_DIM)),
        "w_ob": nrm(ks[15], (L, B_WIDTH, D_MODEL), B_WIDTH ** -0.5),
        "w_o": nrm(ks[16], (L, D_MODEL, D_MODEL), D_MODEL ** -0.5),
        "ffn_norm": gain(ks[17], (L, D_MODEL)),
        "w_router_group": nrm(ks[18], (L, D_MODEL, N_GROUPS), D_MODEL ** -0.5),
        "b_router_group": nrm(ks[19], (L, N_GROUPS), 0.01),
        "w_router_expert": nrm(ks[20], (L, D_MODEL, N_EXPERTS), D_MODEL ** -0.5),
        "b_router_expert": nrm(ks[21], (L, N_EXPERTS), 0.01),
        "w_exp_gate": nrm(ks[22], (L, N_EXPERTS, D_MODEL, D_EXPERT), D_MODEL ** -0.5),
        "w_exp_up": nrm(ks[23], (L, N_EXPERTS, D_MODEL, D_EXPERT), D_MODEL ** -0.5),
        "w_exp_down": nrm(ks[24], (L, N_EXPERTS, D_EXPERT, D_MODEL), D_EXPERT ** -0.5),
    }


def reference(x, attn_norm, w_in, b_gate, a_q_norm, a_k_norm, a_sinks, rel_bias, w_oa,
              q_a_norm, w_qb, kv_a_norm, w_kvb, b_q_norm, b_k_norm, w_ob, w_o,
              ffn_norm, w_router_group, b_router_group, w_router_expert, b_router_expert,
              w_exp_gate, w_exp_up, w_exp_down):
    positions = jnp.arange(x.shape[1], dtype=jnp.int32)
    for l in range(DEPTH):
        x = x + mixer_block(x, attn_norm[l], w_in[l], b_gate[l], a_q_norm[l], a_k_norm[l],
                            a_sinks[l], rel_bias, w_oa[l], q_a_norm[l], w_qb[l], kv_a_norm[l],
                            w_kvb[l], b_q_norm[l], b_k_norm[l], w_ob[l], w_o[l], positions)
        x = x + hier_moe(rmsnorm(x, ffn_norm[l]), w_router_group[l], b_router_group[l],
                         w_router_expert[l], b_router_expert[l],
                         w_exp_gate[l], w_exp_up[l], w_exp_down[l])
    return x
```

```cpp
#include <hip/hip_runtime.h>
#include <cstdio>
#include <cstdint>

#ifndef ONE_LAUNCH
#define ONE_LAUNCH 1
#endif

#define GAS __attribute__((address_space(1)))
#define LAS __attribute__((address_space(3)))
typedef unsigned short bf16_t;
typedef short bf16x8 __attribute__((ext_vector_type(8)));
typedef short s16x4 __attribute__((ext_vector_type(4)));
typedef float f32x4 __attribute__((ext_vector_type(4)));
typedef float f32x2 __attribute__((ext_vector_type(2)));
typedef float f32x16 __attribute__((ext_vector_type(16)));
typedef unsigned u32x4 __attribute__((ext_vector_type(4)));
typedef unsigned u32x2 __attribute__((ext_vector_type(2)));

constexpr int T = 65536, DM = 1024, SEQ = 4096, NB = 16;
constexpr int NPROJ1 = 1280;
constexpr int C_QA = 0, C_KA = 512, C_VA = 640, C_CQ = 768, C_CKV = 1024, C_KPE = 1152, C_GATE = 1184, IN_COLS = 3232;
constexpr int NEXP = 32, DEXP = 256;
constexpr int MOE_CAP = 65536;
constexpr float W8S = 32.0f, W8I = 1.0f / 32.0f;
constexpr int A_PAD = 2 * T + NEXP * 256;
constexpr float EPS = 1e-6f;
constexpr float LOG2E = 1.4426950408889634f;
constexpr float C2A = 0.125f * LOG2E;
constexpr float C2B = 0.10206207261596575f * LOG2E;

constexpr size_t MiB = 1u << 20;
constexpr size_t WS_CTL = 0, CTL_ZERO_BYTES = 2 * MiB;
constexpr size_t WS_SSQX = 2 * MiB;
constexpr size_t WS_RSMID = WS_SSQX + 256 * 1024;
constexpr size_t WS_ROPE = WS_RSMID + 256 * 1024;
constexpr size_t WS_ASE = 3 * MiB, WS_ASP = WS_ASE + 512 * 1024, WS_ASW = WS_ASP + 512 * 1024;
constexpr size_t WS_MY = WS_ASW + 512 * 1024, WS_MW = WS_MY + 768 * 1024, WS_MRS = WS_MW + 768 * 1024;
constexpr size_t WS_LOGITS = 8 * MiB;
constexpr size_t WS_WIN1 = 24 * MiB;
constexpr size_t WS_WG = 29 * MiB;
constexpr size_t WS_WQB = 37 * MiB;
constexpr size_t WS_WKVB = WS_WQB + 768 * 1024;
constexpr size_t WS_WOA = WS_WKVB + 768 * 1024;
constexpr size_t WS_WOB = WS_WOA + 2 * MiB;
constexpr size_t WS_WO = WS_WOB + 2 * MiB;
constexpr size_t WS_WR = WS_WO + 4 * MiB;
constexpr size_t WS_WGU = 48 * MiB;
constexpr size_t WS_WD = 112 * MiB;
constexpr size_t WS_XB = 144 * MiB;
constexpr size_t WS_PROJ1 = 272 * MiB;
constexpr size_t WS_QB = 432 * MiB;
constexpr size_t WS_KVB = 528 * MiB;
constexpr size_t WS_KB = 656 * MiB;
constexpr size_t WS_O = 752 * MiB;
constexpr size_t WS_GATES = 432 * MiB;
constexpr size_t WS_M = 272 * MiB;
constexpr size_t WS_XR = 272 * MiB;
constexpr size_t WS_ACT = 544 * MiB;
constexpr size_t WS_YBUF = 612 * MiB;
constexpr size_t WS_SSQP = 880 * MiB;
constexpr size_t WS_XB8 = 884 * MiB;
constexpr size_t WS_END = 948 * MiB;
static_assert(WS_MRS + 768 * 1024 <= WS_LOGITS && WS_LOGITS + (size_t)T * 64 * 4 <= WS_WIN1, "ws map");
static_assert(WS_WR + 1 * MiB <= WS_WGU && WS_WD + 32 * MiB <= WS_XB, "ws map");
static_assert(WS_XR + (size_t)A_PAD * 1024 * 2 <= WS_ACT && WS_ACT + (size_t)A_PAD * 256 * 2 <= WS_YBUF && WS_YBUF + (size_t)2 * T * 1024 * 2 <= WS_END, "ws map");

constexpr int CW_BAR = 4096;
constexpr int CW_WMAX = 20480;
constexpr int CW_CNT = 16384;

constexpr int RING_BYTES = 131072;
constexpr int MISC_OFF = RING_BYTES;
constexpr int LDS_BYTES = 147456;

#define LDS_WAIT() asm volatile("s_waitcnt lgkmcnt(0)" ::: "memory")
#define VM_WAIT() asm volatile("s_waitcnt vmcnt(0)" ::: "memory")

typedef float f32x2_cv __attribute__((ext_vector_type(2))); typedef __bf16 bf16x2_cv __attribute__((ext_vector_type(2)));
__device__ __forceinline__ unsigned cvt_pk_bf16(float lo, float hi) { const f32x2_cv v = {lo, hi}; const bf16x2_cv b = __builtin_convertvector(v, bf16x2_cv); return __builtin_bit_cast(unsigned, b); }
__device__ __forceinline__ unsigned pk4_i8(float a, float b, float c, float d, float s) {
    int q0 = (int)__builtin_rintf(a * s), q1 = (int)__builtin_rintf(b * s), q2 = (int)__builtin_rintf(c * s), q3 = (int)__builtin_rintf(d * s);
    q0 = q0 < -127 ? -127 : (q0 > 127 ? 127 : q0); q1 = q1 < -127 ? -127 : (q1 > 127 ? 127 : q1); q2 = q2 < -127 ? -127 : (q2 > 127 ? 127 : q2); q3 = q3 < -127 ? -127 : (q3 > 127 ? 127 : q3);
    return (unsigned)(q0 & 255) | ((unsigned)(q1 & 255) << 8) | ((unsigned)(q2 & 255) << 16) | ((unsigned)q3 << 24); }
__device__ __forceinline__ float wave_max(float v) {
#pragma unroll
    for (int o = 1; o < 64; o <<= 1) v = __builtin_fmaxf(v, __shfl_xor(v, o));
    return v;
}
__device__ __forceinline__ unsigned pk4_fp8(float a, float b, float c, float d) { int p = __builtin_amdgcn_cvt_pk_fp8_f32(a, b, 0, false); p = __builtin_amdgcn_cvt_pk_fp8_f32(c, d, p, true); return (unsigned)p; }
__device__ __forceinline__ float bflo(unsigned u) { return __uint_as_float(u << 16); }
__device__ __forceinline__ float bfhi(unsigned u) { return __uint_as_float(u & 0xffff0000u); }
__device__ __forceinline__ float bf1(bf16_t h) { return __uint_as_float((unsigned)h << 16); }
__device__ __forceinline__ float wave_sum(float v) {
#pragma unroll
    for (int o = 1; o < 64; o <<= 1) v += __shfl_xor(v, o);
    return v;
}
__device__ __forceinline__ float fsigmoid(float v) { return __builtin_amdgcn_rcpf(1.0f + __builtin_amdgcn_exp2f(-v * LOG2E)); }

namespace pg8 {
constexpr int BM = 256, BK = 64, HALF = 128, HTB = HALF * BK * 2, STAGE_BYTES = 8 * HTB, NXCD = 8, WGM = 8;
__host__ __device__ __forceinline__ int lds_byte(int r, int c) { const int st = (r >> 4) * 2 + (c >> 5), rr = r & 15, cc = c & 31, ob = rr * 64 + cc * 2; return st * 1024 + (ob ^ (((ob >> 9) & 1) << 5)); }
__host__ __device__ __forceinline__ void stage_rc(int b, int& R, int& C) { const int st = b / 1024, sb = b % 1024, swz = sb ^ (((sb >> 9) & 1) << 5); R = (st >> 1) * 16 + swz / 64; C = (st & 1) * 32 + (swz % 64) / 2; }
__host__ __device__ __forceinline__ int perm32(int rho) { const int n = rho >> 4, i = rho & 15; return 8 * (i >> 2) + 4 * n + (i & 3); }

struct Unit { int pm, pn; };
struct Gemm { const GAS bf16_t* A; const GAS bf16_t* Bt; int lda, ldb, K; };

struct StaticOrder {
    static constexpr bool GATHER = false;
    int nM, nN, nwg, G, c;
    __device__ void init(int M, int N, int G_, int c_) { nM = M / BM; nN = N / BM; nwg = nM * nN; G = G_; c = c_; }
    __device__ __forceinline__ bool next(int i, Unit& u) const {
        const long L = (long)i * G + c; if (L >= nwg) return false;
        int wgid = (int)L; { const int q = nwg / NXCD, r = nwg % NXCD, xcd = wgid % NXCD, off = wgid / NXCD; wgid = (xcd < r ? xcd * (q + 1) : r * (q + 1) + (xcd - r) * q) + off; }
        const int nig = WGM * nN, gid = wgid / nig, fm = gid * WGM, gsz = (nM - fm) < WGM ? (nM - fm) : WGM;
        u.pm = fm + ((wgid % nig) % gsz); u.pn = (wgid % nig) / gsz; return true;
    }
    __device__ __forceinline__ size_t aoff(const Gemm& g, const Unit& u) const { return (size_t)u.pm * BM * g.lda * 2; }
    __device__ __forceinline__ size_t boff(const Gemm& g, const Unit& u) const { return (size_t)u.pn * BM * g.ldb * 2; }
};
template <bool GA> struct MoeOrderT {
    static constexpr bool GATHER = GA;
    int nunits, npn, G, c; const LAS int* pend; size_t estride; const GAS int* tab; const LAS int* pcnt;
    __device__ bool next(int i, Unit& u) const { const long L = (long)i * G + c; if (L >= nunits) return false; u.pm = (int)(L / npn); u.pn = (int)(L % npn); return true; }
    __device__ __forceinline__ int expert(int pm) const { int e = 0; while (e < NEXP - 1 && pend[e] <= pm) ++e; return e; }
    __device__ __forceinline__ size_t aoff(const Gemm& g, const Unit& u) const { return (size_t)u.pm * BM * g.lda * 2; }
    __device__ __forceinline__ size_t boff(const Gemm& g, const Unit& u) const { return (size_t)expert(u.pm) * estride + (size_t)u.pn * BM * g.ldb * 2; }
    __device__ __forceinline__ void gather(const Gemm& g, const Unit& u, int tid, unsigned (&o)[2][2]) const {
        const int e = expert(u.pm), lp = u.pm - (e ? pend[e - 1] : 0), cnt = pcnt[e];
#pragma unroll
        for (int i = 0; i < 2; ++i) { int R, C; stage_rc(tid * 16 + i * 8192, R, C);
#pragma unroll
            for (int h = 0; h < 2; ++h) { const int pos = lp * 256 + h * HALF + R; int tok = 0; if (pos < cnt) tok = tab[(size_t)(e * MOE_CAP + pos) * 4];
                o[h][i] = (unsigned)tok * (unsigned)(g.lda * 2) + (unsigned)C * 2u; } }
    }
};
typedef MoeOrderT<false> MoeOrder; typedef MoeOrderT<true> MoeGather;

#define EPI_ROW(ai, m) (u.pm * 256 + (ai) * 128 + wr * 64 + (m) * 16 + fr)
#define EPI_COL(bj) (u.pn * 256 + (bj) * 128 + wc * 32 + 8 * fq)
#define EPI_COL16 (u.pn * 256 + wc * 64 + 16 * fq)
__device__ __forceinline__ int col16_src(int np) { const int j = np & 255; return (np & ~255) + 64 * ((j >> 5) & 3) + 16 * ((j >> 3) & 3) + 8 * (j >> 7) + (j & 7); }

template <bool SCALED> struct EpiScaleBf16T {
    static constexpr bool PERM = true;
    GAS bf16_t* O; int ldc; const GAS float* ssq; float invn; const GAS float* rowmul; float wsc;
    __device__ __forceinline__ void operator()(const f32x4 (&acc)[2][2][4][2], const Unit& u, int wr, int wc, int fr, int fq) const {
        float sc[2][4];
        if constexpr (SCALED) { float a[2][4], r[2][4];
#pragma unroll
            for (int ai = 0; ai < 2; ++ai)
#pragma unroll
                for (int m = 0; m < 4; ++m) { const int row = EPI_ROW(ai, m); a[ai][m] = ssq[row]; r[ai][m] = rowmul[row]; }
#pragma unroll
            for (int ai = 0; ai < 2; ++ai)
#pragma unroll
                for (int m = 0; m < 4; ++m) sc[ai][m] = __builtin_amdgcn_rsqf(a[ai][m] * invn + EPS) * r[ai][m] * wsc;
        }
#pragma unroll
        for (int ai = 0; ai < 2; ++ai)
#pragma unroll
            for (int m = 0; m < 4; ++m) { const int row = EPI_ROW(ai, m); const float s = SCALED ? sc[ai][m] : 1.0f;
#pragma unroll
                for (int bj = 0; bj < 2; ++bj) { const f32x4 v0 = acc[ai][bj][m][0] * s, v1 = acc[ai][bj][m][1] * s;
                    u32x4 w; w.x = cvt_pk_bf16(v0[0], v0[1]); w.y = cvt_pk_bf16(v0[2], v0[3]); w.z = cvt_pk_bf16(v1[0], v1[1]); w.w = cvt_pk_bf16(v1[2], v1[3]);
                    *(GAS u32x4*)(O + (size_t)row * ldc + EPI_COL(bj)) = w; } }
    }
};
typedef EpiScaleBf16T<true> EpiScaleBf16; typedef EpiScaleBf16T<false> EpiPlainBf16;
struct EpiProj1 {
    static constexpr bool PERM = true; static constexpr int NVM = 16;
    GAS bf16_t* P; const GAS float* ssq; const GAS float* xsc; float wsc; const GAS float* gq; const GAS float* gk; GAS float* pcq; GAS float* pckv; GAS float* pkpe;
    __device__ __forceinline__ void operator()(const f32x4 (&acc)[2][2][4][2], const Unit& u, int wr, int wc, int fr, int fq) const {
        float sc[2][4];
        { float a[2][4], r[2][4];
#pragma unroll
          for (int ai = 0; ai < 2; ++ai)
#pragma unroll
              for (int m = 0; m < 4; ++m) { const int row = EPI_ROW(ai, m); a[ai][m] = ssq[row]; r[ai][m] = xsc[row]; }
#pragma unroll
          for (int ai = 0; ai < 2; ++ai)
#pragma unroll
              for (int m = 0; m < 4; ++m) sc[ai][m] = __builtin_amdgcn_rsqf(a[ai][m] * (1.0f / 1024.0f) + EPS) * r[ai][m] * wsc; }
        if (u.pn < 3) {
            const int head8 = 4 * u.pn + wc; const bool norm = head8 < 10;
            f32x4 g[2][2];
            if (norm) { const GAS float* gp = (head8 < 8 ? gq : gk) + 8 * fq; const float gs = head8 < 8 ? C2A : 1.0f;
#pragma unroll
                for (int bj = 0; bj < 2; ++bj)
#pragma unroll
                    for (int n = 0; n < 2; ++n) g[bj][n] = *(const GAS f32x4*)(gp + 32 * bj + 4 * n) * gs; }
#pragma unroll
            for (int ai = 0; ai < 2; ++ai)
#pragma unroll
                for (int m = 0; m < 4; ++m) { const int row = EPI_ROW(ai, m); f32x4 v[2][2];
#pragma unroll
                    for (int bj = 0; bj < 2; ++bj)
#pragma unroll
                        for (int n = 0; n < 2; ++n) v[bj][n] = acc[ai][bj][m][n] * sc[ai][m];
                    if (norm) { float s = 0.f;
#pragma unroll
                        for (int bj = 0; bj < 2; ++bj)
#pragma unroll
                            for (int n = 0; n < 2; ++n) s += (v[bj][n][0] * v[bj][n][0] + v[bj][n][1] * v[bj][n][1]) + (v[bj][n][2] * v[bj][n][2] + v[bj][n][3] * v[bj][n][3]);
                        s += __shfl_xor(s, 16); s += __shfl_xor(s, 32);
                        const float rs = __builtin_amdgcn_rsqf(s * (1.0f / 64.0f) + EPS);
#pragma unroll
                        for (int bj = 0; bj < 2; ++bj)
#pragma unroll
                            for (int n = 0; n < 2; ++n) v[bj][n] = v[bj][n] * rs * g[bj][n]; }
#pragma unroll
                    for (int bj = 0; bj < 2; ++bj) { u32x4 w; w.x = cvt_pk_bf16(v[bj][0][0], v[bj][0][1]); w.y = cvt_pk_bf16(v[bj][0][2], v[bj][0][3]); w.z = cvt_pk_bf16(v[bj][1][0], v[bj][1][1]); w.w = cvt_pk_bf16(v[bj][1][2], v[bj][1][3]);
                        *(GAS u32x4*)(P + (size_t)row * NPROJ1 + 64 * head8 + 32 * bj + 8 * fq) = w; } }
        } else {
#pragma unroll
            for (int ai = 0; ai < 2; ++ai)
#pragma unroll
                for (int m = 0; m < 4; ++m) { const int row = EPI_ROW(ai, m); float s0 = 0.f, s1 = 0.f;
#pragma unroll
                    for (int bj = 0; bj < 2; ++bj) { const f32x4 v0 = acc[ai][bj][m][0] * sc[ai][m], v1 = acc[ai][bj][m][1] * sc[ai][m];
                        const float q = (v0[0] * v0[0] + v0[1] * v0[1]) + (v0[2] * v0[2] + v0[3] * v0[3]) + (v1[0] * v1[0] + v1[1] * v1[1]) + (v1[2] * v1[2] + v1[3] * v1[3]);
                        if (bj == 0) s0 = q; else s1 = q;
                        u32x4 w; w.x = cvt_pk_bf16(v0[0], v0[1]); w.y = cvt_pk_bf16(v0[2], v0[3]); w.z = cvt_pk_bf16(v1[0], v1[1]); w.w = cvt_pk_bf16(v1[2], v1[3]);
                        *(GAS u32x4*)(P + (size_t)row * NPROJ1 + EPI_COL(bj)) = w; }
                    float s = (u.pn == 3) ? s0 + s1 : s0;
                    s += __shfl_xor(s, 16); s += __shfl_xor(s, 32);
                    if (fq == 0) ((u.pn == 3) ? pcq : pckv)[(size_t)row * 4 + wc] = s;
                    if (u.pn == 4 && wc == 0) { float t = s1; t += __shfl_xor(t, 16); t += __shfl_xor(t, 32); if (fq == 0) pkpe[row] = t; } }
        }
    }
};
struct EpiRowNorm4 {
    static constexpr bool PERM = true; static constexpr int NVM = 16;
    GAS bf16_t* O; int ldc; const GAS float* part; float invn;
    __device__ __forceinline__ void operator()(const f32x4 (&acc)[2][2][4][2], const Unit& u, int wr, int wc, int fr, int fq) const {
        f32x4 p[2][4];
#pragma unroll
        for (int ai = 0; ai < 2; ++ai)
#pragma unroll
            for (int m = 0; m < 4; ++m) p[ai][m] = *(const GAS f32x4*)(part + (size_t)EPI_ROW(ai, m) * 4);
#pragma unroll
        for (int ai = 0; ai < 2; ++ai)
#pragma unroll
            for (int m = 0; m < 4; ++m) { const int row = EPI_ROW(ai, m); const float s = __builtin_amdgcn_rsqf(((p[ai][m].x + p[ai][m].y) + (p[ai][m].z + p[ai][m].w)) * invn + EPS);
#pragma unroll
                for (int bj = 0; bj < 2; ++bj) { const f32x4 v0 = acc[ai][bj][m][0] * s, v1 = acc[ai][bj][m][1] * s;
                    u32x4 w; w.x = cvt_pk_bf16(v0[0], v0[1]); w.y = cvt_pk_bf16(v0[2], v0[3]); w.z = cvt_pk_bf16(v1[0], v1[1]); w.w = cvt_pk_bf16(v1[2], v1[3]);
                    *(GAS u32x4*)(O + (size_t)row * ldc + EPI_COL(bj)) = w; } }
    }
};
struct EpiGates {
    static constexpr bool PERM = true;
    GAS bf16_t* O; const GAS float* ssq; const GAS float* bias; const GAS float* rowmul; float wsc;
    __device__ __forceinline__ void operator()(const f32x4 (&acc)[2][2][4][2], const Unit& u, int wr, int wc, int fr, int fq) const {
        f32x4 bv[2][2]; float a[2][4], r[2][4], sc[2][4];
#pragma unroll
        for (int bj = 0; bj < 2; ++bj)
#pragma unroll
            for (int n = 0; n < 2; ++n) bv[bj][n] = *(const GAS f32x4*)(bias + EPI_COL(bj) + 4 * n);
#pragma unroll
        for (int ai = 0; ai < 2; ++ai)
#pragma unroll
            for (int m = 0; m < 4; ++m) { const int row = EPI_ROW(ai, m); a[ai][m] = ssq[row]; r[ai][m] = rowmul[row]; }
#pragma unroll
        for (int ai = 0; ai < 2; ++ai)
#pragma unroll
            for (int m = 0; m < 4; ++m) sc[ai][m] = __builtin_amdgcn_rsqf(a[ai][m] * (1.0f / 1024.0f) + EPS) * r[ai][m] * wsc;
#pragma unroll
        for (int ai = 0; ai < 2; ++ai)
#pragma unroll
            for (int m = 0; m < 4; ++m) { const int row = EPI_ROW(ai, m); const float s = sc[ai][m];
#pragma unroll
                for (int bj = 0; bj < 2; ++bj) { f32x4 v0 = acc[ai][bj][m][0] * s + bv[bj][0], v1 = acc[ai][bj][m][1] * s + bv[bj][1];
#pragma unroll
                    for (int i = 0; i < 4; ++i) { v0[i] = fsigmoid(v0[i]); v1[i] = fsigmoid(v1[i]); }
                    u32x4 w; w.x = cvt_pk_bf16(v0[0], v0[1]); w.y = cvt_pk_bf16(v0[2], v0[3]); w.z = cvt_pk_bf16(v1[0], v1[1]); w.w = cvt_pk_bf16(v1[2], v1[3]);
                    *(GAS u32x4*)(O + (size_t)row * 2048 + EPI_COL(bj)) = w; } }
    }
};
struct EpiKv {
    static constexpr bool PERM = true; static constexpr int NVM = 16;
    GAS bf16_t* KBo; GAS bf16_t* Vo; const GAS float* pckv; const GAS float* pkpe; const GAS bf16_t* P; const GAS float* gbk; const GAS float* rope;
    __device__ __forceinline__ void operator()(const f32x4 (&acc)[2][2][4][2], const Unit& u, int wr, int wc, int fr, int fq) const {
        asm volatile("" : "+v"(fr), "+v"(fq));
        float rc[2][4];
        { f32x4 p[2][4];
#pragma unroll
          for (int ai = 0; ai < 2; ++ai)
#pragma unroll
              for (int m = 0; m < 4; ++m) p[ai][m] = *(const GAS f32x4*)(pckv + (unsigned)(EPI_ROW(ai, m) * 4));
#pragma unroll
          for (int ai = 0; ai < 2; ++ai)
#pragma unroll
              for (int m = 0; m < 4; ++m) rc[ai][m] = __builtin_amdgcn_rsqf(((p[ai][m].x + p[ai][m].y) + (p[ai][m].z + p[ai][m].w)) * (1.0f / 128.0f) + EPS); }
        const int head = 2 * u.pn + (wc & 1);
        if (wc >= 2) {
#pragma unroll
            for (int ai = 0; ai < 2; ++ai)
#pragma unroll
                for (int m = 0; m < 4; ++m) { const int row = EPI_ROW(ai, m);
#pragma unroll
                    for (int bj = 0; bj < 2; ++bj) { const f32x4 v0 = acc[ai][bj][m][0] * rc[ai][m], v1 = acc[ai][bj][m][1] * rc[ai][m];
                        u32x4 w; w.x = cvt_pk_bf16(v0[0], v0[1]); w.y = cvt_pk_bf16(v0[2], v0[3]); w.z = cvt_pk_bf16(v1[0], v1[1]); w.w = cvt_pk_bf16(v1[2], v1[3]);
                        *(GAS u32x4*)(Vo + (unsigned)(row * 1024 + 128 * head + 64 + 32 * bj + 8 * fq)) = w; } }
        } else {
            float rsh[2][4];
            {
                float sk[2][4];
#pragma unroll
                for (int ai = 0; ai < 2; ++ai)
#pragma unroll
                    for (int m = 0; m < 4; ++m) sk[ai][m] = pkpe[(unsigned)EPI_ROW(ai, m)];
                f32x4 g[2][2];
#pragma unroll
                for (int bj = 0; bj < 2; ++bj)
#pragma unroll
                    for (int n = 0; n < 2; ++n) g[bj][n] = *(const GAS f32x4*)(gbk + (unsigned)(32 * bj + 8 * fq + 4 * n));
#pragma unroll
                for (int ai = 0; ai < 2; ++ai)
#pragma unroll
                    for (int m = 0; m < 4; ++m) { const int row = EPI_ROW(ai, m); f32x4 v[2][2]; float s = 0.f;
#pragma unroll
                        for (int bj = 0; bj < 2; ++bj)
#pragma unroll
                            for (int n = 0; n < 2; ++n) { v[bj][n] = acc[ai][bj][m][n] * rc[ai][m]; s += (v[bj][n][0] * v[bj][n][0] + v[bj][n][1] * v[bj][n][1]) + (v[bj][n][2] * v[bj][n][2] + v[bj][n][3] * v[bj][n][3]); }
                        s += __shfl_xor(s, 16); s += __shfl_xor(s, 32);
                        const float rs = __builtin_amdgcn_rsqf((s + sk[ai][m]) * (1.0f / 96.0f) + EPS); rsh[ai][m] = rs;
                        const unsigned dof = (unsigned)((((row >> 12) * 8 + head) * 64 + ((row & (SEQ - 1)) >> 6)) * 12 * 512 + (row & 63) * 8);
#pragma unroll
                        for (int bj = 0; bj < 2; ++bj) { const f32x4 a0 = v[bj][0] * rs * g[bj][0], a1 = v[bj][1] * rs * g[bj][1];
                            u32x4 w; w.x = cvt_pk_bf16(a0[0], a0[1]); w.y = cvt_pk_bf16(a0[2], a0[3]); w.z = cvt_pk_bf16(a1[0], a1[1]); w.w = cvt_pk_bf16(a1[2], a1[3]);
                            *(GAS u32x4*)(KBo + (dof + (4 * bj + fq) * 512)) = w; }
                        }
            }
            asm volatile("" : "+v"(fq), "+v"(fr) :: "memory");
            {
                const f32x4 gr0 = *(const GAS f32x4*)(gbk + (unsigned)(64 + 4 * fq)), gr1 = *(const GAS f32x4*)(gbk + (unsigned)(80 + 4 * fq));
#pragma unroll
                for (int ai = 0; ai < 2; ++ai) { u32x2 kp0[4], kp1[4]; f32x4 cs[4], sn[4];
#pragma unroll
                    for (int m = 0; m < 4; ++m) { const int row = EPI_ROW(ai, m);
                        const unsigned pof = (unsigned)(row * NPROJ1 + C_KPE + 4 * fq); kp0[m] = *(const GAS u32x2*)(P + pof); kp1[m] = *(const GAS u32x2*)(P + (pof + 16));
                        const unsigned rof = (unsigned)((row & (SEQ - 1)) * 32 + 4 * fq); cs[m] = *(const GAS f32x4*)(rope + rof); sn[m] = *(const GAS f32x4*)(rope + (rof + 16)); }
#pragma unroll
                    for (int m = 0; m < 4; ++m) { const int row = EPI_ROW(ai, m); const float rs = rsh[ai][m]; const unsigned dof = (unsigned)((((row >> 12) * 8 + head) * 64 + ((row & (SEQ - 1)) >> 6)) * 12 * 512 + (row & 63) * 8);
                        const f32x4 x1 = (f32x4){bflo(kp0[m].x), bfhi(kp0[m].x), bflo(kp0[m].y), bfhi(kp0[m].y)} * rs * gr0, x2 = (f32x4){bflo(kp1[m].x), bfhi(kp1[m].x), bflo(kp1[m].y), bfhi(kp1[m].y)} * rs * gr1;
                        const f32x4 o1 = x1 * cs[m] - x2 * sn[m], o2 = x1 * sn[m] + x2 * cs[m];
                        u32x2 w1, w2; w1.x = cvt_pk_bf16(o1[0], o1[1]); w1.y = cvt_pk_bf16(o1[2], o1[3]); w2.x = cvt_pk_bf16(o2[0], o2[1]); w2.y = cvt_pk_bf16(o2[2], o2[3]);
                        *(GAS u32x2*)(KBo + (dof + (8 + (fq >> 1)) * 512 + 4 * (fq & 1))) = w1; *(GAS u32x2*)(KBo + (dof + (10 + (fq >> 1)) * 512 + 4 * (fq & 1))) = w2; }
                    asm volatile("" ::: "memory"); }
            }
        }
    }
};
struct EpiGates2 {
    static constexpr bool PERM = true; static constexpr int NVM = 16;
    GAS bf16_t* GR; GAS bf16_t* GBo; const GAS float* ssq; const GAS float* bias; const GAS float* rowmul; float wsc;
    __device__ __forceinline__ void operator()(const f32x4 (&acc)[2][2][4][2], const Unit& u, int wr, int wc, int fr, int fq) const {
        f32x4 ba[2], bb[2]; float a[2][4], r[2][4], sc[2][4];
        const int c0 = u.pn * 128 + wc * 32 + 8 * fq;
#pragma unroll
        for (int n = 0; n < 2; ++n) { ba[n] = *(const GAS f32x4*)(bias + c0 + 4 * n) * (-LOG2E); bb[n] = *(const GAS f32x4*)(bias + 1024 + c0 + 4 * n) * (-LOG2E); }
#pragma unroll
        for (int ai = 0; ai < 2; ++ai)
#pragma unroll
            for (int m = 0; m < 4; ++m) { const int row = EPI_ROW(ai, m); a[ai][m] = ssq[row]; r[ai][m] = rowmul[row]; }
#pragma unroll
        for (int ai = 0; ai < 2; ++ai)
#pragma unroll
            for (int m = 0; m < 4; ++m) sc[ai][m] = __builtin_amdgcn_rsqf(a[ai][m] * (1.0f / 1024.0f) + EPS) * r[ai][m] * (wsc * -LOG2E);
#pragma unroll
        for (int ai = 0; ai < 2; ++ai)
#pragma unroll
            for (int m = 0; m < 4; ++m) { const int row = EPI_ROW(ai, m); const float s = sc[ai][m]; f32x4 rr[2], gb[2];
#pragma unroll
                for (int n = 0; n < 2; ++n) { const f32x4 la = acc[ai][0][m][n] * s + ba[n], lb = acc[ai][1][m][n] * s + bb[n];
#pragma unroll
                    for (int i = 0; i < 4; ++i) { const float ea = __builtin_amdgcn_exp2f(la[i]), eb = __builtin_amdgcn_exp2f(lb[i]);
                        gb[n][i] = __builtin_amdgcn_rcpf(1.0f + eb); rr[n][i] = (1.0f + eb) * __builtin_amdgcn_rcpf(1.0f + ea); } }
                const size_t off = (size_t)row * 1024 + c0;
                u32x4 w; w.x = cvt_pk_bf16(rr[0][0], rr[0][1]); w.y = cvt_pk_bf16(rr[0][2], rr[0][3]); w.z = cvt_pk_bf16(rr[1][0], rr[1][1]); w.w = cvt_pk_bf16(rr[1][2], rr[1][3]); *(GAS u32x4*)(GR + off) = w;
                w.x = cvt_pk_bf16(gb[0][0], gb[0][1]); w.y = cvt_pk_bf16(gb[0][2], gb[0][3]); w.z = cvt_pk_bf16(gb[1][0], gb[1][1]); w.w = cvt_pk_bf16(gb[1][2], gb[1][3]); *(GAS u32x4*)(GBo + off) = w; }
    }
};
struct EpiMerge {
    static constexpr bool PERM = true; static constexpr bool HAS_MID = true; static constexpr int NVM = 8;
    GAS bf16_t* Mo; const GAS bf16_t* GR; const GAS bf16_t* GBi;
    template <bool FIN> __device__ __forceinline__ void apply(f32x4 (&acc)[2][2][4][2], const Unit& u, int wr, int wc, int fr, int fq) const {
        const GAS bf16_t* G_ = FIN ? GBi : GR;
        u32x4 gv[2][4][2];
#pragma unroll
        for (int ai = 0; ai < 2; ++ai)
#pragma unroll
            for (int m = 0; m < 4; ++m)
#pragma unroll
                for (int bj = 0; bj < 2; ++bj) gv[ai][m][bj] = *(const GAS u32x4*)(G_ + (size_t)EPI_ROW(ai, m) * 1024 + EPI_COL16 + 8 * bj);
#pragma unroll
        for (int ai = 0; ai < 2; ++ai) {
#pragma unroll
            for (int m = 0; m < 4; ++m) { u32x4 w;
#pragma unroll
                for (int bj = 0; bj < 2; ++bj) { const u32x4 g = gv[ai][m][bj]; f32x4 v0 = acc[ai][bj][m][0], v1 = acc[ai][bj][m][1];
                    v0[0] *= bflo(g.x); v0[1] *= bfhi(g.x); v0[2] *= bflo(g.y); v0[3] *= bfhi(g.y); v1[0] *= bflo(g.z); v1[1] *= bfhi(g.z); v1[2] *= bflo(g.w); v1[3] *= bfhi(g.w);
                    if constexpr (FIN) { v0 = v0 * W8I; v1 = v1 * W8I; const unsigned lo_ = pk4_fp8(v0[0], v0[1], v0[2], v0[3]), hi_ = pk4_fp8(v1[0], v1[1], v1[2], v1[3]);
                        if (bj == 0) { w.x = lo_; w.y = hi_; } else { w.z = lo_; w.w = hi_; } }
                    else { acc[ai][bj][m][0] = v0; acc[ai][bj][m][1] = v1; } }
                if constexpr (FIN) *(GAS u32x4*)((GAS unsigned char*)Mo + (size_t)EPI_ROW(ai, m) * 1024 + EPI_COL16) = w; }
            asm volatile("" ::: "memory"); }
    }
    __device__ __forceinline__ void mid(f32x4 (&acc)[2][2][4][2], const Unit& u, int wr, int wc, int fr, int fq) const { apply<false>(acc, u, wr, wc, fr, fq); }
    __device__ __forceinline__ void operator()(f32x4 (&acc)[2][2][4][2], const Unit& u, int wr, int wc, int fr, int fq) const { apply<true>(acc, u, wr, wc, fr, fq); }
};
template <bool ACCUM> struct EpiGateMul {
    static constexpr bool PERM = true;
    GAS bf16_t* Mo; const GAS bf16_t* gates; int goff;
    __device__ __forceinline__ void operator()(const f32x4 (&acc)[2][2][4][2], const Unit& u, int wr, int wc, int fr, int fq) const {
#pragma unroll
        for (int ai = 0; ai < 2; ++ai) { u32x4 gv[4][2], pv[4][2];
#pragma unroll
            for (int m = 0; m < 4; ++m) { const int row = EPI_ROW(ai, m);
#pragma unroll
                for (int bj = 0; bj < 2; ++bj) { const int col = EPI_COL(bj); gv[m][bj] = *(const GAS u32x4*)(gates + (size_t)row * 2048 + goff + col);
                    if (ACCUM) pv[m][bj] = *(const GAS u32x4*)(Mo + (size_t)row * 1024 + col); } }
#pragma unroll
            for (int m = 0; m < 4; ++m) { const int row = EPI_ROW(ai, m);
#pragma unroll
                for (int bj = 0; bj < 2; ++bj) { const int col = EPI_COL(bj); const u32x4 g = gv[m][bj];
                    f32x4 v0 = acc[ai][bj][m][0], v1 = acc[ai][bj][m][1];
                    v0[0] *= bflo(g.x); v0[1] *= bfhi(g.x); v0[2] *= bflo(g.y); v0[3] *= bfhi(g.y);
                    v1[0] *= bflo(g.z); v1[1] *= bfhi(g.z); v1[2] *= bflo(g.w); v1[3] *= bfhi(g.w);
                    if (ACCUM) { const u32x4 p = pv[m][bj];
                        v0[0] += bflo(p.x); v0[1] += bfhi(p.x); v0[2] += bflo(p.y); v0[3] += bfhi(p.y);
                        v1[0] += bflo(p.z); v1[1] += bfhi(p.z); v1[2] += bflo(p.w); v1[3] += bfhi(p.w); }
                    u32x4 w; w.x = cvt_pk_bf16(v0[0], v0[1]); w.y = cvt_pk_bf16(v0[2], v0[3]); w.z = cvt_pk_bf16(v1[0], v1[1]); w.w = cvt_pk_bf16(v1[2], v1[3]);
                    *(GAS u32x4*)(Mo + (size_t)row * 1024 + col) = w; } }
            asm volatile("" ::: "memory"); }
    }
};
struct EpiResid {
    static constexpr bool PERM = true; static constexpr int NVM = 16;
    const GAS float* xres; GAS bf16_t* xb; GAS float* ssq;
    __device__ __forceinline__ void operator()(const f32x4 (&acc)[2][2][4][2], const Unit& u, int wr, int wc, int fr, int fq) const {
#pragma unroll
        for (int ai = 0; ai < 2; ++ai) { f32x4 pre[4][2][2];
            if (xres) {
#pragma unroll
                for (int m = 0; m < 4; ++m) { const int row = EPI_ROW(ai, m);
#pragma unroll
                    for (int bj = 0; bj < 2; ++bj) { const size_t off = (size_t)row * 1024 + EPI_COL16 + 8 * bj; pre[m][bj][0] = *(const GAS f32x4*)(xres + off); pre[m][bj][1] = *(const GAS f32x4*)(xres + off + 4); } }
            } else {
                u32x4 pb[4][2];
#pragma unroll
                for (int m = 0; m < 4; ++m) { const int row = EPI_ROW(ai, m);
#pragma unroll
                    for (int bj = 0; bj < 2; ++bj) pb[m][bj] = *(const GAS u32x4*)(xb + (size_t)row * 1024 + EPI_COL16 + 8 * bj); }
#pragma unroll
                for (int m = 0; m < 4; ++m)
#pragma unroll
                    for (int bj = 0; bj < 2; ++bj) { const u32x4 p = pb[m][bj]; pre[m][bj][0] = (f32x4){bflo(p.x), bfhi(p.x), bflo(p.y), bfhi(p.y)}; pre[m][bj][1] = (f32x4){bflo(p.z), bfhi(p.z), bflo(p.w), bfhi(p.w)}; }
            }
#pragma unroll
            for (int m = 0; m < 4; ++m) { const int row = EPI_ROW(ai, m); float s = 0.f;
#pragma unroll
                for (int bj = 0; bj < 2; ++bj) { const size_t off = (size_t)row * 1024 + EPI_COL16 + 8 * bj;
                    const f32x4 v0 = acc[ai][bj][m][0] * W8I + pre[m][bj][0], v1 = acc[ai][bj][m][1] * W8I + pre[m][bj][1];
                    s += (v0[0] * v0[0] + v0[1] * v0[1]) + (v0[2] * v0[2] + v0[3] * v0[3]) + (v1[0] * v1[0] + v1[1] * v1[1]) + (v1[2] * v1[2] + v1[3] * v1[3]);
                    u32x4 w; w.x = cvt_pk_bf16(v0[0], v0[1]); w.y = cvt_pk_bf16(v0[2], v0[3]); w.z = cvt_pk_bf16(v1[0], v1[1]); w.w = cvt_pk_bf16(v1[2], v1[3]);
                    *(GAS u32x4*)(xb + off) = w; }
                s += __shfl_xor(s, 16); s += __shfl_xor(s, 32);
                if (fq == 0) ssq[(size_t)row * 16 + u.pn * 4 + wc] = s; }
            asm volatile("" ::: "memory"); }
    }
};
struct EpiLogits {
    static constexpr bool PERM = true;
    GAS float* L; const GAS float* ssqp;
    __device__ __forceinline__ void operator()(const f32x4 (&acc)[2][2][4][2], const Unit& u, int wr, int wc, int fr, int fq) const {
        if (u.pn != 0 || wc > 1) return;
#pragma unroll
        for (int ai = 0; ai < 2; ++ai) { f32x4 pp[4][4];
#pragma unroll
            for (int m = 0; m < 4; ++m) { const GAS f32x4* p = (const GAS f32x4*)(ssqp + (size_t)EPI_ROW(ai, m) * 16); pp[m][0] = p[0]; pp[m][1] = p[1]; pp[m][2] = p[2]; pp[m][3] = p[3]; }
#pragma unroll
            for (int m = 0; m < 4; ++m) { const int row = EPI_ROW(ai, m); const f32x4 a = pp[m][0], b = pp[m][1], c = pp[m][2], d = pp[m][3];
                const float sc = __builtin_amdgcn_rsqf((((a.x + a.y) + (a.z + a.w)) + ((b.x + b.y) + (b.z + b.w)) + ((c.x + c.y) + (c.z + c.w)) + ((d.x + d.y) + (d.z + d.w))) * (1.0f / 1024.0f) + EPS);
#pragma unroll
                for (int n = 0; n < 2; ++n) { const int col = wc * 32 + 8 * fq + 4 * n; if (col < 36) *(GAS f32x4*)(L + (size_t)row * 64 + col) = acc[ai][0][m][n] * sc; } } }
    }
};
struct EpiGateUp {
    static constexpr bool PERM = true; static constexpr int NVM = 8;
    GAS bf16_t* act; const GAS float* tabf; const LAS int* pend; const LAS int* pcnt; float wsc;
    __device__ __forceinline__ void operator()(const f32x4 (&acc)[2][2][4][2], const Unit& u, int wr, int wc, int fr, int fq) const {
        int e = 0; while (e < NEXP - 1 && pend[e] <= u.pm) ++e;
        const int lp = u.pm - (e ? pend[e - 1] : 0), cnt = pcnt[e] - lp * 256; const unsigned base = (unsigned)(e * MOE_CAP + lp * 256);
        float sc[2][4];
#pragma unroll
        for (int ai = 0; ai < 2; ++ai)
#pragma unroll
            for (int m = 0; m < 4; ++m) { const int r = ai * 128 + wr * 64 + m * 16 + fr; const float v = tabf[(size_t)(base + r) * 4 + 1]; sc[ai][m] = (r < cnt) ? v : 0.f; }
#pragma unroll
        for (int ai = 0; ai < 2; ++ai)
#pragma unroll
            for (int m = 0; m < 4; ++m) { const int row = EPI_ROW(ai, m); const float s = sc[ai][m] * wsc; f32x4 a[2];
#pragma unroll
                for (int n = 0; n < 2; ++n) { const f32x4 gg = acc[ai][0][m][n] * s, uu = acc[ai][1][m][n] * s;
#pragma unroll
                    for (int i = 0; i < 4; ++i) a[n][i] = gg[i] * fsigmoid(gg[i]) * uu[i]; }
                u32x4 w; w.x = cvt_pk_bf16(a[0][0], a[0][1]); w.y = cvt_pk_bf16(a[0][2], a[0][3]); w.z = cvt_pk_bf16(a[1][0], a[1][1]); w.w = cvt_pk_bf16(a[1][2], a[1][3]);
                *(GAS u32x4*)(act + (size_t)row * 256 + u.pn * 128 + wc * 32 + 8 * fq) = w; }
    }
};
struct EpiDown {
    static constexpr bool PERM = true;
    GAS bf16_t* ybuf; const GAS int* tabi; const LAS int* pend; const LAS int* pcnt;
    __device__ __forceinline__ void operator()(const f32x4 (&acc)[2][2][4][2], const Unit& u, int wr, int wc, int fr, int fq) const {
        int e = 0; while (e < NEXP - 1 && pend[e] <= u.pm) ++e;
        const int lp = u.pm - (e ? pend[e - 1] : 0), cnt = pcnt[e] - lp * 256; const unsigned base = (unsigned)(e * MOE_CAP + lp * 256);
        int yd[2][4]; float sw[2][4];
#pragma unroll
        for (int ai = 0; ai < 2; ++ai)
#pragma unroll
            for (int m = 0; m < 4; ++m) { const int r = ai * 128 + wr * 64 + m * 16 + fr; const GAS int* en = tabi + (size_t)(base + r) * 4; const int y_ = en[2]; const float w_ = __int_as_float(en[3]);
                yd[ai][m] = (r < cnt) ? y_ : -1; sw[ai][m] = w_; }
#pragma unroll
        for (int ai = 0; ai < 2; ++ai)
#pragma unroll
            for (int m = 0; m < 4; ++m) { const float sc = sw[ai][m];
                if (yd[ai][m] >= 0) {
#pragma unroll
                    for (int bj = 0; bj < 2; ++bj) { const f32x4 v0 = acc[ai][bj][m][0] * sc, v1 = acc[ai][bj][m][1] * sc;
                        u32x4 w; w.x = cvt_pk_bf16(v0[0], v0[1]); w.y = cvt_pk_bf16(v0[2], v0[3]); w.z = cvt_pk_bf16(v1[0], v1[1]); w.w = cvt_pk_bf16(v1[2], v1[3]);
                        *(GAS u32x4*)(ybuf + (size_t)yd[ai][m] * 1024 + EPI_COL(bj)) = w; } } }
    }
};

typedef int v4i32_t __attribute__((ext_vector_type(4)));
typedef long i64x2_t __attribute__((ext_vector_type(2)));
template <class E, class = void> struct nvm_of { static constexpr int v = 0; };
template <class E> struct nvm_of<E, decltype((void)E::NVM)> { static constexpr int v = E::NVM; };
template <class Epi, class Sched, bool I8 = false, bool MID = false, bool F8 = false, bool ALIGN_EPI = true, bool SP2 = true>
__device__ __forceinline__ void gemm_phase(LAS unsigned char* lds, const Gemm g, const Sched& S, const Epi& E) {
    int tid_ = threadIdx.x; asm volatile("" : "+v"(tid_));
    const int tid = tid_, wid = __builtin_amdgcn_readfirstlane(tid >> 6), lane = tid & 63, wr = wid >> 2, wc = wid & 3, fr = lane & 15, fq = lane >> 4;
    int K_ = g.K; asm volatile("" : "+s"(K_));
    const int K = K_, nt = K / BK;
    unsigned voffA[2], voffB[2];
#pragma unroll
    for (int i = 0; i < 2; ++i) { int R, C; stage_rc(tid * 16 + i * 8192, R, C); const int Rb = Epi::PERM ? ((R & ~31) + perm32(R & 31)) : R;
        voffA[i] = (unsigned)(R * g.lda + C) * 2u; voffB[i] = (unsigned)(Rb * g.ldb + C) * 2u; }
    const size_t kstep = (size_t)(BK * 2);
    const size_t hstepA = (size_t)HALF * g.lda * 2, hstepB = (size_t)HALF * g.ldb * 2;
    const unsigned ldsw = (unsigned)wid * 1024u;
    const int aoff = lds_byte(wr * 64 + fr, fq * 8), boff = lds_byte(wc * 32 + fr, fq * 8);
#define PG8_SA(b, h) (((b) * 2 + (h)) * HTB)
#define PG8_SB(b, h) ((4 + (b) * 2 + (h)) * HTB)
#define PG8_STAGE(bufoff, gbase, voff) do { _Pragma("unroll") for (int _i = 0; _i < 2; ++_i) \
        __builtin_amdgcn_global_load_lds((const GAS unsigned*)((const char*)(gbase) + (voff)[_i]), (LAS unsigned*)(lds + (bufoff) + ldsw + _i * 8192), 16, 0, 0); } while (0)
#define PG8_LDA(dst, b, h) do { _Pragma("unroll") for (int m = 0; m < 4; ++m) _Pragma("unroll") for (int k = 0; k < 2; ++k) dst[m][k] = *(const LAS bf16x8*)(lds + PG8_SA(b, h) + aoff + m * 2048 + k * 1024); } while (0)
#define PG8_LDB(dst, b, h) do { _Pragma("unroll") for (int n = 0; n < 2; ++n) _Pragma("unroll") for (int k = 0; k < 2; ++k) dst[n][k] = *(const LAS bf16x8*)(lds + PG8_SB(b, h) + boff + n * 2048 + k * 1024); } while (0)
#define PG8_MMA(ai, bj, At, Bt) do { __builtin_amdgcn_s_setprio(1); _Pragma("unroll") for (int m = 0; m < 4; ++m) _Pragma("unroll") for (int n = 0; n < 2; ++n) _Pragma("unroll") for (int k = 0; k < 2; ++k) { \
        if constexpr (I8) acc[ai][bj][m][n] = __builtin_bit_cast(f32x4, __builtin_amdgcn_mfma_i32_16x16x64_i8(__builtin_bit_cast(v4i32_t, Bt[n][k]), __builtin_bit_cast(v4i32_t, At[m][k]), __builtin_bit_cast(v4i32_t, acc[ai][bj][m][n]), 0, 0, 0)); \
        else if constexpr (F8) { const i64x2_t b_ = __builtin_bit_cast(i64x2_t, Bt[n][k]), a_ = __builtin_bit_cast(i64x2_t, At[m][k]); \
            acc[ai][bj][m][n] = __builtin_amdgcn_mfma_f32_16x16x32_fp8_fp8(b_[0], a_[0], acc[ai][bj][m][n], 0, 0, 0); acc[ai][bj][m][n] = __builtin_amdgcn_mfma_f32_16x16x32_fp8_fp8(b_[1], a_[1], acc[ai][bj][m][n], 0, 0, 0); } \
        else acc[ai][bj][m][n] = __builtin_amdgcn_mfma_f32_16x16x32_bf16(Bt[n][k], At[m][k], acc[ai][bj][m][n], 0, 0, 0); } \
        __builtin_amdgcn_s_setprio(0); } while (0)
#define PG8_WAIT_V(n) asm volatile("s_waitcnt vmcnt(" #n ")" ::: "memory")
#define PG8_WAIT_V0(first_) do { if constexpr (nvm_of<Epi>::v > 0) { if (first_) asm volatile("s_waitcnt vmcnt(%0)" :: "n"(8 + nvm_of<Epi>::v) : "memory"); else PG8_WAIT_V(8); } else PG8_WAIT_V(8); } while (0)
#define PG8_WAIT_L(n) asm volatile("s_waitcnt lgkmcnt(" #n ")" ::: "memory")
#define PG8_BAR __builtin_amdgcn_s_barrier()
#define PG8_SCHED __builtin_amdgcn_sched_barrier(0)
    Unit cur, nxt; int ui = 0;
    if (!S.next(0, cur)) return;
    unsigned gvc[2][2], gvn[2][2];
    if constexpr (Sched::GATHER) { S.gather(g, cur, tid, gvc); gvn[0][0] = gvc[0][0]; gvn[0][1] = gvc[0][1]; gvn[1][0] = gvc[1][0]; gvn[1][1] = gvc[1][1]; }
#define PG8_STAGE_A(b, h, aptr, ko, nx) do { if constexpr (Sched::GATHER) { unsigned sv_[2] = {(nx) ? gvn[h][0] : gvc[h][0], (nx) ? gvn[h][1] : gvc[h][1]}; PG8_STAGE(PG8_SA(b, h), (const char*)g.A + (ko), sv_); } \
        else PG8_STAGE(PG8_SA(b, h), (aptr), voffA); } while (0)
    f32x4 acc[2][2][4][2];
#pragma unroll
    for (int a = 0; a < 2; ++a)
#pragma unroll
        for (int b = 0; b < 2; ++b)
#pragma unroll
            for (int m = 0; m < 4; ++m)
#pragma unroll
                for (int n = 0; n < 2; ++n) acc[a][b][m][n] = (f32x4){0.f, 0.f, 0.f, 0.f};
    bf16x8 At[4][2], B0[2][2], B1[2][2];
    const char* cA = (const char*)g.A + S.aoff(g, cur); const char* cB = (const char*)g.Bt + S.boff(g, cur);
    const int ntm = nt - 1;
#define PG8_ROT(u_) ((MID || nt < 4) ? 0 : (((u_).pn & 3) * (nt >> 2)))
#define PG8_KO(rot_, t_) ((size_t)(((t_) + (rot_)) & ntm) * kstep)
    int rotc = PG8_ROT(cur);
    if constexpr (SP2) {
        PG8_STAGE(PG8_SB(0, 0), cB + PG8_KO(rotc, 0), voffB); PG8_STAGE(PG8_SB(0, 1), cB + hstepB + PG8_KO(rotc, 0), voffB); PG8_STAGE_A(0, 0, cA + PG8_KO(rotc, 0), PG8_KO(rotc, 0), false); PG8_STAGE_A(0, 1, cA + hstepA + PG8_KO(rotc, 0), PG8_KO(rotc, 0), false);
        if (wr == 1) PG8_BAR;
        PG8_WAIT_V(2); PG8_BAR;
        PG8_STAGE(PG8_SB(1, 0), cB + PG8_KO(rotc, 1), voffB); PG8_STAGE_A(1, 0, cA + PG8_KO(rotc, 1), PG8_KO(rotc, 1), false); PG8_STAGE(PG8_SB(1, 1), cB + hstepB + PG8_KO(rotc, 1), voffB);
        PG8_WAIT_V(6); PG8_BAR;
    }
    for (;;) {
        const bool has_next = S.next(ui + 1, nxt);
        const char* nA = has_next ? (const char*)g.A + S.aoff(g, nxt) : cA; const char* nB = has_next ? (const char*)g.Bt + S.boff(g, nxt) : cB;
        const int rotn = has_next ? PG8_ROT(nxt) : rotc;
        if constexpr (Sched::GATHER) { if (has_next) S.gather(g, nxt, tid, gvn); }
        int fw_ = __builtin_amdgcn_readfirstlane(ui > 0 ? 1 : 0); asm volatile("" : "+s"(fw_));
        for (int t = 0; t < nt; t += 2) {
            if constexpr (MID) { if (t == (nt >> 1)) E.mid(acc, cur, wr, wc, fr, fq); }
            const bool last = (t == nt - 2);
            const char* a1 = cA + PG8_KO(rotc, t + 1);
            const char* a2 = last ? nA + PG8_KO(rotn, 0) : cA + PG8_KO(rotc, t + 2); const char* b2 = last ? nB + PG8_KO(rotn, 0) : cB + PG8_KO(rotc, t + 2);
            const char* a3 = last ? nA + PG8_KO(rotn, 1) : cA + PG8_KO(rotc, t + 3); const char* b3 = last ? nB + PG8_KO(rotn, 1) : cB + PG8_KO(rotc, t + 3);
            const size_t ko1 = PG8_KO(rotc, t + 1), ko2 = last ? PG8_KO(rotn, 0) : PG8_KO(rotc, t + 2), ko3 = last ? PG8_KO(rotn, 1) : PG8_KO(rotc, t + 3); (void)ko1; (void)ko2; (void)ko3;
            PG8_LDB(B0, 0, 0); PG8_LDB(B1, 0, 1); PG8_SCHED; PG8_LDA(At, 0, 0); PG8_STAGE_A(1, 1, a1 + hstepA, ko1, false);
            PG8_WAIT_V0(fw_ != 0); PG8_WAIT_L(0); PG8_BAR; PG8_MMA(0, 0, At, B0); PG8_MMA(0, 1, At, B1); PG8_BAR; PG8_SCHED;
            PG8_LDA(At, 0, 1); PG8_STAGE(PG8_SB(0, 0), b2, voffB); PG8_STAGE(PG8_SB(0, 1), b2 + hstepB, voffB); PG8_STAGE_A(0, 0, a2, ko2, last);
            PG8_WAIT_V0(fw_ != 0); PG8_WAIT_L(0); PG8_BAR; PG8_MMA(1, 0, At, B0); PG8_MMA(1, 1, At, B1); PG8_BAR; PG8_SCHED;
            if constexpr (nvm_of<Epi>::v > 0) { fw_ = 0; asm volatile("" : "+s"(fw_)); }
            PG8_LDB(B0, 1, 0); PG8_LDB(B1, 1, 1); PG8_SCHED; PG8_LDA(At, 1, 0); PG8_STAGE_A(0, 1, a2 + hstepA, ko2, last);
            PG8_WAIT_V(8); PG8_WAIT_L(0); PG8_BAR; PG8_MMA(0, 0, At, B0); PG8_MMA(0, 1, At, B1); PG8_BAR; PG8_SCHED;
            PG8_LDA(At, 1, 1); PG8_STAGE(PG8_SB(1, 0), b3, voffB); PG8_STAGE(PG8_SB(1, 1), b3 + hstepB, voffB); PG8_STAGE_A(1, 0, a3, ko3, last);
            PG8_WAIT_V(8); PG8_WAIT_L(0); PG8_BAR; PG8_MMA(1, 0, At, B0); PG8_MMA(1, 1, At, B1); PG8_BAR; PG8_SCHED;
        }
        if constexpr (ALIGN_EPI) { if (wr == 0) PG8_BAR; }
        if constexpr (I8) {
#pragma unroll
            for (int a = 0; a < 2; ++a)
#pragma unroll
                for (int b = 0; b < 2; ++b)
#pragma unroll
                    for (int m = 0; m < 4; ++m)
#pragma unroll
                        for (int n = 0; n < 2; ++n) { const v4i32_t q = __builtin_bit_cast(v4i32_t, acc[a][b][m][n]); acc[a][b][m][n] = (f32x4){(float)q[0], (float)q[1], (float)q[2], (float)q[3]}; }
        }
        E(acc, cur, wr, wc, fr, fq);
        if (!has_next) break;
#pragma unroll
        for (int a = 0; a < 2; ++a)
#pragma unroll
            for (int b = 0; b < 2; ++b)
#pragma unroll
                for (int m = 0; m < 4; ++m)
#pragma unroll
                    for (int n = 0; n < 2; ++n) acc[a][b][m][n] = (f32x4){0.f, 0.f, 0.f, 0.f};
        cur = nxt; cA = nA; cB = nB; rotc = rotn; ++ui;
        if constexpr (Sched::GATHER) { gvc[0][0] = gvn[0][0]; gvc[0][1] = gvn[0][1]; gvc[1][0] = gvn[1][0]; gvc[1][1] = gvn[1][1]; }
        if constexpr (ALIGN_EPI) { if (wr == 1) PG8_BAR; }
    }
    PG8_WAIT_V(0);
    if constexpr (!ALIGN_EPI) { if (wr == 0) PG8_BAR; }
    PG8_BAR;
#undef PG8_SA
#undef PG8_SB
#undef PG8_STAGE
#undef PG8_STAGE_A
#undef PG8_LDA
#undef PG8_LDB
#undef PG8_MMA
#undef PG8_ROT
#undef PG8_KO
#undef PG8_WAIT_V
#undef PG8_WAIT_V0
#undef PG8_WAIT_L
#undef PG8_BAR
#undef PG8_SCHED
}
}

namespace att {
typedef LAS const char* lds_cptr;
typedef short v4i16_t __attribute__((ext_vector_type(4)));
typedef float f32x2_t __attribute__((ext_vector_type(2))); typedef __bf16 bf16x2_t __attribute__((ext_vector_type(2)));
__device__ __forceinline__ int crow(int r, int hi) { return (r & 3) + 8 * (r >> 2) + 4 * hi; }
__device__ __forceinline__ void glds16(const GAS void* gsrc, unsigned lds_dst) { unsigned keep;
    asm volatile("s_mov_b32 %0, m0\n\ts_mov_b32 m0, %2\n\ts_nop 0\n\tglobal_load_lds_dwordx4 %1, off\n\ts_mov_b32 m0, %0" : "=&s"(keep) : "v"(gsrc), "s"(lds_dst) : "memory"); }
__device__ __forceinline__ void glds16s(const GAS void* sbase, unsigned voff, unsigned lds_dst) { unsigned keep;
    asm volatile("s_mov_b32 %0, m0\n\ts_mov_b32 m0, %3\n\ts_nop 0\n\tglobal_load_lds_dwordx4 %1, %2\n\ts_mov_b32 m0, %0" : "=&s"(keep) : "v"(voff), "s"(sbase), "s"(lds_dst) : "memory"); }
__device__ __forceinline__ unsigned cvtpk_s(float lo, float hi) { f32x2_t v = {lo, hi}; bf16x2_t b = __builtin_convertvector(v, bf16x2_t); return __builtin_bit_cast(unsigned, b); }
#define ATT_WAIT_BAR() asm volatile("s_waitcnt vmcnt(0) lgkmcnt(0)\n\ts_barrier" ::: "memory")
constexpr float THR = 8.0f;

template <int NQ> __device__ __forceinline__ void qk_tile(f32x16& p0, f32x16& p1, lds_cptr kslot, const bf16x8* qr, const f32x16& negm, int r32, int hi) {
    lds_cptr kb = kslot + hi * 1024 + r32 * 16;
    p0 = negm; p1 = negm;
#pragma unroll
    for (int d0 = 0; d0 < NQ; ++d0) {
        const bf16x8 b0 = *(const LAS bf16x8*)(kb + d0 * 2048);
        const bf16x8 b1 = *(const LAS bf16x8*)(kb + d0 * 2048 + 512);
        p0 = __builtin_amdgcn_mfma_f32_32x32x16_bf16(b0, qr[d0], p0, 0, 0, 0);
        p1 = __builtin_amdgcn_mfma_f32_32x32x16_bf16(b1, qr[d0], p1, 0, 0, 0);
    }
}
__device__ __forceinline__ void pv(f32x16* o, int vb, bf16x8 pa0, bf16x8 pa1, bf16x8 pa2, bf16x8 pa3) {
#pragma unroll
    for (int d0 = 0; d0 < 2; ++d0) { s16x4 lo[4], hi[4];
#pragma unroll
        for (int ks = 0; ks < 4; ++ks) {
            asm volatile("ds_read_b64_tr_b16 %0,%1 offset:%c2" : "=&v"(lo[ks]) : "v"(vb), "i"(d0 * 4096 + ks * 1024) : "memory");
            asm volatile("ds_read_b64_tr_b16 %0,%1 offset:%c2" : "=&v"(hi[ks]) : "v"(vb), "i"(d0 * 4096 + ks * 1024 + 512) : "memory"); }
        asm volatile("s_waitcnt lgkmcnt(0)" ::: "memory"); __builtin_amdgcn_sched_barrier(0);
#define PK(k) (bf16x8){lo[k][0], lo[k][1], lo[k][2], lo[k][3], hi[k][0], hi[k][1], hi[k][2], hi[k][3]}
        o[d0] = __builtin_amdgcn_mfma_f32_32x32x16_bf16(pa0, PK(0), o[d0], 0, 0, 0);
        o[d0] = __builtin_amdgcn_mfma_f32_32x32x16_bf16(pa1, PK(1), o[d0], 0, 0, 0);
        o[d0] = __builtin_amdgcn_mfma_f32_32x32x16_bf16(pa2, PK(2), o[d0], 0, 0, 0);
        o[d0] = __builtin_amdgcn_mfma_f32_32x32x16_bf16(pa3, PK(3), o[d0], 0, 0, 0);
#undef PK
    }
}
__device__ __forceinline__ void softmax_pv(f32x16& p0, f32x16& p1, float& mhat, float& l_reg, f32x16& negm, f32x16* o, bool first, LAS float* wsf, int vb, int r32, int hi) {
    float a = __builtin_fmaxf(p0[0], p1[0]);
#pragma unroll
    for (int r = 1; r < 16; ++r) a = __builtin_fmaxf(a, __builtin_fmaxf(p0[r], p1[r]));
    float rm = a;
    { auto rr = __builtin_amdgcn_permlane32_swap(__float_as_uint(rm), __float_as_uint(rm), false, false); rm = __builtin_fmaxf(__uint_as_float(rr[0]), __uint_as_float(rr[1])); }
    if (first) {
        const float dl = rm; mhat += dl;
#pragma unroll
        for (int r = 0; r < 16; ++r) { p0[r] -= dl; p1[r] -= dl; }
#pragma unroll
        for (int r = 0; r < 16; ++r) negm[r] = -mhat;
    } else if (__any(rm > THR)) {
        const float dl = __builtin_fmaxf(rm, 0.f); mhat += dl;
#pragma unroll
        for (int r = 0; r < 16; ++r) { p0[r] -= dl; p1[r] -= dl; }
#pragma unroll
        for (int r = 0; r < 16; ++r) negm[r] = -mhat;
        const float f = __builtin_amdgcn_exp2f(-dl); l_reg *= f;
        if (hi == 0) wsf[r32] = f;
        LDS_WAIT();
#pragma unroll
        for (int r = 0; r < 16; ++r) { const float fr_ = wsf[crow(r, hi)]; o[0][r] *= fr_; o[1][r] *= fr_; }
        LDS_WAIT();
    }
    float sacc = 0.f;
#pragma unroll
    for (int r = 0; r < 16; ++r) { p0[r] = __builtin_amdgcn_exp2f(p0[r]); p1[r] = __builtin_amdgcn_exp2f(p1[r]); sacc += p0[r] + p1[r]; }
    l_reg += sacc;
    u32x4 pw0, pw1, pw2, pw3;
    pw0 = (u32x4){cvtpk_s(p0[0], p0[1]), cvtpk_s(p0[2], p0[3]), cvtpk_s(p0[4], p0[5]), cvtpk_s(p0[6], p0[7])};
    pw1 = (u32x4){cvtpk_s(p0[8], p0[9]), cvtpk_s(p0[10], p0[11]), cvtpk_s(p0[12], p0[13]), cvtpk_s(p0[14], p0[15])};
    pw2 = (u32x4){cvtpk_s(p1[0], p1[1]), cvtpk_s(p1[2], p1[3]), cvtpk_s(p1[4], p1[5]), cvtpk_s(p1[6], p1[7])};
    pw3 = (u32x4){cvtpk_s(p1[8], p1[9]), cvtpk_s(p1[10], p1[11]), cvtpk_s(p1[12], p1[13]), cvtpk_s(p1[14], p1[15])};
    pv(o, vb, __builtin_bit_cast(bf16x8, pw0), __builtin_bit_cast(bf16x8, pw1), __builtin_bit_cast(bf16x8, pw2), __builtin_bit_cast(bf16x8, pw3));
}
__device__ __forceinline__ void softmax_pv_fixed(f32x16& p0, f32x16& p1, float& l_reg, f32x16* o, int vb) {
    float sacc = 0.f;
#pragma unroll
    for (int r = 0; r < 16; ++r) { p0[r] = __builtin_amdgcn_exp2f(p0[r]); p1[r] = __builtin_amdgcn_exp2f(p1[r]); sacc += p0[r] + p1[r]; }
    l_reg += sacc;
    u32x4 pw0, pw1, pw2, pw3;
    pw0 = (u32x4){cvtpk_s(p0[0], p0[1]), cvtpk_s(p0[2], p0[3]), cvtpk_s(p0[4], p0[5]), cvtpk_s(p0[6], p0[7])};
    pw1 = (u32x4){cvtpk_s(p0[8], p0[9]), cvtpk_s(p0[10], p0[11]), cvtpk_s(p0[12], p0[13]), cvtpk_s(p0[14], p0[15])};
    pw2 = (u32x4){cvtpk_s(p1[0], p1[1]), cvtpk_s(p1[2], p1[3]), cvtpk_s(p1[4], p1[5]), cvtpk_s(p1[6], p1[7])};
    pw3 = (u32x4){cvtpk_s(p1[8], p1[9]), cvtpk_s(p1[10], p1[11]), cvtpk_s(p1[12], p1[13]), cvtpk_s(p1[14], p1[15])};
    pv(o, vb, __builtin_bit_cast(bf16x8, pw0), __builtin_bit_cast(bf16x8, pw1), __builtin_bit_cast(bf16x8, pw2), __builtin_bit_cast(bf16x8, pw3));
}
__device__ __forceinline__ void store_o(const f32x16* o, float l_reg, LAS float* wsf, LAS bf16_t* stg, GAS bf16_t* Ow, int pitch, int lane, int r32, int hi) {
    { auto rr = __builtin_amdgcn_permlane32_swap(__float_as_uint(l_reg), __float_as_uint(l_reg), false, false); l_reg = __uint_as_float(rr[0]) + __uint_as_float(rr[1]); }
    if (hi == 0) wsf[32 + r32] = l_reg;
    LDS_WAIT();
    float rli[16];
#pragma unroll
    for (int r = 0; r < 16; ++r) rli[r] = __builtin_amdgcn_rcpf(wsf[32 + crow(r, hi)]);
#pragma unroll
    for (int r = 0; r < 16; ++r) { const int orow = crow(r, hi);
#pragma unroll
        for (int d0 = 0; d0 < 2; ++d0) stg[orow * 64 + d0 * 32 + r32] = (bf16_t)(cvt_pk_bf16(o[d0][r] * rli[r], 0.f) & 0xffffu); }
    LDS_WAIT();
#pragma unroll
    for (int i = 0; i < 4; ++i) { const int row = i * 8 + (lane >> 3), ch = lane & 7; const u32x4 v = *(const LAS u32x4*)(stg + row * 64 + ch * 8); *(GAS u32x4*)(Ow + (size_t)row * pitch + ch * 8) = v; }
    LDS_WAIT();
}

constexpr int M_NS = 4, M_KSLOT = 12288, M_VSLOT = 8192, M_LK = 0, M_LV = M_NS * M_KSLOT, M_LWS = M_LV + M_NS * M_VSLOT, M_LOST = M_LWS + 2048, M_LDS = M_LOST + 32768;
#define ATT_WAITN_BAR(N) asm volatile("s_waitcnt vmcnt(" #N ") lgkmcnt(0)\n\ts_barrier" ::: "memory")
__device__ __forceinline__ void mla_load_q(bf16x8 (&qr)[6], const GAS bf16_t* Qrow, const GAS float* gbq, const GAS float* rope, int pos, int hi) {
#pragma unroll
    for (int d0 = 0; d0 < 6; ++d0) qr[d0] = *(const GAS bf16x8*)(Qrow + d0 * 16 + hi * 8);
    float f[6][8]; float ss = 0.f;
#pragma unroll
    for (int d0 = 0; d0 < 6; ++d0) { const u32x4 w = __builtin_bit_cast(u32x4, qr[d0]);
        f[d0][0] = bflo(w.x); f[d0][1] = bfhi(w.x); f[d0][2] = bflo(w.y); f[d0][3] = bfhi(w.y); f[d0][4] = bflo(w.z); f[d0][5] = bfhi(w.z); f[d0][6] = bflo(w.w); f[d0][7] = bfhi(w.w);
#pragma unroll
        for (int j = 0; j < 8; ++j) ss += f[d0][j] * f[d0][j]; }
    ss += __shfl_xor(ss, 32);
    const float rs = __builtin_amdgcn_rsqf(ss * (1.0f / 96.0f) + EPS) * C2B;
#pragma unroll
    for (int d0 = 0; d0 < 6; ++d0) { const f32x4 g0 = *(const GAS f32x4*)(gbq + 16 * d0 + 8 * hi), g1 = *(const GAS f32x4*)(gbq + 16 * d0 + 8 * hi + 4);
        f[d0][0] *= rs * g0.x; f[d0][1] *= rs * g0.y; f[d0][2] *= rs * g0.z; f[d0][3] *= rs * g0.w; f[d0][4] *= rs * g1.x; f[d0][5] *= rs * g1.y; f[d0][6] *= rs * g1.z; f[d0][7] *= rs * g1.w; }
    { const GAS float* rp = rope + (size_t)pos * 32 + 8 * hi; const f32x4 c0 = *(const GAS f32x4*)rp, c1 = *(const GAS f32x4*)(rp + 4), s0 = *(const GAS f32x4*)(rp + 16), s1 = *(const GAS f32x4*)(rp + 20);
      const float cs[8] = {c0.x, c0.y, c0.z, c0.w, c1.x, c1.y, c1.z, c1.w}, sn[8] = {s0.x, s0.y, s0.z, s0.w, s1.x, s1.y, s1.z, s1.w};
#pragma unroll
      for (int j = 0; j < 8; ++j) { const float a = f[4][j], c = f[5][j]; f[4][j] = a * cs[j] - c * sn[j]; f[5][j] = a * sn[j] + c * cs[j]; } }
#pragma unroll
    for (int d0 = 0; d0 < 6; ++d0) { u32x4 w; w.x = cvt_pk_bf16(f[d0][0], f[d0][1]); w.y = cvt_pk_bf16(f[d0][2], f[d0][3]); w.z = cvt_pk_bf16(f[d0][4], f[d0][5]); w.w = cvt_pk_bf16(f[d0][6], f[d0][7]); qr[d0] = __builtin_bit_cast(bf16x8, w); }
}
__device__ __forceinline__ void qk_tile2(f32x16& a0, f32x16& a1, f32x16& b0, f32x16& b1, lds_cptr kslot, const bf16x8* qa, const bf16x8* qb, int r32, int hi) {
    lds_cptr kb = kslot + hi * 1024 + r32 * 16;
    a0 = f32x16{}; a1 = f32x16{}; b0 = f32x16{}; b1 = f32x16{};
    bf16x8 k0 = *(const LAS bf16x8*)(kb), k1 = *(const LAS bf16x8*)(kb + 512);
#pragma unroll
    for (int d0 = 0; d0 < 6; ++d0) {
        bf16x8 n0 = k0, n1 = k1;
        if (d0 < 5) { n0 = *(const LAS bf16x8*)(kb + (d0 + 1) * 2048); n1 = *(const LAS bf16x8*)(kb + (d0 + 1) * 2048 + 512); }
        __builtin_amdgcn_sched_barrier(0);
        a0 = __builtin_amdgcn_mfma_f32_32x32x16_bf16(k0, qa[d0], a0, 0, 0, 0);
        a1 = __builtin_amdgcn_mfma_f32_32x32x16_bf16(k1, qa[d0], a1, 0, 0, 0);
        b0 = __builtin_amdgcn_mfma_f32_32x32x16_bf16(k0, qb[d0], b0, 0, 0, 0);
        b1 = __builtin_amdgcn_mfma_f32_32x32x16_bf16(k1, qb[d0], b1, 0, 0, 0);
        __builtin_amdgcn_sched_barrier(0);
        k0 = n0; k1 = n1;
    }
}
__device__ __forceinline__ void exp_pack(f32x16& p0, f32x16& p1, float& l_reg, bf16x8 (&pa)[4], float sub) {
    float sacc = 0.f;
    if (sub != 0.f) {
#pragma unroll
        for (int r = 0; r < 16; ++r) { p0[r] -= sub; p1[r] -= sub; } }
#pragma unroll
    for (int r = 0; r < 16; ++r) { p0[r] = __builtin_amdgcn_exp2f(p0[r]); p1[r] = __builtin_amdgcn_exp2f(p1[r]); sacc += p0[r] + p1[r]; }
    l_reg += sacc;
    pa[0] = __builtin_bit_cast(bf16x8, (u32x4){cvtpk_s(p0[0], p0[1]), cvtpk_s(p0[2], p0[3]), cvtpk_s(p0[4], p0[5]), cvtpk_s(p0[6], p0[7])});
    pa[1] = __builtin_bit_cast(bf16x8, (u32x4){cvtpk_s(p0[8], p0[9]), cvtpk_s(p0[10], p0[11]), cvtpk_s(p0[12], p0[13]), cvtpk_s(p0[14], p0[15])});
    pa[2] = __builtin_bit_cast(bf16x8, (u32x4){cvtpk_s(p1[0], p1[1]), cvtpk_s(p1[2], p1[3]), cvtpk_s(p1[4], p1[5]), cvtpk_s(p1[6], p1[7])});
    pa[3] = __builtin_bit_cast(bf16x8, (u32x4){cvtpk_s(p1[8], p1[9]), cvtpk_s(p1[10], p1[11]), cvtpk_s(p1[12], p1[13]), cvtpk_s(p1[14], p1[15])});
}
__device__ __forceinline__ void pv2(f32x16* oa, f32x16* ob, int vb, const bf16x8 (&pa)[4], const bf16x8 (&pb)[4], bool doA, bool doB) {
    s16x4 lo[2][4], hi[2][4];
#pragma unroll
    for (int d0 = 0; d0 < 2; ++d0)
#pragma unroll
        for (int ks = 0; ks < 4; ++ks) {
            asm volatile("ds_read_b64_tr_b16 %0,%1 offset:%c2" : "=&v"(lo[d0][ks]) : "v"(vb), "i"(d0 * 4096 + ks * 1024) : "memory");
            asm volatile("ds_read_b64_tr_b16 %0,%1 offset:%c2" : "=&v"(hi[d0][ks]) : "v"(vb), "i"(d0 * 4096 + ks * 1024 + 512) : "memory"); }
#define PK(d, k) (bf16x8){lo[d][k][0], lo[d][k][1], lo[d][k][2], lo[d][k][3], hi[d][k][0], hi[d][k][1], hi[d][k][2], hi[d][k][3]}
#pragma unroll
    for (int d0 = 0; d0 < 2; ++d0) {
        if (d0 == 0) asm volatile("s_waitcnt lgkmcnt(8)" ::: "memory"); else asm volatile("s_waitcnt lgkmcnt(0)" ::: "memory");
        __builtin_amdgcn_sched_barrier(0);
        if (doA) {
#pragma unroll
            for (int k = 0; k < 4; ++k) oa[d0] = __builtin_amdgcn_mfma_f32_32x32x16_bf16(pa[k], PK(d0, k), oa[d0], 0, 0, 0); }
        if (doB) {
#pragma unroll
            for (int k = 0; k < 4; ++k) ob[d0] = __builtin_amdgcn_mfma_f32_32x32x16_bf16(pb[k], PK(d0, k), ob[d0], 0, 0, 0); }
    }
#undef PK
}
__device__ __forceinline__ void store_o8(const f32x16* o, float l_reg, LAS float* wsf, LAS unsigned char* stg, GAS unsigned char* Ow8, int pitch, int lane, int r32, int hi) {
    { auto rr = __builtin_amdgcn_permlane32_swap(__float_as_uint(l_reg), __float_as_uint(l_reg), false, false); l_reg = __uint_as_float(rr[0]) + __uint_as_float(rr[1]); }
    if (hi == 0) wsf[32 + r32] = l_reg;
    LDS_WAIT();
    float rli[16];
#pragma unroll
    for (int r = 0; r < 16; ++r) rli[r] = __builtin_amdgcn_rcpf(wsf[32 + crow(r, hi)]);
#pragma unroll
    for (int r = 0; r < 16; ++r) { const int orow = crow(r, hi);
        const int p = __builtin_amdgcn_cvt_pk_fp8_f32(o[0][r] * rli[r], o[1][r] * rli[r], 0, false);
        stg[orow * 64 + r32] = (unsigned char)(p & 0xff); stg[orow * 64 + 32 + r32] = (unsigned char)((p >> 8) & 0xff); }
    LDS_WAIT();
    { const int row = lane >> 1, hf = lane & 1; const u32x4 v0 = *(const LAS u32x4*)(stg + row * 64 + hf * 32), v1 = *(const LAS u32x4*)(stg + row * 64 + hf * 32 + 16);
      GAS unsigned char* d = Ow8 + (size_t)row * pitch + hf * 32; *(GAS u32x4*)d = v0; *(GAS u32x4*)(d + 16) = v1; }
    LDS_WAIT();
}
__device__ __forceinline__ void mla_unit(int b, int h, int qb, const GAS bf16_t* Q, const GAS bf16_t* K, const GAS bf16_t* V, GAS bf16_t* O, char* shm, float mfix, const GAS float* gbq, const GAS float* rope) {
    int tid_ = threadIdx.x; asm volatile("" : "+v"(tid_));
    const int tid = tid_, lane = tid & 63, r32 = lane & 31, hi = lane >> 5; const int wid = __builtin_amdgcn_readfirstlane(tid >> 6);
    const long rowbase = (long)b * SEQ; const int q0 = qb * 512;
    const unsigned lds0 = (unsigned)(uintptr_t)shm;
    const lds_cptr shm3 = (lds_cptr)shm;
    LAS float* wsf = (LAS float*)(shm3 + M_LWS) + wid * 64;
    const GAS bf16_t* Kb = K + (size_t)((b * 8 + h) * 64) * 12 * 512; const GAS bf16_t* Vb = V + rowbase * 1024 + h * 128 + 64;
    const unsigned kof0 = (unsigned)(lane * 8) * 2u;
    const unsigned vof = (unsigned)((16 * (wid & 3) + (lane >> 2)) * 1024 + (wid >> 2) * 32 + (lane & 3) * 8) * 2u;
    const int vb0 = (int)(lds0 + M_LV) + ((lane >> 4) & 1) * 32 + (lane & 3) * 8 + (4 * hi + ((lane & 15) >> 2)) * 64;
#define MLA_DMA(t, s) do { const GAS bf16_t* kt_ = Kb + (size_t)(t) * 12 * 512; const GAS bf16_t* vt_ = Vb + (size_t)(t) * 64 * 1024; \
        glds16s(kt_ + wid * 512, kof0, (unsigned)__builtin_amdgcn_readfirstlane(lds0 + M_LK + (s) * M_KSLOT + wid * 1024)); \
        glds16s(kt_ + (8 + (wid & 3)) * 512, kof0, (unsigned)__builtin_amdgcn_readfirstlane(lds0 + M_LK + (s) * M_KSLOT + (8 + (wid & 3)) * 1024)); \
        glds16s(vt_, vof, (unsigned)__builtin_amdgcn_readfirstlane(lds0 + M_LV + (s) * M_VSLOT + wid * 1024)); } while (0)
    const int NT = 8 * (qb + 1);
    MLA_DMA(0, 0); MLA_DMA(1, 1); MLA_DMA(2, 2);
    bf16x8 qa[6], qbb[6];
    mla_load_q(qa, Q + (rowbase + q0 + wid * 64 + r32) * 768 + h * 96, gbq, rope, q0 + wid * 64 + r32, hi);
    mla_load_q(qbb, Q + (rowbase + q0 + wid * 64 + 32 + r32) * 768 + h * 96, gbq, rope, q0 + wid * 64 + 32 + r32, hi);
    float la = 0.f, lb = 0.f; f32x16 oa[2], ob[2]; oa[0] = f32x16{}; oa[1] = f32x16{}; ob[0] = f32x16{}; ob[1] = f32x16{};
    const float sub = __builtin_fmaxf(mfix - 40.0f, 0.0f);
    const int qrelA = wid * 64 + r32, qrelB = qrelA + 32;
    const int NTw = NT - 7 + wid;
    for (int t = 0; t < NT; ++t) {
        const int rem = NT - 1 - t;
        if (rem >= 2) ATT_WAITN_BAR(6); else if (rem == 1) ATT_WAITN_BAR(3); else ATT_WAITN_BAR(0);
        if (t + 3 < NT) MLA_DMA(t + 3, (t + 3) & 3);
        if (t >= NTw) continue;
        const int s = t & 3, jb = t - (NT - 8);
        const bool liveA = !(jb >= 0 && 64 * jb > 64 * wid + 31);
        f32x16 pA0, pA1, pB0, pB1;
        qk_tile2(pA0, pA1, pB0, pB1, shm3 + M_LK + s * M_KSLOT, qa, qbb, r32, hi);
        if (jb >= 0) { const int kb = 64 * jb + 4 * hi;
#pragma unroll
            for (int r = 0; r < 16; ++r) { const int kv = kb + (r & 3) + 8 * (r >> 2);
                if (kv > qrelA) pA0[r] = -INFINITY; if (kv + 32 > qrelA) pA1[r] = -INFINITY; if (kv > qrelB) pB0[r] = -INFINITY; if (kv + 32 > qrelB) pB1[r] = -INFINITY; } }
        bf16x8 pa[4], pb[4];
        if (liveA) exp_pack(pA0, pA1, la, pa, sub);
        exp_pack(pB0, pB1, lb, pb, sub);
        pv2(oa, ob, vb0 + s * M_VSLOT, pa, pb, liveA, true);
    }
    store_o8(oa, la, wsf, (LAS unsigned char*)(shm3 + M_LOST) + wid * 4096, (GAS unsigned char*)O + (rowbase + q0 + wid * 64) * 1024 + 512 + h * 64, 1024, lane, r32, hi);
    store_o8(ob, lb, wsf, (LAS unsigned char*)(shm3 + M_LOST) + wid * 4096, (GAS unsigned char*)O + (rowbase + q0 + wid * 64 + 32) * 1024 + 512 + h * 64, 1024, lane, r32, hi);
    ATT_WAIT_BAR();
#undef MLA_DMA
}

constexpr int S_LK = 0, S_LV = 32768, S_LBIAS = 65536, S_LWS = S_LBIAS + 4096, S_LOST = S_LWS + 2048, S_LDS = S_LOST + 32768;
__device__ __forceinline__ void swa_unit(int b, int n, int g, const GAS bf16_t* P, GAS bf16_t* O, const GAS float* sinks, char* shm, float sbound) {
    int tid_ = threadIdx.x; asm volatile("" : "+v"(tid_));
    const int tid = tid_, lane = tid & 63, r32 = lane & 31, hi = lane >> 5; const int wid = __builtin_amdgcn_readfirstlane(tid >> 6);
    const unsigned lds0 = (unsigned)(uintptr_t)shm;
    const lds_cptr shm3 = (lds_cptr)shm;
    LAS float* wsf = (LAS float*)(shm3 + S_LWS) + wid * 64;
    const LAS float* biasl = (const LAS float*)(shm3 + S_LBIAS);
    const long kb0 = (long)b * SEQ + 128 * (n - 1);
    const int tt0 = (n == 0) ? 2 : 0;
    for (int tt = tt0; tt < 4; ++tt) {
        glds16(P + (kb0 + 64 * tt + lane) * NPROJ1 + C_KA + 64 * g + wid * 8, (unsigned)__builtin_amdgcn_readfirstlane(lds0 + S_LK + tt * 8192 + wid * 1024));
        glds16(P + (kb0 + 64 * tt + 16 * (wid & 3) + (lane >> 2)) * NPROJ1 + C_VA + 64 * g + (wid >> 2) * 32 + (lane & 3) * 8, (unsigned)__builtin_amdgcn_readfirstlane(lds0 + S_LV + tt * 8192 + wid * 1024));
    }
    const int vb0 = (int)(lds0 + S_LV) + ((lane >> 4) & 1) * 32 + (lane & 3) * 8 + (4 * hi + ((lane & 15) >> 2)) * 64;
    ATT_WAIT_BAR();
    for (int pass = 0; pass < 2; ++pass) {
        const int bq = wid + 8 * pass, hg = bq >> 2, j = bq & 3, head = 4 * g + hg;
        const long qrow0 = (long)b * SEQ + 128 * n + 32 * j;
        bf16x8 qr[4];
        { const GAS bf16_t* Qw = P + (qrow0 + r32) * NPROJ1 + C_QA + 64 * head + hi * 8;
#pragma unroll
          for (int d0 = 0; d0 < 4; ++d0) qr[d0] = *(const GAS bf16x8*)(Qw + d0 * 16); }
        const float sink2 = sinks[head] * LOG2E, mfix = __builtin_fmaxf(sbound, sink2);
        float l_reg = (hi == 0) ? __builtin_amdgcn_exp2f(sink2 - mfix) : 0.0f; f32x16 o[2]; o[0] = f32x16{}; o[1] = f32x16{}; f32x16 negm;
#pragma unroll
        for (int r = 0; r < 16; ++r) negm[r] = -mfix;
        const int ts = (j < 2) ? 0 : 1;
        for (int tt = ts; tt < ts + 3; ++tt) {
            if (tt < tt0) continue;
            f32x16 p0, p1;
            qk_tile<4>(p0, p1, shm3 + S_LK + tt * 8192, qr, negm, r32, hi);
            const int dbase = 32 * j + r32 + 128 - 64 * tt - 4 * hi;
#pragma unroll
            for (int r = 0; r < 16; ++r) { const int d0_ = dbase - ((r & 3) + 8 * (r >> 2)), d1_ = d0_ - 32;
                const float b0 = biasl[head * 128 + (d0_ & 127)], b1 = biasl[head * 128 + (d1_ & 127)];
                p0[r] = (d0_ >= 0 && d0_ < 128) ? p0[r] + b0 : -INFINITY;
                p1[r] = (d1_ >= 0 && d1_ < 128) ? p1[r] + b1 : -INFINITY; }
            softmax_pv_fixed(p0, p1, l_reg, o, vb0 + tt * 8192);
        }
        store_o8(o, l_reg, wsf, (LAS unsigned char*)(shm3 + S_LOST) + wid * 4096, (GAS unsigned char*)O + qrow0 * 1024 + 64 * head, 1024, lane, r32, hi);
    }
    ATT_WAIT_BAR();
}
}

#define XB_TMO      128
#define XB_XCNT(j)  (256  + 64 * (j))
#define XB_XSUB(j)  (1280 + 64 * (j))
#define XB_XGEN(j)  (2304 + 64 * (j))
#define XB_TOP      3328
#define XB_TOPGEN   3392
#define XCD_BAR_WORDS 3456
#define XB_SPIN_CAP (1u << 22)
__device__ __forceinline__ unsigned xb_ld(unsigned* p)              { return __hip_atomic_load(p, __ATOMIC_RELAXED, __HIP_MEMORY_SCOPE_AGENT); }
__device__ __forceinline__ unsigned xb_add(unsigned* p, unsigned v) { return __hip_atomic_fetch_add(p, v, __ATOMIC_RELAXED, __HIP_MEMORY_SCOPE_AGENT); }
__device__ __forceinline__ unsigned xb_xcc_id() { return (unsigned)__builtin_amdgcn_s_getreg((3 << 11) | 20) & 0xFu; }
#define XB_SPIN(cond, bar) do { unsigned _sp = 0; while (cond) { __builtin_amdgcn_s_sleep(1); \
    if ((++_sp & 255u) == 0u) { if (xb_ld(&(bar)[XB_TMO])) break; if (_sp > XB_SPIN_CAP) { atomicAdd(&(bar)[XB_TMO], 1u); break; } } } } while (0)
struct XcdBarrier { unsigned* bar; unsigned x; volatile LAS unsigned* st; };
__device__ __forceinline__ XcdBarrier xcd_barrier_post(unsigned* bar, volatile LAS unsigned* st) {
    XcdBarrier b; b.bar = bar; b.x = xb_xcc_id(); b.st = st;
    if (threadIdx.x == 0) (void)xb_add(&bar[XB_XCNT(b.x)], 1u);
    return b;
}
__device__ __forceinline__ void xcd_barrier_complete(unsigned* bar, unsigned x, unsigned& nloc, unsigned& nx) {
    const unsigned G = gridDim.x * gridDim.y * gridDim.z;
    unsigned sum, cnt, mine, sp = 0u;
    for (;;) {
        sum = 0u; cnt = 0u; mine = 0u;
#pragma unroll
        for (unsigned j = 0; j < 16; ++j) { const unsigned c = xb_ld(&bar[XB_XCNT(j)]); sum += c; cnt += (c > 0u) ? 1u : 0u; mine = (j == x) ? c : mine; }
        if (sum == G) break;
        __builtin_amdgcn_s_sleep(1);
        if ((++sp & 255u) == 0u) { if (xb_ld(&bar[XB_TMO])) break; if (sp > XB_SPIN_CAP) { atomicAdd(&bar[XB_TMO], 1u); break; } }
    }
    nloc = mine > 0u ? mine : 1u; nx = cnt > 0u ? cnt : 1u;
}
__device__ __forceinline__ void xcd_barrier(const XcdBarrier& b) {
    asm volatile("s_waitcnt vmcnt(0)" ::: "memory");
    __syncthreads();
    if (threadIdx.x == 0) {
        unsigned* bar = b.bar;
        __builtin_amdgcn_s_waitcnt(0);
        unsigned nloc = b.st[0], nx = b.st[1];
        if (nloc == 0u) { xcd_barrier_complete(bar, b.x, nloc, nx); b.st[0] = nloc; b.st[1] = nx; }
        const unsigned old = xb_add(&bar[XB_XSUB(b.x)], 1u);
        const unsigned gen = old / nloc;
        if (old + 1u == (gen + 1u) * nloc) {
            __builtin_amdgcn_fence(__ATOMIC_RELEASE, "agent");
            asm volatile("s_waitcnt vmcnt(0)" ::: "memory");
            const unsigned og = xb_add(&bar[XB_TOP], 1u);
            const unsigned tg = og / nx;
            if (og + 1u == (tg + 1u) * nx) xb_add(&bar[XB_TOPGEN], 1u);
            else XB_SPIN(xb_ld(&bar[XB_TOPGEN]) == tg, bar);
            __builtin_amdgcn_fence(__ATOMIC_ACQUIRE, "agent");
            xb_add(&bar[XB_XGEN(b.x)], 1u);
            asm volatile("s_waitcnt vmcnt(0)" ::: "memory");
        } else {
            XB_SPIN(xb_ld(&bar[XB_XGEN(b.x)]) == gen, bar);
            __builtin_amdgcn_fence(__ATOMIC_ACQUIRE, "agent");
            asm volatile("s_waitcnt vmcnt(0)" ::: "memory");
        }
    }
    __syncthreads();
}

enum { MAP_NAT = 0, MAP_GU = 1, MAP_ROUTER = 2 };
template <int Q8 = 0> __device__ __forceinline__ void cvt_item(const GAS float* sp, int ns, const GAS float* gain, GAS bf16_t* dst, int ldd, int k0, int n0, LAS float* scr, int lane, float qs = 1.f) {
    { float vv[32], gg[32];
#pragma unroll
      for (int i = 0; i < 32; ++i) { const int kk = 2 * i + (lane >> 5); vv[i] = sp ? sp[(size_t)(k0 + kk) * ns] : 0.f; gg[i] = gain ? gain[k0 + kk] : 1.f; }
#pragma unroll
      for (int i = 0; i < 32; ++i) { const int kk = 2 * i + (lane >> 5); scr[kk * 33 + (lane & 31)] = vv[i] * gg[i]; } }
    LDS_WAIT(); asm volatile("" ::: "memory");
    const int ch = lane & 7;
#pragma unroll
    for (int j = 0; j < 4; ++j) { const int n = (lane >> 3) + 8 * j; const LAS float* s = scr + (8 * ch) * 33 + n;
        if constexpr (Q8 == 2) { u32x2 o; o.x = pk4_fp8(s[0 * 33] * qs, s[1 * 33] * qs, s[2 * 33] * qs, s[3 * 33] * qs); o.y = pk4_fp8(s[4 * 33] * qs, s[5 * 33] * qs, s[6 * 33] * qs, s[7 * 33] * qs);
            *(GAS u32x2*)((GAS unsigned char*)dst + (size_t)(n0 + n) * ldd + k0 + 8 * ch) = o; }
        else if constexpr (Q8 == 1) { u32x2 o; o.x = pk4_i8(s[0 * 33], s[1 * 33], s[2 * 33], s[3 * 33], qs); o.y = pk4_i8(s[4 * 33], s[5 * 33], s[6 * 33], s[7 * 33], qs);
            *(GAS u32x2*)((GAS unsigned char*)dst + (size_t)(n0 + n) * ldd + k0 + 8 * ch) = o; }
        else { u32x4 o; o.x = cvt_pk_bf16(s[0 * 33], s[1 * 33]); o.y = cvt_pk_bf16(s[2 * 33], s[3 * 33]); o.z = cvt_pk_bf16(s[4 * 33], s[5 * 33]); o.w = cvt_pk_bf16(s[6 * 33], s[7 * 33]);
            *(GAS u32x4*)(dst + (size_t)(n0 + n) * ldd + k0 + 8 * ch) = o; } }
    LDS_WAIT(); asm volatile("" ::: "memory");
}
template <int Q8 = 0> __device__ __forceinline__ void cvt_nat(const GAS float* src, int Nsrc, int coff, int nvalid, const GAS float* gain, GAS bf16_t* dst, int K, int Ndst, int item, LAS float* scr, int lane, float qs = 1.f) {
    const int nblk = Ndst / 32, kb = item / nblk, nb = item % nblk, n0 = 32 * nb, np = n0 + (lane & 31);
    cvt_item<Q8>(np < nvalid ? src + coff + np : nullptr, Nsrc, gain, dst, K, 64 * kb, n0, scr, lane, qs);
}

struct Args { const GAS float* in[25]; GAS float* out; unsigned char* ws; int ph_lo, ph_hi; };
constexpr int NPH_LAYER = 15, NPHASES = 1 + 2 * NPH_LAYER;

__global__ void __launch_bounds__(512, 2) fwd(Args args) {
    extern __shared__ __attribute__((aligned(16))) unsigned char lds[];
    LAS unsigned char* L = (LAS unsigned char*)lds;
    volatile LAS unsigned* MISC = (volatile LAS unsigned*)(L + MISC_OFF);
    LAS int* pend = (LAS int*)(L + MISC_OFF + 64);
    LAS int* pcnt = (LAS int*)(L + MISC_OFF + 256);
    const int tid = threadIdx.x, lane = tid & 63, wave = __builtin_amdgcn_readfirstlane(tid >> 6);
    const int G = gridDim.x, bx = blockIdx.x;
    const int vcu = (G % 8 == 0) ? (bx % 8) * (G / 8) + bx / 8 : bx;
    const int gw = vcu * 8 + wave, NGW = G * 8;
    typedef __attribute__((address_space(4))) const unsigned long long* karg_t;
    const karg_t ka0 = (karg_t)__builtin_amdgcn_kernarg_segment_ptr();
    unsigned char* ws = (unsigned char*)ka0[26];
    unsigned* ctl = (unsigned*)(ws + WS_CTL);
    for (int u = tid; u < 256; u += 512) ((LAS unsigned*)(L + MISC_OFF))[u] = 0u;
    __syncthreads();
#if ONE_LAUNCH
    XcdBarrier bar = xcd_barrier_post(ctl + CW_BAR, MISC);
#define GRID_BAR() xcd_barrier(bar)
#else
#define GRID_BAR() do {} while (0)
#endif
    const int lo = args.ph_lo, hi = args.ph_hi;
#ifndef PHONLY
#define PHONLY -1
#endif
#define PHSEL(k) (PHONLY < 0 || (((k) == 0 ? 0 : (((k) - 1) % 15) + 1)) == PHONLY)
#define IN(k) (PHSEL(k) && lo <= (k) && (k) < hi)
#define SEAM(k) do { if (IN(k) && IN((k) + 1)) GRID_BAR(); } while (0)
#define PH_BEGIN int tid = threadIdx.x; asm volatile("" : "+v"(tid)); const int lane = tid & 63; (void)lane; karg_t ka = ka0; asm volatile("" : "+s"(ka)); unsigned char* lw = (unsigned char*)ka[26]; GAS float* out = (GAS float*)ka[25]; (void)lw; (void)out;
#define INP(k) ((const GAS float*)ka[k])
#define SSQX ((GAS float*)(lw + WS_SSQX))
#define SSQP ((GAS float*)(lw + WS_SSQP))
#define WMAXP ((GAS float*)(lw + WS_SSQP))
#define WABSV ((GAS float*)(lw + 7 * MiB))
#define XSC ((GAS float*)(lw + WS_RSMID))
#define ROPE ((GAS float*)(lw + WS_ROPE))
#define ASE ((GAS int*)(lw + WS_ASE))
#define ASP ((GAS int*)(lw + WS_ASP))
#define ASW ((GAS float*)(lw + WS_ASW))
#define MY ((GAS int*)(lw + WS_MY))
#define MW ((GAS float*)(lw + WS_MW))
#define MRS ((GAS float*)(lw + WS_MRS))
#define LOGITS ((GAS float*)(lw + WS_LOGITS))
#define PCQ ((GAS float*)(lw + WS_LOGITS))
#define PCKV ((GAS float*)(lw + WS_LOGITS + MiB))
#define PKPE ((GAS float*)(lw + WS_LOGITS + 2 * MiB))
#define XB ((GAS bf16_t*)(lw + WS_XB))
#define XB8 ((GAS unsigned char*)(lw + WS_XB8))
#define PROJ1 ((GAS bf16_t*)(lw + WS_PROJ1))
#define QB ((GAS bf16_t*)(lw + WS_QB))
#define KVB ((GAS bf16_t*)(lw + WS_KVB))
#define KB ((GAS bf16_t*)(lw + WS_KB))
#define OB ((GAS bf16_t*)(lw + WS_O))
#define GATES ((GAS bf16_t*)(lw + WS_GATES))
#define MB ((GAS bf16_t*)(lw + WS_M))
#define XM8 ((GAS unsigned char*)(lw + WS_XR))
#define TAB ((GAS int*)(lw + WS_XR + 64 * MiB))
#define ACT ((GAS bf16_t*)(lw + WS_ACT))
#define YBUF ((GAS bf16_t*)(lw + WS_YBUF))

    if (IN(0)) {
        PH_BEGIN
        {
          float mx_in0 = 0.f, mx_in1 = 0.f;
          { const int l = gw >> 10, k = gw & 1023;
            for (int rr = gw; rr < 2048; rr += NGW) { const int l2 = rr >> 10, k2 = rr & 1023; const GAS float* row = INP(2) + ((size_t)l2 * 1024 + k2) * IN_COLS; float mx = 0.f;
                for (int c = lane * 4; c < IN_COLS; c += 256) { const f32x4 q = *(const GAS f32x4*)(row + c); mx = __builtin_fmaxf(mx, __builtin_fmaxf(__builtin_fmaxf(__builtin_fabsf(q.x), __builtin_fabsf(q.y)), __builtin_fmaxf(__builtin_fabsf(q.z), __builtin_fabsf(q.w)))); }
                mx = wave_max(mx) * __builtin_fabsf(INP(1)[l2 * 1024 + k2]);
                if (l2 == 0) mx_in0 = __builtin_fmaxf(mx_in0, mx); else mx_in1 = __builtin_fmaxf(mx_in1, mx); }
            (void)l; (void)k; }
          for (int l2 = 0; l2 < 2; ++l2) { float mxw = 0.f;
            for (int r0 = gw * 4; r0 < 2 * NEXP * 1024; r0 += NGW * 4) { f32x4 q[4];
#pragma unroll
                for (int r = 0; r < 4; ++r) { const int rr = r0 + r, which = rr >> 15, ek = rr & 32767; q[r] = ((const GAS f32x4*)((which ? INP(23) : INP(22)) + ((size_t)l2 * NEXP * 1024 + ek) * 256) + lane)[0]; }
#pragma unroll
                for (int r = 0; r < 4; ++r) { const int k2 = (r0 + r) & 1023; const float g = __builtin_fabsf(INP(17)[l2 * 1024 + k2]);
                    mxw = __builtin_fmaxf(mxw, g * __builtin_fmaxf(__builtin_fmaxf(__builtin_fabsf(q[r].x), __builtin_fabsf(q[r].y)), __builtin_fmaxf(__builtin_fabsf(q[r].z), __builtin_fabsf(q[r].w)))); } }
            mxw = wave_max(mxw);
            if (lane == 0) WMAXP[(l2 * 2 + 1) * 2048 + gw] = mxw; }
          if (lane == 0) { WMAXP[0 * 2048 + gw] = mx_in0; WMAXP[2 * 2048 + gw] = mx_in1; } }
        { const GAS float* x_in = INP(0);
        for (int m0 = gw * 8; m0 < T; m0 += NGW * 8) {
            f32x4 v[8][4];
#pragma unroll
            for (int r = 0; r < 8; ++r)
#pragma unroll
                for (int j = 0; j < 4; ++j) v[r][j] = ((const GAS f32x4*)(x_in + (size_t)(m0 + r) * DM) + lane)[64 * j];
#pragma unroll
            for (int r = 0; r < 8; ++r) { float s = 0.f, mx = 0.f;
#pragma unroll
                for (int j = 0; j < 4; ++j) { const f32x4 q = v[r][j]; s += (q.x * q.x + q.y * q.y) + (q.z * q.z + q.w * q.w);
                    mx = __builtin_fmaxf(mx, __builtin_fmaxf(__builtin_fmaxf(__builtin_fabsf(q.x), __builtin_fabsf(q.y)), __builtin_fmaxf(__builtin_fabsf(q.z), __builtin_fabsf(q.w))));
                    }
                s = wave_sum(s); mx = wave_max(mx); mx = mx > 0.f ? mx : 1.f; const float qs = 127.0f / mx;
#pragma unroll
                for (int j = 0; j < 4; ++j) { const f32x4 q = v[r][j]; ((GAS unsigned*)(XB8 + (size_t)(m0 + r) * DM) + lane)[64 * j] = pk4_i8(q.x, q.y, q.z, q.w, qs); }
                if (lane == 0) { SSQX[m0 + r] = s; XSC[m0 + r] = mx * (1.0f / 127.0f); } }
        } }
        for (int e = bx * 512 + tid; e < SEQ * 16; e += G * 512) { const int pos = e >> 4, i = e & 15;
            const int i4 = i & 3; const double m4 = (i4 == 0) ? 1.0 : (i4 == 1) ? 0.5623413251903491 : (i4 == 2) ? 0.31622776601683794 : 0.1778279410038923;
            const int i16 = i >> 2; const double d4 = (i16 == 0) ? 1.0 : (i16 == 1) ? 0.1 : (i16 == 2) ? 0.01 : 0.001;
            const float ang = (float)pos * (float)(m4 * d4);
            double rev = (double)ang * 0.15915494309189535; rev -= __builtin_rint(rev); const float fr_ = (float)rev;
            ROPE[pos * 32 + i] = __builtin_amdgcn_cosf(fr_); ROPE[pos * 32 + 16 + i] = __builtin_amdgcn_sinf(fr_); }
            GRID_BAR();
        float wabs[4];
#pragma unroll
        for (int q = 0; q < 4; ++q) { float m = 0.f; for (int i = lane; i < NGW; i += 64) m = __builtin_fmaxf(m, WMAXP[q * 2048 + i]); m = wave_max(m); wabs[q] = m > 0.f ? m : 1.f; }
        if (bx == 0 && tid == 0) { WABSV[0] = wabs[0]; WABSV[1] = wabs[1]; WABSV[2] = wabs[2]; WABSV[3] = wabs[3]; }
#define WDQ(l_, t_) (WABSV[2 * (l_) + (t_)] * (1.0f / 127.0f))
#define WQS(l_, t_) (127.0f / wabs[2 * (l_) + (t_)])
        const float qs_in0 = WQS(0, 0), qs_in1 = WQS(1, 0), qs_gu0 = WQS(0, 1), qs_gu1 = WQS(1, 1);
        LAS float* scr = (LAS float*)(L + wave * 16384);
        constexpr int I_WIN1 = 16 * 40, I_WG = 16 * 64, I_WQB = 4 * 24, I_WKVB = 2 * 32, I_WOA = 8 * 32, I_WO = 16 * 32, I_WR = 16 * 8, I_WGU = 32 * 16 * 16, I_WD = 32 * 4 * 32;
        constexpr int NIT = I_WIN1 + I_WG + I_WQB + I_WKVB + 2 * I_WOA + I_WO + I_WR + I_WGU + I_WD;
        for (int it = gw; it < 2 * NIT; it += NGW) {
            const int l = it >= NIT ? 1 : 0; int r = it - l * NIT;
            if (r < I_WIN1) {
                const int kb = r / 40, nb = r % 40, n0 = 32 * nb, np = n0 + (lane & 31);
                int sc_ = np; if (np < 768) { const int pn = np >> 8, q = np & 255; sc_ = 64 * (4 * pn + ((q >> 5) & 3)) + 32 * (q >> 7) + (q & 31); }
                cvt_item<1>(np < C_GATE ? INP(2) + (size_t)l * 1024 * IN_COLS + sc_ : nullptr, IN_COLS, INP(1) + l * 1024, (GAS bf16_t*)(lw + WS_WIN1 + (size_t)l * 1280 * 1024), 1024, 64 * kb, n0, scr, lane, (l ? qs_in1 : qs_in0)); continue; } r -= I_WIN1;
            if (r < I_WG) {
                const int kb = r / 64, nb = r % 64, n0 = 32 * nb, np = n0 + (lane & 31);
                const int q = np >> 8, p = np & 255, cc = 128 * q + (p & 127) + ((p >> 7) ? 1024 : 0);
                cvt_item<1>(INP(2) + (size_t)l * 1024 * IN_COLS + C_GATE + cc, IN_COLS, INP(1) + l * 1024, (GAS bf16_t*)(lw + WS_WG + (size_t)l * 2048 * 1024), 1024, 64 * kb, n0, scr, lane, (l ? qs_in1 : qs_in0)); continue; } r -= I_WG;
            if (r < I_WQB) { cvt_nat(INP(10) + (size_t)l * 256 * 768, 768, 0, 768, INP(9) + l * 256, (GAS bf16_t*)(lw + WS_WQB) + (size_t)l * 768 * 256, 256, 768, r, scr, lane); continue; } r -= I_WQB;
            if (r < I_WKVB) {
                const int kb = r / 32, nb = r % 32, n0 = 32 * nb, np = n0 + (lane & 31);
                const int pn = np >> 8, q = np & 255, wc_ = (q >> 5) & 3; const int sc_ = 128 * (2 * pn + (wc_ & 1)) + 64 * (wc_ >> 1) + 32 * (q >> 7) + (q & 31);
                cvt_item(INP(12) + (size_t)l * 128 * 1024 + sc_, 1024, INP(11) + l * 128, (GAS bf16_t*)(lw + WS_WKVB) + (size_t)l * 1024 * 128, 128, 64 * kb, n0, scr, lane); continue; } r -= I_WKVB;
            if (r < 2 * I_WOA) {
                const int half = r >= I_WOA, r2 = r - half * I_WOA, kb = r2 / 32, nb = r2 % 32, n0 = 32 * nb;
                cvt_item<2>((half ? INP(15) : INP(8)) + (size_t)l * 512 * 1024 + pg8::col16_src(n0 + (lane & 31)), 1024, nullptr, (GAS bf16_t*)(lw + WS_WOA + (size_t)l * 1024 * 1024 + half * 512), 1024, 64 * kb, n0, scr, lane, W8S); continue; } r -= 2 * I_WOA;
            if (r < I_WO) { const int kb = r / 32, nb = r % 32, n0 = 32 * nb;
                cvt_item<2>(INP(16) + (size_t)l * 1024 * 1024 + pg8::col16_src(n0 + (lane & 31)), 1024, nullptr, (GAS bf16_t*)(lw + WS_WO + (size_t)l * 1024 * 1024), 1024, 64 * kb, n0, scr, lane, W8S); continue; } r -= I_WO;
            if (r < I_WR) {
                const int kb = r / 8, nb = r % 8, n0 = 32 * nb, np = n0 + (lane & 31);
                const GAS float* sp = nullptr; int ns = 32;
                if (np < 32) { sp = INP(20) + (size_t)l * 1024 * 32 + np; ns = 32; } else if (np < 36) { sp = INP(18) + (size_t)l * 1024 * 4 + (np - 32); ns = 4; }
                cvt_item(sp, ns, INP(17) + l * 1024, (GAS bf16_t*)(lw + WS_WR) + (size_t)l * 256 * 1024, 1024, 64 * kb, n0, scr, lane); continue; } r -= I_WR;
            if (r < I_WGU) {
                const int e = r / 256, r2 = r % 256, kb = r2 / 16, nb = r2 % 16, n0 = 32 * nb, np = n0 + (lane & 31);
                const int pn = np >> 8, q = np & 255, n = q >> 7;
                const int cc = 128 * pn + (q & 127);
                const GAS float* sp = (n ? INP(23) : INP(22)) + ((size_t)l * NEXP + e) * 1024 * 256 + cc;
                cvt_item<1>(sp, 256, INP(17) + l * 1024, (GAS bf16_t*)(lw + WS_WGU + ((size_t)l * NEXP + e) * 512 * 1024), 1024, 64 * kb, n0, scr, lane, (l ? qs_gu1 : qs_gu0)); continue; } r -= I_WGU;
            { const int e = r / 128; cvt_nat(INP(24) + ((size_t)l * NEXP + e) * 256 * 1024, 1024, 0, 1024, nullptr, (GAS bf16_t*)(lw + WS_WD) + ((size_t)l * NEXP + e) * 1024 * 256, 256, 1024, r % 128, scr, lane); }
        }
    }
    SEAM(0);

    for (int l = 0; l < 2; ++l) {
        const int pb = 1 + NPH_LAYER * l;
        if (IN(pb + 0)) { PH_BEGIN
            pg8::Gemm g{(const GAS bf16_t*)XB8, (const GAS bf16_t*)(lw + WS_WIN1 + (size_t)l * 1280 * 1024), 512, 512, 512}; pg8::StaticOrder S; S.init(T, NPROJ1, G, bx);
            pg8::EpiProj1 E{PROJ1, SSQX, XSC, WDQ(l, 0), INP(4) + l * 64, INP(5) + l * 64, PCQ, PCKV, PKPE};
            pg8::gemm_phase<pg8::EpiProj1, pg8::StaticOrder, true>(L, g, S, E);
        }
        SEAM(pb + 0);
        if (IN(pb + 2)) { PH_BEGIN
            { pg8::Gemm g{PROJ1 + C_CQ, (const GAS bf16_t*)(lw + WS_WQB) + (size_t)l * 768 * 256, NPROJ1, 256, 256}; pg8::StaticOrder S; S.init(T, 768, G, bx);
              pg8::EpiRowNorm4 E{QB, 768, PCQ, 1.0f / 256.0f};
              pg8::gemm_phase<pg8::EpiRowNorm4, pg8::StaticOrder>(L, g, S, E); }
            { pg8::Gemm g{PROJ1 + C_CKV, (const GAS bf16_t*)(lw + WS_WKVB) + (size_t)l * 1024 * 128, NPROJ1, 128, 128}; pg8::StaticOrder S; S.init(T, 1024, G, bx);
              pg8::EpiKv E{KB, KVB, PCKV, PKPE, PROJ1, INP(14) + l * 96, ROPE};
              pg8::gemm_phase<pg8::EpiKv, pg8::StaticOrder>(L, g, S, E); }
        }
        SEAM(pb + 2);
        if (IN(pb + 4)) { PH_BEGIN
            char* shm = (char*)lds;
            float mfixB, sboundA;
            { const GAS float* gq = INP(13) + l * 96; const GAS float* gk = INP(14) + l * 96; float a = 0.f, c = 0.f;
              for (int i = lane; i < 96; i += 64) { a = __builtin_fmaxf(a, __builtin_fabsf(gq[i])); c = __builtin_fmaxf(c, __builtin_fabsf(gk[i])); }
              a = wave_max(a); c = wave_max(c); mfixB = __uint_as_float(__builtin_amdgcn_readfirstlane(__float_as_uint(__builtin_fminf(96.0f * C2B * a * c + 0.5f, 60.0f)))); }
            { const GAS float* gq = INP(4) + l * 64; const GAS float* gk = INP(5) + l * 64; const GAS float* rel = INP(7);
              float a = __builtin_fabsf(gq[lane]), c = __builtin_fabsf(gk[lane]), bm = 0.f;
              for (int i = lane; i < 256; i += 64) bm = __builtin_fmaxf(bm, __builtin_fabsf(rel[i]));
              a = wave_max(a); c = wave_max(c); bm = wave_max(bm); sboundA = __uint_as_float(__builtin_amdgcn_readfirstlane(__float_as_uint(__builtin_fminf(64.0f * C2A * a * c + bm * LOG2E + 0.5f, 60.0f)))); }
            for (int v = vcu; v < 256; v += G) {
                const int bh = v >> 1, s0 = 2 * (v & 1);
                for (int i = 0; i < 4; ++i) { const int s = s0 + (i >> 1), qb = (i & 1) ? 7 - s : s; att::mla_unit(bh >> 3, bh & 7, qb, QB, KB, KVB, OB, shm, mfixB, INP(13) + l * 96, ROPE); }
            }
            { LAS float* biasl = (LAS float*)(L + att::S_LBIAS); const GAS float* rel = INP(7);
              for (int e = tid; e < 8 * 128; e += 512) { const int hd = e >> 7, d = e & 127; int bk = d;
                  if (d >= 16) { bk = 16 + (int)(__logf((float)d * (1.0f / 16.0f)) / 2.0794415416798357f * 16.0f); bk = bk > 31 ? 31 : bk; }
                  biasl[e] = rel[bk * 8 + hd] * LOG2E; }
              __syncthreads(); }
            for (int u = vcu; u < NB * 32 * 2; u += G) { const int g2 = u & 1, n = (u >> 1) & 31, b = u >> 6; att::swa_unit(b, n, g2, PROJ1, OB, INP(6) + l * 8, shm, sboundA); }
        }
        SEAM(pb + 4);
        if (IN(pb + 5)) { PH_BEGIN
            pg8::Gemm g{(const GAS bf16_t*)XB8, (const GAS bf16_t*)(lw + WS_WG + (size_t)l * 2048 * 1024), 512, 512, 512}; pg8::StaticOrder S; S.init(T, 2048, G, bx);
            pg8::EpiGates2 E{GATES, GATES + (size_t)T * 1024, SSQX, INP(3) + l * 2048, XSC, WDQ(l, 0)};
            pg8::gemm_phase<pg8::EpiGates2, pg8::StaticOrder, true>(L, g, S, E);
        }
        SEAM(pb + 5);
        if (IN(pb + 6)) { PH_BEGIN
            pg8::Gemm g{OB, (const GAS bf16_t*)(lw + WS_WOA + (size_t)l * 1024 * 1024), 512, 512, 512}; pg8::StaticOrder S; S.init(T, 1024, G, bx);
            pg8::EpiMerge E{MB, GATES, GATES + (size_t)T * 1024};
            pg8::gemm_phase<pg8::EpiMerge, pg8::StaticOrder, false, true, true>(L, g, S, E);
        }
        SEAM(pb + 6);
        if (IN(pb + 7)) { PH_BEGIN
            pg8::Gemm g{MB, (const GAS bf16_t*)(lw + WS_WO + (size_t)l * 1024 * 1024), 512, 512, 512}; pg8::StaticOrder S; S.init(T, 1024, G, bx);
            pg8::EpiResid E{(l == 0) ? INP(0) : (const GAS float*)nullptr, XB, SSQP};
            pg8::gemm_phase<pg8::EpiResid, pg8::StaticOrder, false, false, true>(L, g, S, E);
        }
        SEAM(pb + 7);
        if (IN(pb + 9)) { PH_BEGIN
            pg8::Gemm g{XB, (const GAS bf16_t*)(lw + WS_WR) + (size_t)l * 256 * 1024, 1024, 1024, 1024}; pg8::StaticOrder S; S.init(T, 256, G, bx);
            pg8::EpiLogits E{LOGITS, SSQP};
            pg8::gemm_phase<pg8::EpiLogits, pg8::StaticOrder>(L, g, S, E);
            VM_WAIT(); __syncthreads();
            LAS int* cnt = (LAS int*)L; LAS int* basep = cnt + 32;
            const GAS float* brg = INP(19) + l * 4; const GAS float* bre = INP(21) + l * 32;
            GAS unsigned* gcnt = (GAS unsigned*)(lw + WS_CTL) + CW_CNT + 64 * l;
            pg8::Unit ru;
            LAS float* rsc = (LAS float*)(L + 4096);
            for (int iu = 0; S.next(iu, ru); ++iu) {
                if (tid < 32) cnt[tid] = 0;
                {
                    const int wv = tid >> 6;
                    for (int rr = 0; rr < 32; rr += 4) { u32x4 v0[4], v1[4]; float rsm[4];
#pragma unroll
                        for (int r = 0; r < 4; ++r) { const int t = ru.pm * 256 + wv * 32 + rr + r; const GAS u32x4* s = (const GAS u32x4*)(XB + (size_t)t * DM) + lane; v0[r] = s[0]; v1[r] = s[64];
                            const GAS f32x4* pp = (const GAS f32x4*)(SSQP + (size_t)t * 16); const f32x4 a = pp[0], b = pp[1], c = pp[2], d = pp[3];
                            rsm[r] = __builtin_amdgcn_rsqf((((a.x + a.y) + (a.z + a.w)) + ((b.x + b.y) + (b.z + b.w)) + ((c.x + c.y) + (c.z + c.w)) + ((d.x + d.y) + (d.z + d.w))) * (1.0f / 1024.0f) + EPS); }
#pragma unroll
                        for (int r = 0; r < 4; ++r) { const int t = ru.pm * 256 + wv * 32 + rr + r; const u32x4 a = v0[r], b = v1[r];
                            const float f[16] = {bflo(a.x), bfhi(a.x), bflo(a.y), bfhi(a.y), bflo(a.z), bfhi(a.z), bflo(a.w), bfhi(a.w), bflo(b.x), bfhi(b.x), bflo(b.y), bfhi(b.y), bflo(b.z), bfhi(b.z), bflo(b.w), bfhi(b.w)};
                            float mx = 0.f;
#pragma unroll
                            for (int i = 0; i < 16; ++i) mx = __builtin_fmaxf(mx, __builtin_fabsf(f[i]));
                            mx = wave_max(mx); mx = mx > 0.f ? mx : 1.f; const float qs = 127.0f / mx;
                            u32x2 q0, q1; q0.x = pk4_i8(f[0], f[1], f[2], f[3], qs); q0.y = pk4_i8(f[4], f[5], f[6], f[7], qs); q1.x = pk4_i8(f[8], f[9], f[10], f[11], qs); q1.y = pk4_i8(f[12], f[13], f[14], f[15], qs);
                            { GAS u32x2* d = (GAS u32x2*)(XM8 + (size_t)t * DM) + lane; d[0] = q0; d[64] = q1; }
                            if (lane == 0) rsc[wv * 32 + rr + r] = rsm[r] * mx * (1.0f / 127.0f); } }
                }
                __syncthreads();
                const bool act = tid < 256; const int t = ru.pm * 256 + (tid & 255); const GAS float* lg = LOGITS + (size_t)t * 64;
                float gl[4]; float gmx = -INFINITY; int gi = 0;
#pragma unroll
                for (int q = 0; q < 4; ++q) { gl[q] = lg[32 + q] + brg[q]; if (gl[q] > gmx) { gmx = gl[q]; gi = q; } }
                float gs = 0.f;
#pragma unroll
                for (int q = 0; q < 4; ++q) gs += __expf(gl[q] - gmx);
                const float gp = 1.0f / gs;
                float el[8]; float e0 = -INFINITY; int i0 = 0;
#pragma unroll
                for (int q = 0; q < 8; ++q) { el[q] = lg[8 * gi + q] + bre[8 * gi + q]; if (el[q] > e0) { e0 = el[q]; i0 = q; } }
                float e1 = -INFINITY; int i1 = 0;
#pragma unroll
                for (int q = 0; q < 8; ++q) if (q != i0 && el[q] > e1) { e1 = el[q]; i1 = q; }
                const float w1 = 1.0f / (1.0f + __expf(e0 - e1)), w0 = 1.0f - w1;
                const int ex0 = 8 * gi + i0, ex1 = 8 * gi + i1;
                int r0 = 0, r1 = 0;
                if (act) { r0 = __hip_atomic_fetch_add(&cnt[ex0], 1, __ATOMIC_RELAXED, __HIP_MEMORY_SCOPE_WORKGROUP); r1 = __hip_atomic_fetch_add(&cnt[ex1], 1, __ATOMIC_RELAXED, __HIP_MEMORY_SCOPE_WORKGROUP); }
                __syncthreads();
                if (tid < 32) basep[tid] = (int)__hip_atomic_fetch_add(gcnt + tid, (unsigned)cnt[tid], __ATOMIC_RELAXED, __HIP_MEMORY_SCOPE_AGENT);
                __syncthreads();
                if (act) { const unsigned sb = __float_as_uint(rsc[tid]);
                    *(GAS u32x4*)(TAB + (size_t)(ex0 * MOE_CAP + basep[ex0] + r0) * 4) = (u32x4){(unsigned)t, sb, (unsigned)(2 * t), __float_as_uint(gp * w0)};
                    *(GAS u32x4*)(TAB + (size_t)(ex1 * MOE_CAP + basep[ex1] + r1) * 4) = (u32x4){(unsigned)t, sb, (unsigned)(2 * t + 1), __float_as_uint(gp * w1)}; }
                __syncthreads();
            }
        }
        SEAM(pb + 10);
        if (IN(pb + 12) || IN(pb + 13)) {
            PH_BEGIN
            if (tid == 0) { const GAS unsigned* gcnt = (const GAS unsigned*)(lw + WS_CTL) + CW_CNT + 64 * l; int acc = 0;
                for (int e = 0; e < NEXP; ++e) { const int c = (int)__hip_atomic_load(gcnt + e, __ATOMIC_RELAXED, __HIP_MEMORY_SCOPE_AGENT); acc += (c + 255) >> 8; pend[e] = acc; pcnt[e] = c; } }
            __syncthreads();
        }
        if (IN(pb + 12)) { PH_BEGIN
            pg8::Gemm g{(const GAS bf16_t*)XM8, (const GAS bf16_t*)(lw + WS_WGU + (size_t)l * NEXP * 512 * 1024), 512, 512, 512};
            pg8::MoeGather S{pend[NEXP - 1] * 2, 2, G, bx, pend, (size_t)512 * 1024, TAB, pcnt};
            pg8::EpiGateUp E{ACT, (const GAS float*)TAB, pend, pcnt, WDQ(l, 1)};
            pg8::gemm_phase<pg8::EpiGateUp, pg8::MoeGather, true>(L, g, S, E);
        }
        SEAM(pb + 12);
        if (IN(pb + 13)) { PH_BEGIN
            pg8::Gemm g{ACT, (const GAS bf16_t*)(lw + WS_WD) + (size_t)l * NEXP * 1024 * 256, 256, 256, 256};
            pg8::MoeOrder S{pend[NEXP - 1] * 4, 4, G, bx, pend, (size_t)1024 * 256 * 2, TAB, pcnt};
            pg8::EpiDown E{YBUF, TAB, pend, pcnt};
            pg8::gemm_phase<pg8::EpiDown, pg8::MoeOrder>(L, g, S, E);
        }
        SEAM(pb + 13);
        if (IN(pb + 14)) { PH_BEGIN
            for (int m0 = gw * 4; m0 < T; m0 += NGW * 4) {
                u32x2 xm[4][4], ya[4][4], yb[4][4]; f32x4 xv[4][4];
#pragma unroll
                for (int r = 0; r < 4; ++r) { const int m = m0 + r;
#pragma unroll
                    for (int j = 0; j < 4; ++j) { xm[r][j] = ((const GAS u32x2*)(XB + (size_t)m * DM) + lane)[64 * j];
                        ya[r][j] = ((const GAS u32x2*)(YBUF + (size_t)(2 * m) * DM) + lane)[64 * j]; yb[r][j] = ((const GAS u32x2*)(YBUF + (size_t)(2 * m + 1) * DM) + lane)[64 * j]; } }
#pragma unroll
                for (int r = 0; r < 4; ++r) { const int m = m0 + r; float s = 0.f, mx = 0.f;
#pragma unroll
                    for (int j = 0; j < 4; ++j) { const u32x2 x = xm[r][j], a = ya[r][j], b = yb[r][j]; f32x4 v;
                        v.x = bflo(x.x) + bflo(a.x) + bflo(b.x); v.y = bfhi(x.x) + bfhi(a.x) + bfhi(b.x); v.z = bflo(x.y) + bflo(a.y) + bflo(b.y); v.w = bfhi(x.y) + bfhi(a.y) + bfhi(b.y); xv[r][j] = v;
                        if (l == 1) ((GAS f32x4*)(out + (size_t)m * DM) + lane)[64 * j] = v;
                        else { u32x2 w; w.x = cvt_pk_bf16(v.x, v.y); w.y = cvt_pk_bf16(v.z, v.w); ((GAS u32x2*)(XB + (size_t)m * DM) + lane)[64 * j] = w; }
                        s += (v.x * v.x + v.y * v.y) + (v.z * v.z + v.w * v.w);
                        mx = __builtin_fmaxf(mx, __builtin_fmaxf(__builtin_fmaxf(__builtin_fabsf(v.x), __builtin_fabsf(v.y)), __builtin_fmaxf(__builtin_fabsf(v.z), __builtin_fabsf(v.w)))); }
                    if (l == 0) {
                    s = wave_sum(s); mx = wave_max(mx); mx = mx > 0.f ? mx : 1.f; const float qs = 127.0f / mx;
#pragma unroll
                    for (int j = 0; j < 4; ++j) { const f32x4 v = xv[r][j]; ((GAS unsigned*)(XB8 + (size_t)m * DM) + lane)[64 * j] = pk4_i8(v.x, v.y, v.z, v.w, qs); }
                    if (lane == 0) { SSQX[m] = s; XSC[m] = mx * (1.0f / 127.0f); } } }
            }
        }
        SEAM(pb + 14);
    }
}

extern "C" void kernel_launch(void* const* d_in, const GAS int* in_sizes, int n_in, void* d_out, int out_size, void* d_ws, size_t ws_size, hipStream_t stream) {
    static int grid = 0;
    if (grid == 0) {
        if (n_in != 25 || in_sizes[0] != T * DM || out_size != T * DM || ws_size < WS_END) { fprintf(stderr, "kernel_launch: unexpected shapes / workspace (%d inputs, ws %zu)\n", n_in, ws_size); grid = -1; return; }
        int dev = 0, cus = 0, per_cu = 0;
        if (hipGetDevice(&dev) != hipSuccess || hipDeviceGetAttribute(&cus, hipDeviceAttributeMultiprocessorCount, dev) != hipSuccess) { grid = -1; return; }
        if (hipFuncSetAttribute((const void*)fwd, hipFuncAttributeMaxDynamicSharedMemorySize, LDS_BYTES) != hipSuccess) { fprintf(stderr, "kernel_launch: hipFuncSetAttribute failed\n"); grid = -1; return; }
        if (hipOccupancyMaxActiveBlocksPerMultiprocessor(&per_cu, (const void*)fwd, 512, LDS_BYTES) != hipSuccess || per_cu < 1) fprintf(stderr, "kernel_launch: occupancy query reports %d\n", per_cu);
        (void)hipGetLastError();
        grid = cus;
    }
    if (grid < 0) return;
    if (hipMemsetAsync((char*)d_ws + WS_CTL, 0, CTL_ZERO_BYTES, stream) != hipSuccess) return;
    Args a{};
    for (int i = 0; i < 25; ++i) a.in[i] = (const GAS float*)d_in[i];
    a.out = (GAS float*)d_out; a.ws = (unsigned char*)d_ws;
#if ONE_LAUNCH
    a.ph_lo = 0; a.ph_hi = NPHASES;
    hipLaunchKernelGGL(fwd, dim3(grid), dim3(512), LDS_BYTES, stream, a);
#else
    for (int ph = 0; ph < NPHASES; ++ph) { a.ph_lo = ph; a.ph_hi = ph + 1; hipLaunchKernelGGL(fwd, dim3(grid), dim3(512), LDS_BYTES, stream, a); }
#endif
}
```

```cpp
#include <hip/hip_runtime.h>
#include <cstdio>
#include <cstdint>

#ifndef ONE_LAUNCH
#define ONE_LAUNCH 1
#endif

#define GAS __attribute__((address_space(1)))
#define LAS __attribute__((address_space(3)))
typedef unsigned short bf16_t;
typedef short bf16x8 __attribute__((ext_vector_type(8)));
typedef short s16x4 __attribute__((ext_vector_type(4)));
typedef float f32x4 __attribute__((ext_vector_type(4)));
typedef float f32x2 __attribute__((ext_vector_type(2)));
typedef float f32x16 __attribute__((ext_vector_type(16)));
typedef unsigned u32x4 __attribute__((ext_vector_type(4)));
typedef unsigned u32x2 __attribute__((ext_vector_type(2)));

constexpr int T = 65536, DM = 1024, SEQ = 4096, NB = 16;
constexpr int NPROJ1 = 1280;
constexpr int C_QA = 0, C_KA = 512, C_VA = 640, C_CQ = 768, C_CKV = 1024, C_KPE = 1152, C_GATE = 1184, IN_COLS = 3232;
constexpr int NEXP = 32, DEXP = 256;
constexpr int MOE_CAP = 65536;
constexpr float W8S = 32.0f, W8I = 1.0f / 32.0f;
constexpr int A_PAD = 2 * T + NEXP * 256;
constexpr float EPS = 1e-6f;
constexpr float LOG2E = 1.4426950408889634f;
constexpr float C2A = 0.125f * LOG2E;
constexpr float C2B = 0.10206207261596575f * LOG2E;

constexpr size_t MiB = 1u << 20;
constexpr size_t WS_CTL = 0, CTL_ZERO_BYTES = 2 * MiB;
constexpr size_t WS_SSQX = 2 * MiB;
constexpr size_t WS_RSMID = WS_SSQX + 256 * 1024;
constexpr size_t WS_ROPE = WS_RSMID + 256 * 1024;
constexpr size_t WS_ASE = 3 * MiB, WS_ASP = WS_ASE + 512 * 1024, WS_ASW = WS_ASP + 512 * 1024;
constexpr size_t WS_MY = WS_ASW + 512 * 1024, WS_MW = WS_MY + 768 * 1024, WS_MRS = WS_MW + 768 * 1024;
constexpr size_t WS_LOGITS = 8 * MiB;
constexpr size_t WS_WIN1 = 24 * MiB;
constexpr size_t WS_WG = 29 * MiB;
constexpr size_t WS_WQB = 37 * MiB;
constexpr size_t WS_WKVB = WS_WQB + 768 * 1024;
constexpr size_t WS_WOA = WS_WKVB + 768 * 1024;
constexpr size_t WS_WOB = WS_WOA + 2 * MiB;
constexpr size_t WS_WO = WS_WOB + 2 * MiB;
constexpr size_t WS_WR = WS_WO + 4 * MiB;
constexpr size_t WS_WGU = 48 * MiB;
constexpr size_t WS_WD = 112 * MiB;
constexpr size_t WS_XB = 144 * MiB;
constexpr size_t WS_PROJ1 = 272 * MiB;
constexpr size_t WS_QB = 432 * MiB;
constexpr size_t WS_KVB = 528 * MiB;
constexpr size_t WS_KB = 656 * MiB;
constexpr size_t WS_O = 752 * MiB;
constexpr size_t WS_GATES = 432 * MiB;
constexpr size_t WS_M = 272 * MiB;
constexpr size_t WS_XR = 272 * MiB;
constexpr size_t WS_ACT = 544 * MiB;
constexpr size_t WS_YBUF = 612 * MiB;
constexpr size_t WS_SSQP = 880 * MiB;
constexpr size_t WS_XB8 = 884 * MiB;
constexpr size_t WS_END = 948 * MiB;
static_assert(WS_MRS + 768 * 1024 <= WS_LOGITS && WS_LOGITS + (size_t)T * 64 * 4 <= WS_WIN1, "ws map");
static_assert(WS_WR + 1 * MiB <= WS_WGU && WS_WD + 32 * MiB <= WS_XB, "ws map");
static_assert(WS_XR + (size_t)A_PAD * 1024 * 2 <= WS_ACT && WS_ACT + (size_t)A_PAD * 256 * 2 <= WS_YBUF && WS_YBUF + (size_t)2 * T * 1024 * 2 <= WS_END, "ws map");

constexpr int CW_BAR = 4096;
constexpr int CW_WMAX = 20480;
constexpr int CW_CNT = 16384;

constexpr int RING_BYTES = 131072;
constexpr int MISC_OFF = RING_BYTES;
constexpr int LDS_BYTES = 147456;

#define LDS_WAIT() asm volatile("s_waitcnt lgkmcnt(0)" ::: "memory")
#define VM_WAIT() asm volatile("s_waitcnt vmcnt(0)" ::: "memory")

typedef float f32x2_cv __attribute__((ext_vector_type(2))); typedef __bf16 bf16x2_cv __attribute__((ext_vector_type(2)));
__device__ __forceinline__ unsigned cvt_pk_bf16(float lo, float hi) { const f32x2_cv v = {lo, hi}; const bf16x2_cv b = __builtin_convertvector(v, bf16x2_cv); return __builtin_bit_cast(unsigned, b); }
__device__ __forceinline__ unsigned pk4_i8(float a, float b, float c, float d, float s) {
    int q0 = (int)__builtin_rintf(a * s), q1 = (int)__builtin_rintf(b * s), q2 = (int)__builtin_rintf(c * s), q3 = (int)__builtin_rintf(d * s);
    q0 = q0 < -127 ? -127 : (q0 > 127 ? 127 : q0); q1 = q1 < -127 ? -127 : (q1 > 127 ? 127 : q1); q2 = q2 < -127 ? -127 : (q2 > 127 ? 127 : q2); q3 = q3 < -127 ? -127 : (q3 > 127 ? 127 : q3);
    return (unsigned)(q0 & 255) | ((unsigned)(q1 & 255) << 8) | ((unsigned)(q2 & 255) << 16) | ((unsigned)q3 << 24); }
__device__ __forceinline__ float wave_max(float v) {
#pragma unroll
    for (int o = 1; o < 64; o <<= 1) v = __builtin_fmaxf(v, __shfl_xor(v, o));
    return v;
}
__device__ __forceinline__ unsigned pk4_fp8(float a, float b, float c, float d) { int p = __builtin_amdgcn_cvt_pk_fp8_f32(a, b, 0, false); p = __builtin_amdgcn_cvt_pk_fp8_f32(c, d, p, true); return (unsigned)p; }
__device__ __forceinline__ float bflo(unsigned u) { return __uint_as_float(u << 16); }
__device__ __forceinline__ float bfhi(unsigned u) { return __uint_as_float(u & 0xffff0000u); }
__device__ __forceinline__ float bf1(bf16_t h) { return __uint_as_float((unsigned)h << 16); }
__device__ __forceinline__ float wave_sum(float v) {
#pragma unroll
    for (int o = 1; o < 64; o <<= 1) v += __shfl_xor(v, o);
    return v;
}
__device__ __forceinline__ float fsigmoid(float v) { return __builtin_amdgcn_rcpf(1.0f + __builtin_amdgcn_exp2f(-v * LOG2E)); }

namespace pg8 {
constexpr int BM = 256, BK = 64, HALF = 128, HTB = HALF * BK * 2, STAGE_BYTES = 8 * HTB, NXCD = 8, WGM = 8;
__host__ __device__ __forceinline__ int lds_byte(int r, int c) { const int st = (r >> 4) * 2 + (c >> 5), rr = r & 15, cc = c & 31, ob = rr * 64 + cc * 2; return st * 1024 + (ob ^ (((ob >> 9) & 1) << 5)); }
__host__ __device__ __forceinline__ void stage_rc(int b, int& R, int& C) { const int st = b / 1024, sb = b % 1024, swz = sb ^ (((sb >> 9) & 1) << 5); R = (st >> 1) * 16 + swz / 64; C = (st & 1) * 32 + (swz % 64) / 2; }
__host__ __device__ __forceinline__ int perm32(int rho) { const int n = rho >> 4, i = rho & 15; return 8 * (i >> 2) + 4 * n + (i & 3); }

struct Unit { int pm, pn; };
struct Gemm { const GAS bf16_t* A; const GAS bf16_t* Bt; int lda, ldb, K; };

struct StaticOrder {
    static constexpr bool GATHER = false;
    int nM, nN, nwg, G, c;
    __device__ void init(int M, int N, int G_, int c_) { nM = M / BM; nN = N / BM; nwg = nM * nN; G = G_; c = c_; }
    __device__ __forceinline__ bool next(int i, Unit& u) const {
        const long L = (long)i * G + c; if (L >= nwg) return false;
        int wgid = (int)L; { const int q = nwg / NXCD, r = nwg % NXCD, xcd = wgid % NXCD, off = wgid / NXCD; wgid = (xcd < r ? xcd * (q + 1) : r * (q + 1) + (xcd - r) * q) + off; }
        const int nig = WGM * nN, gid = wgid / nig, fm = gid * WGM, gsz = (nM - fm) < WGM ? (nM - fm) : WGM;
        u.pm = fm + ((wgid % nig) % gsz); u.pn = (wgid % nig) / gsz; return true;
    }
    __device__ __forceinline__ size_t aoff(const Gemm& g, const Unit& u) const { return (size_t)u.pm * BM * g.lda * 2; }
    __device__ __forceinline__ size_t boff(const Gemm& g, const Unit& u) const { return (size_t)u.pn * BM * g.ldb * 2; }
};
template <bool GA> struct MoeOrderT {
    static constexpr bool GATHER = GA;
    int nunits, npn, G, c; const LAS int* pend; size_t estride; const GAS int* tab; const LAS int* pcnt;
    __device__ bool next(int i, Unit& u) const { const long L = (long)i * G + c; if (L >= nunits) return false; u.pm = (int)(L / npn); u.pn = (int)(L % npn); return true; }
    __device__ __forceinline__ int expert(int pm) const { int e = 0; while (e < NEXP - 1 && pend[e] <= pm) ++e; return e; }
    __device__ __forceinline__ size_t aoff(const Gemm& g, const Unit& u) const { return (size_t)u.pm * BM * g.lda * 2; }
    __device__ __forceinline__ size_t boff(const Gemm& g, const Unit& u) const { return (size_t)expert(u.pm) * estride + (size_t)u.pn * BM * g.ldb * 2; }
    __device__ __forceinline__ void gather(const Gemm& g, const Unit& u, int tid, unsigned (&o)[2][2]) const {
        const int e = expert(u.pm), lp = u.pm - (e ? pend[e - 1] : 0), cnt = pcnt[e];
#pragma unroll
        for (int i = 0; i < 2; ++i) { int R, C; stage_rc(tid * 16 + i * 8192, R, C);
#pragma unroll
            for (int h = 0; h < 2; ++h) { const int pos = lp * 256 + h * HALF + R; int tok = 0; if (pos < cnt) tok = tab[(size_t)(e * MOE_CAP + pos) * 4];
                o[h][i] = (unsigned)tok * (unsigned)(g.lda * 2) + (unsigned)C * 2u; } }
    }
};
typedef MoeOrderT<false> MoeOrder; typedef MoeOrderT<true> MoeGather;

#define EPI_ROW(ai, m) (u.pm * 256 + (ai) * 128 + wr * 64 + (m) * 16 + fr)
#define EPI_COL(bj) (u.pn * 256 + (bj) * 128 + wc * 32 + 8 * fq)
#define EPI_COL16 (u.pn * 256 + wc * 64 + 16 * fq)
__device__ __forceinline__ int col16_src(int np) { const int j = np & 255; return (np & ~255) + 64 * ((j >> 5) & 3) + 16 * ((j >> 3) & 3) + 8 * (j >> 7) + (j & 7); }

template <bool SCALED> struct EpiScaleBf16T {
    static constexpr bool PERM = true;
    GAS bf16_t* O; int ldc; const GAS float* ssq; float invn; const GAS float* rowmul; float wsc;
    __device__ __forceinline__ void operator()(const f32x4 (&acc)[2][2][4][2], const Unit& u, int wr, int wc, int fr, int fq) const {
        float sc[2][4];
        if constexpr (SCALED) { float a[2][4], r[2][4];
#pragma unroll
            for (int ai = 0; ai < 2; ++ai)
#pragma unroll
                for (int m = 0; m < 4; ++m) { const int row = EPI_ROW(ai, m); a[ai][m] = ssq[row]; r[ai][m] = rowmul[row]; }
#pragma unroll
            for (int ai = 0; ai < 2; ++ai)
#pragma unroll
                for (int m = 0; m < 4; ++m) sc[ai][m] = __builtin_amdgcn_rsqf(a[ai][m] * invn + EPS) * r[ai][m] * wsc;
        }
#pragma unroll
        for (int ai = 0; ai < 2; ++ai)
#pragma unroll
            for (int m = 0; m < 4; ++m) { const int row = EPI_ROW(ai, m); const float s = SCALED ? sc[ai][m] : 1.0f;
#pragma unroll
                for (int bj = 0; bj < 2; ++bj) { const f32x4 v0 = acc[ai][bj][m][0] * s, v1 = acc[ai][bj][m][1] * s;
                    u32x4 w; w.x = cvt_pk_bf16(v0[0], v0[1]); w.y = cvt_pk_bf16(v0[2], v0[3]); w.z = cvt_pk_bf16(v1[0], v1[1]); w.w = cvt_pk_bf16(v1[2], v1[3]);
                    *(GAS u32x4*)(O + (size_t)row * ldc + EPI_COL(bj)) = w; } }
    }
};
typedef EpiScaleBf16T<true> EpiScaleBf16; typedef EpiScaleBf16T<false> EpiPlainBf16;
struct EpiProj1 {
    static constexpr bool PERM = true;
    GAS bf16_t* P; const GAS float* ssq; const GAS float* xsc; float wsc; const GAS float* gq; const GAS float* gk; GAS float* pcq; GAS float* pckv; GAS float* pkpe;
    __device__ __forceinline__ void operator()(const f32x4 (&acc)[2][2][4][2], const Unit& u, int wr, int wc, int fr, int fq) const {
        float sc[2][4];
        { float a[2][4], r[2][4];
#pragma unroll
          for (int ai = 0; ai < 2; ++ai)
#pragma unroll
              for (int m = 0; m < 4; ++m) { const int row = EPI_ROW(ai, m); a[ai][m] = ssq[row]; r[ai][m] = xsc[row]; }
#pragma unroll
          for (int ai = 0; ai < 2; ++ai)
#pragma unroll
              for (int m = 0; m < 4; ++m) sc[ai][m] = __builtin_amdgcn_rsqf(a[ai][m] * (1.0f / 1024.0f) + EPS) * r[ai][m] * wsc; }
        if (u.pn < 3) {
            const int head8 = 4 * u.pn + wc; const bool norm = head8 < 10;
            f32x4 g[2][2];
            if (norm) { const GAS float* gp = (head8 < 8 ? gq : gk) + 8 * fq; const float gs = head8 < 8 ? C2A : 1.0f;
#pragma unroll
                for (int bj = 0; bj < 2; ++bj)
#pragma unroll
                    for (int n = 0; n < 2; ++n) g[bj][n] = *(const GAS f32x4*)(gp + 32 * bj + 4 * n) * gs; }
#pragma unroll
            for (int ai = 0; ai < 2; ++ai)
#pragma unroll
                for (int m = 0; m < 4; ++m) { const int row = EPI_ROW(ai, m); f32x4 v[2][2];
#pragma unroll
                    for (int bj = 0; bj < 2; ++bj)
#pragma unroll
                        for (int n = 0; n < 2; ++n) v[bj][n] = acc[ai][bj][m][n] * sc[ai][m];
                    if (norm) { float s = 0.f;
#pragma unroll
                        for (int bj = 0; bj < 2; ++bj)
#pragma unroll
                            for (int n = 0; n < 2; ++n) s += (v[bj][n][0] * v[bj][n][0] + v[bj][n][1] * v[bj][n][1]) + (v[bj][n][2] * v[bj][n][2] + v[bj][n][3] * v[bj][n][3]);
                        s += __shfl_xor(s, 16); s += __shfl_xor(s, 32);
                        const float rs = __builtin_amdgcn_rsqf(s * (1.0f / 64.0f) + EPS);
#pragma unroll
                        for (int bj = 0; bj < 2; ++bj)
#pragma unroll
                            for (int n = 0; n < 2; ++n) v[bj][n] = v[bj][n] * rs * g[bj][n]; }
#pragma unroll
                    for (int bj = 0; bj < 2; ++bj) { u32x4 w; w.x = cvt_pk_bf16(v[bj][0][0], v[bj][0][1]); w.y = cvt_pk_bf16(v[bj][0][2], v[bj][0][3]); w.z = cvt_pk_bf16(v[bj][1][0], v[bj][1][1]); w.w = cvt_pk_bf16(v[bj][1][2], v[bj][1][3]);
                        *(GAS u32x4*)(P + (size_t)row * NPROJ1 + 64 * head8 + 32 * bj + 8 * fq) = w; } }
        } else {
#pragma unroll
            for (int ai = 0; ai < 2; ++ai)
#pragma unroll
                for (int m = 0; m < 4; ++m) { const int row = EPI_ROW(ai, m); float s0 = 0.f, s1 = 0.f;
#pragma unroll
                    for (int bj = 0; bj < 2; ++bj) { const f32x4 v0 = acc[ai][bj][m][0] * sc[ai][m], v1 = acc[ai][bj][m][1] * sc[ai][m];
                        const float q = (v0[0] * v0[0] + v0[1] * v0[1]) + (v0[2] * v0[2] + v0[3] * v0[3]) + (v1[0] * v1[0] + v1[1] * v1[1]) + (v1[2] * v1[2] + v1[3] * v1[3]);
                        if (bj == 0) s0 = q; else s1 = q;
                        u32x4 w; w.x = cvt_pk_bf16(v0[0], v0[1]); w.y = cvt_pk_bf16(v0[2], v0[3]); w.z = cvt_pk_bf16(v1[0], v1[1]); w.w = cvt_pk_bf16(v1[2], v1[3]);
                        *(GAS u32x4*)(P + (size_t)row * NPROJ1 + EPI_COL(bj)) = w; }
                    float s = (u.pn == 3) ? s0 + s1 : s0;
                    s += __shfl_xor(s, 16); s += __shfl_xor(s, 32);
                    if (fq == 0) ((u.pn == 3) ? pcq : pckv)[(size_t)row * 4 + wc] = s;
                    if (u.pn == 4 && wc == 0) { float t = s1; t += __shfl_xor(t, 16); t += __shfl_xor(t, 32); if (fq == 0) pkpe[row] = t; } }
        }
    }
};
struct EpiRowNorm4 {
    static constexpr bool PERM = true;
    GAS bf16_t* O; int ldc; const GAS float* part; float invn;
    __device__ __forceinline__ void operator()(const f32x4 (&acc)[2][2][4][2], const Unit& u, int wr, int wc, int fr, int fq) const {
        f32x4 p[2][4];
#pragma unroll
        for (int ai = 0; ai < 2; ++ai)
#pragma unroll
            for (int m = 0; m < 4; ++m) p[ai][m] = *(const GAS f32x4*)(part + (size_t)EPI_ROW(ai, m) * 4);
#pragma unroll
        for (int ai = 0; ai < 2; ++ai)
#pragma unroll
            for (int m = 0; m < 4; ++m) { const int row = EPI_ROW(ai, m); const float s = __builtin_amdgcn_rsqf(((p[ai][m].x + p[ai][m].y) + (p[ai][m].z + p[ai][m].w)) * invn + EPS);
#pragma unroll
                for (int bj = 0; bj < 2; ++bj) { const f32x4 v0 = acc[ai][bj][m][0] * s, v1 = acc[ai][bj][m][1] * s;
                    u32x4 w; w.x = cvt_pk_bf16(v0[0], v0[1]); w.y = cvt_pk_bf16(v0[2], v0[3]); w.z = cvt_pk_bf16(v1[0], v1[1]); w.w = cvt_pk_bf16(v1[2], v1[3]);
                    *(GAS u32x4*)(O + (size_t)row * ldc + EPI_COL(bj)) = w; } }
    }
};
struct EpiGates {
    static constexpr bool PERM = true;
    GAS bf16_t* O; const GAS float* ssq; const GAS float* bias; const GAS float* rowmul; float wsc;
    __device__ __forceinline__ void operator()(const f32x4 (&acc)[2][2][4][2], const Unit& u, int wr, int wc, int fr, int fq) const {
        f32x4 bv[2][2]; float a[2][4], r[2][4], sc[2][4];
#pragma unroll
        for (int bj = 0; bj < 2; ++bj)
#pragma unroll
            for (int n = 0; n < 2; ++n) bv[bj][n] = *(const GAS f32x4*)(bias + EPI_COL(bj) + 4 * n);
#pragma unroll
        for (int ai = 0; ai < 2; ++ai)
#pragma unroll
            for (int m = 0; m < 4; ++m) { const int row = EPI_ROW(ai, m); a[ai][m] = ssq[row]; r[ai][m] = rowmul[row]; }
#pragma unroll
        for (int ai = 0; ai < 2; ++ai)
#pragma unroll
            for (int m = 0; m < 4; ++m) sc[ai][m] = __builtin_amdgcn_rsqf(a[ai][m] * (1.0f / 1024.0f) + EPS) * r[ai][m] * wsc;
#pragma unroll
        for (int ai = 0; ai < 2; ++ai)
#pragma unroll
            for (int m = 0; m < 4; ++m) { const int row = EPI_ROW(ai, m); const float s = sc[ai][m];
#pragma unroll
                for (int bj = 0; bj < 2; ++bj) { f32x4 v0 = acc[ai][bj][m][0] * s + bv[bj][0], v1 = acc[ai][bj][m][1] * s + bv[bj][1];
#pragma unroll
                    for (int i = 0; i < 4; ++i) { v0[i] = fsigmoid(v0[i]); v1[i] = fsigmoid(v1[i]); }
                    u32x4 w; w.x = cvt_pk_bf16(v0[0], v0[1]); w.y = cvt_pk_bf16(v0[2], v0[3]); w.z = cvt_pk_bf16(v1[0], v1[1]); w.w = cvt_pk_bf16(v1[2], v1[3]);
                    *(GAS u32x4*)(O + (size_t)row * 2048 + EPI_COL(bj)) = w; } }
    }
};
struct EpiKv {
    static constexpr bool PERM = true;
    GAS bf16_t* KBo; GAS bf16_t* Vo; const GAS float* pckv; const GAS float* pkpe; const GAS bf16_t* P; const GAS float* gbk; const GAS float* rope;
    __device__ __forceinline__ void operator()(const f32x4 (&acc)[2][2][4][2], const Unit& u, int wr, int wc, int fr, int fq) const {
        asm volatile("" : "+v"(fr), "+v"(fq));
        float rc[2][4];
        { f32x4 p[2][4];
#pragma unroll
          for (int ai = 0; ai < 2; ++ai)
#pragma unroll
              for (int m = 0; m < 4; ++m) p[ai][m] = *(const GAS f32x4*)(pckv + (unsigned)(EPI_ROW(ai, m) * 4));
#pragma unroll
          for (int ai = 0; ai < 2; ++ai)
#pragma unroll
              for (int m = 0; m < 4; ++m) rc[ai][m] = __builtin_amdgcn_rsqf(((p[ai][m].x + p[ai][m].y) + (p[ai][m].z + p[ai][m].w)) * (1.0f / 128.0f) + EPS); }
        const int head = 2 * u.pn + (wc & 1);
        if (wc >= 2) {
#pragma unroll
            for (int ai = 0; ai < 2; ++ai)
#pragma unroll
                for (int m = 0; m < 4; ++m) { const int row = EPI_ROW(ai, m);
#pragma unroll
                    for (int bj = 0; bj < 2; ++bj) { const f32x4 v0 = acc[ai][bj][m][0] * rc[ai][m], v1 = acc[ai][bj][m][1] * rc[ai][m];
                        u32x4 w; w.x = cvt_pk_bf16(v0[0], v0[1]); w.y = cvt_pk_bf16(v0[2], v0[3]); w.z = cvt_pk_bf16(v1[0], v1[1]); w.w = cvt_pk_bf16(v1[2], v1[3]);
                        *(GAS u32x4*)(Vo + (unsigned)(row * 1024 + 128 * head + 64 + 32 * bj + 8 * fq)) = w; } }
        } else {
            float rsh[2][4];
            {
                float sk[2][4];
#pragma unroll
                for (int ai = 0; ai < 2; ++ai)
#pragma unroll
                    for (int m = 0; m < 4; ++m) sk[ai][m] = pkpe[(unsigned)EPI_ROW(ai, m)];
                f32x4 g[2][2];
#pragma unroll
                for (int bj = 0; bj < 2; ++bj)
#pragma unroll
                    for (int n = 0; n < 2; ++n) g[bj][n] = *(const GAS f32x4*)(gbk + (unsigned)(32 * bj + 8 * fq + 4 * n));
#pragma unroll
                for (int ai = 0; ai < 2; ++ai)
#pragma unroll
                    for (int m = 0; m < 4; ++m) { const int row = EPI_ROW(ai, m); f32x4 v[2][2]; float s = 0.f;
#pragma unroll
                        for (int bj = 0; bj < 2; ++bj)
#pragma unroll
                            for (int n = 0; n < 2; ++n) { v[bj][n] = acc[ai][bj][m][n] * rc[ai][m]; s += (v[bj][n][0] * v[bj][n][0] + v[bj][n][1] * v[bj][n][1]) + (v[bj][n][2] * v[bj][n][2] + v[bj][n][3] * v[bj][n][3]); }
                        s += __shfl_xor(s, 16); s += __shfl_xor(s, 32);
                        const float rs = __builtin_amdgcn_rsqf((s + sk[ai][m]) * (1.0f / 96.0f) + EPS); rsh[ai][m] = rs;
                        const unsigned dof = (unsigned)((((row >> 12) * 8 + head) * 64 + ((row & (SEQ - 1)) >> 6)) * 12 * 512 + (row & 63) * 8);
#pragma unroll
                        for (int bj = 0; bj < 2; ++bj) { const f32x4 a0 = v[bj][0] * rs * g[bj][0], a1 = v[bj][1] * rs * g[bj][1];
                            u32x4 w; w.x = cvt_pk_bf16(a0[0], a0[1]); w.y = cvt_pk_bf16(a0[2], a0[3]); w.z = cvt_pk_bf16(a1[0], a1[1]); w.w = cvt_pk_bf16(a1[2], a1[3]);
                            *(GAS u32x4*)(KBo + (dof + (4 * bj + fq) * 512)) = w; }
                        }
            }
            asm volatile("" : "+v"(fq), "+v"(fr) :: "memory");
            {
                const f32x4 gr0 = *(const GAS f32x4*)(gbk + (unsigned)(64 + 4 * fq)), gr1 = *(const GAS f32x4*)(gbk + (unsigned)(80 + 4 * fq));
#pragma unroll
                for (int ai = 0; ai < 2; ++ai) { u32x2 kp0[4], kp1[4]; f32x4 cs[4], sn[4];
#pragma unroll
                    for (int m = 0; m < 4; ++m) { const int row = EPI_ROW(ai, m);
                        const unsigned pof = (unsigned)(row * NPROJ1 + C_KPE + 4 * fq); kp0[m] = *(const GAS u32x2*)(P + pof); kp1[m] = *(const GAS u32x2*)(P + (pof + 16));
                        const unsigned rof = (unsigned)((row & (SEQ - 1)) * 32 + 4 * fq); cs[m] = *(const GAS f32x4*)(rope + rof); sn[m] = *(const GAS f32x4*)(rope + (rof + 16)); }
#pragma unroll
                    for (int m = 0; m < 4; ++m) { const int row = EPI_ROW(ai, m); const float rs = rsh[ai][m]; const unsigned dof = (unsigned)((((row >> 12) * 8 + head) * 64 + ((row & (SEQ - 1)) >> 6)) * 12 * 512 + (row & 63) * 8);
                        const f32x4 x1 = (f32x4){bflo(kp0[m].x), bfhi(kp0[m].x), bflo(kp0[m].y), bfhi(kp0[m].y)} * rs * gr0, x2 = (f32x4){bflo(kp1[m].x), bfhi(kp1[m].x), bflo(kp1[m].y), bfhi(kp1[m].y)} * rs * gr1;
                        const f32x4 o1 = x1 * cs[m] - x2 * sn[m], o2 = x1 * sn[m] + x2 * cs[m];
                        u32x2 w1, w2; w1.x = cvt_pk_bf16(o1[0], o1[1]); w1.y = cvt_pk_bf16(o1[2], o1[3]); w2.x = cvt_pk_bf16(o2[0], o2[1]); w2.y = cvt_pk_bf16(o2[2], o2[3]);
                        *(GAS u32x2*)(KBo + (dof + (8 + (fq >> 1)) * 512 + 4 * (fq & 1))) = w1; *(GAS u32x2*)(KBo + (dof + (10 + (fq >> 1)) * 512 + 4 * (fq & 1))) = w2; }
                    asm volatile("" ::: "memory"); }
            }
        }
    }
};
struct EpiGates2 {
    static constexpr bool PERM = true;
    GAS bf16_t* GR; GAS bf16_t* GBo; const GAS float* ssq; const GAS float* bias; const GAS float* rowmul; float wsc;
    __device__ __forceinline__ void operator()(const f32x4 (&acc)[2][2][4][2], const Unit& u, int wr, int wc, int fr, int fq) const {
        f32x4 ba[2], bb[2]; float a[2][4], r[2][4], sc[2][4];
        const int c0 = u.pn * 128 + wc * 32 + 8 * fq;
#pragma unroll
        for (int n = 0; n < 2; ++n) { ba[n] = *(const GAS f32x4*)(bias + c0 + 4 * n) * (-LOG2E); bb[n] = *(const GAS f32x4*)(bias + 1024 + c0 + 4 * n) * (-LOG2E); }
#pragma unroll
        for (int ai = 0; ai < 2; ++ai)
#pragma unroll
            for (int m = 0; m < 4; ++m) { const int row = EPI_ROW(ai, m); a[ai][m] = ssq[row]; r[ai][m] = rowmul[row]; }
#pragma unroll
        for (int ai = 0; ai < 2; ++ai)
#pragma unroll
            for (int m = 0; m < 4; ++m) sc[ai][m] = __builtin_amdgcn_rsqf(a[ai][m] * (1.0f / 1024.0f) + EPS) * r[ai][m] * (wsc * -LOG2E);
#pragma unroll
        for (int ai = 0; ai < 2; ++ai)
#pragma unroll
            for (int m = 0; m < 4; ++m) { const int row = EPI_ROW(ai, m); const float s = sc[ai][m]; f32x4 rr[2], gb[2];
#pragma unroll
                for (int n = 0; n < 2; ++n) { const f32x4 la = acc[ai][0][m][n] * s + ba[n], lb = acc[ai][1][m][n] * s + bb[n];
#pragma unroll
                    for (int i = 0; i < 4; ++i) { const float ea = __builtin_amdgcn_exp2f(la[i]), eb = __builtin_amdgcn_exp2f(lb[i]);
                        gb[n][i] = __builtin_amdgcn_rcpf(1.0f + eb); rr[n][i] = (1.0f + eb) * __builtin_amdgcn_rcpf(1.0f + ea); } }
                const size_t off = (size_t)row * 1024 + c0;
                u32x4 w; w.x = cvt_pk_bf16(rr[0][0], rr[0][1]); w.y = cvt_pk_bf16(rr[0][2], rr[0][3]); w.z = cvt_pk_bf16(rr[1][0], rr[1][1]); w.w = cvt_pk_bf16(rr[1][2], rr[1][3]); *(GAS u32x4*)(GR + off) = w;
                w.x = cvt_pk_bf16(gb[0][0], gb[0][1]); w.y = cvt_pk_bf16(gb[0][2], gb[0][3]); w.z = cvt_pk_bf16(gb[1][0], gb[1][1]); w.w = cvt_pk_bf16(gb[1][2], gb[1][3]); *(GAS u32x4*)(GBo + off) = w; }
    }
};
struct EpiMerge {
    static constexpr bool PERM = true; static constexpr bool HAS_MID = true;
    GAS bf16_t* Mo; const GAS bf16_t* GR; const GAS bf16_t* GBi;
    template <bool FIN> __device__ __forceinline__ void apply(f32x4 (&acc)[2][2][4][2], const Unit& u, int wr, int wc, int fr, int fq) const {
        const GAS bf16_t* G_ = FIN ? GBi : GR;
        u32x4 gv[2][4][2];
#pragma unroll
        for (int ai = 0; ai < 2; ++ai)
#pragma unroll
            for (int m = 0; m < 4; ++m)
#pragma unroll
                for (int bj = 0; bj < 2; ++bj) gv[ai][m][bj] = *(const GAS u32x4*)(G_ + (size_t)EPI_ROW(ai, m) * 1024 + EPI_COL16 + 8 * bj);
#pragma unroll
        for (int ai = 0; ai < 2; ++ai) {
#pragma unroll
            for (int m = 0; m < 4; ++m) { u32x4 w;
#pragma unroll
                for (int bj = 0; bj < 2; ++bj) { const u32x4 g = gv[ai][m][bj]; f32x4 v0 = acc[ai][bj][m][0], v1 = acc[ai][bj][m][1];
                    v0[0] *= bflo(g.x); v0[1] *= bfhi(g.x); v0[2] *= bflo(g.y); v0[3] *= bfhi(g.y); v1[0] *= bflo(g.z); v1[1] *= bfhi(g.z); v1[2] *= bflo(g.w); v1[3] *= bfhi(g.w);
                    if constexpr (FIN) { v0 = v0 * W8I; v1 = v1 * W8I; const unsigned lo_ = pk4_fp8(v0[0], v0[1], v0[2], v0[3]), hi_ = pk4_fp8(v1[0], v1[1], v1[2], v1[3]);
                        if (bj == 0) { w.x = lo_; w.y = hi_; } else { w.z = lo_; w.w = hi_; } }
                    else { acc[ai][bj][m][0] = v0; acc[ai][bj][m][1] = v1; } }
                if constexpr (FIN) *(GAS u32x4*)((GAS unsigned char*)Mo + (size_t)EPI_ROW(ai, m) * 1024 + EPI_COL16) = w; }
            asm volatile("" ::: "memory"); }
    }
    __device__ __forceinline__ void mid(f32x4 (&acc)[2][2][4][2], const Unit& u, int wr, int wc, int fr, int fq) const { apply<false>(acc, u, wr, wc, fr, fq); }
    __device__ __forceinline__ void operator()(f32x4 (&acc)[2][2][4][2], const Unit& u, int wr, int wc, int fr, int fq) const { apply<true>(acc, u, wr, wc, fr, fq); }
};
template <bool ACCUM> struct EpiGateMul {
    static constexpr bool PERM = true;
    GAS bf16_t* Mo; const GAS bf16_t* gates; int goff;
    __device__ __forceinline__ void operator()(const f32x4 (&acc)[2][2][4][2], const Unit& u, int wr, int wc, int fr, int fq) const {
#pragma unroll
        for (int ai = 0; ai < 2; ++ai) { u32x4 gv[4][2], pv[4][2];
#pragma unroll
            for (int m = 0; m < 4; ++m) { const int row = EPI_ROW(ai, m);
#pragma unroll
                for (int bj = 0; bj < 2; ++bj) { const int col = EPI_COL(bj); gv[m][bj] = *(const GAS u32x4*)(gates + (size_t)row * 2048 + goff + col);
                    if (ACCUM) pv[m][bj] = *(const GAS u32x4*)(Mo + (size_t)row * 1024 + col); } }
#pragma unroll
            for (int m = 0; m < 4; ++m) { const int row = EPI_ROW(ai, m);
#pragma unroll
                for (int bj = 0; bj < 2; ++bj) { const int col = EPI_COL(bj); const u32x4 g = gv[m][bj];
                    f32x4 v0 = acc[ai][bj][m][0], v1 = acc[ai][bj][m][1];
                    v0[0] *= bflo(g.x); v0[1] *= bfhi(g.x); v0[2] *= bflo(g.y); v0[3] *= bfhi(g.y);
                    v1[0] *= bflo(g.z); v1[1] *= bfhi(g.z); v1[2] *= bflo(g.w); v1[3] *= bfhi(g.w);
                    if (ACCUM) { const u32x4 p = pv[m][bj];
                        v0[0] += bflo(p.x); v0[1] += bfhi(p.x); v0[2] += bflo(p.y); v0[3] += bfhi(p.y);
                        v1[0] += bflo(p.z); v1[1] += bfhi(p.z); v1[2] += bflo(p.w); v1[3] += bfhi(p.w); }
                    u32x4 w; w.x = cvt_pk_bf16(v0[0], v0[1]); w.y = cvt_pk_bf16(v0[2], v0[3]); w.z = cvt_pk_bf16(v1[0], v1[1]); w.w = cvt_pk_bf16(v1[2], v1[3]);
                    *(GAS u32x4*)(Mo + (size_t)row * 1024 + col) = w; } }
            asm volatile("" ::: "memory"); }
    }
};
struct EpiResid {
    static constexpr bool PERM = true;
    const GAS float* xres; GAS bf16_t* xb; GAS float* ssq;
    __device__ __forceinline__ void operator()(const f32x4 (&acc)[2][2][4][2], const Unit& u, int wr, int wc, int fr, int fq) const {
#pragma unroll
        for (int ai = 0; ai < 2; ++ai) { f32x4 pre[4][2][2];
            if (xres) {
#pragma unroll
                for (int m = 0; m < 4; ++m) { const int row = EPI_ROW(ai, m);
#pragma unroll
                    for (int bj = 0; bj < 2; ++bj) { const size_t off = (size_t)row * 1024 + EPI_COL16 + 8 * bj; pre[m][bj][0] = *(const GAS f32x4*)(xres + off); pre[m][bj][1] = *(const GAS f32x4*)(xres + off + 4); } }
            } else {
                u32x4 pb[4][2];
#pragma unroll
                for (int m = 0; m < 4; ++m) { const int row = EPI_ROW(ai, m);
#pragma unroll
                    for (int bj = 0; bj < 2; ++bj) pb[m][bj] = *(const GAS u32x4*)(xb + (size_t)row * 1024 + EPI_COL16 + 8 * bj); }
#pragma unroll
                for (int m = 0; m < 4; ++m)
#pragma unroll
                    for (int bj = 0; bj < 2; ++bj) { const u32x4 p = pb[m][bj]; pre[m][bj][0] = (f32x4){bflo(p.x), bfhi(p.x), bflo(p.y), bfhi(p.y)}; pre[m][bj][1] = (f32x4){bflo(p.z), bfhi(p.z), bflo(p.w), bfhi(p.w)}; }
            }
#pragma unroll
            for (int m = 0; m < 4; ++m) { const int row = EPI_ROW(ai, m); float s = 0.f;
#pragma unroll
                for (int bj = 0; bj < 2; ++bj) { const size_t off = (size_t)row * 1024 + EPI_COL16 + 8 * bj;
                    const f32x4 v0 = acc[ai][bj][m][0] * W8I + pre[m][bj][0], v1 = acc[ai][bj][m][1] * W8I + pre[m][bj][1];
                    s += (v0[0] * v0[0] + v0[1] * v0[1]) + (v0[2] * v0[2] + v0[3] * v0[3]) + (v1[0] * v1[0] + v1[1] * v1[1]) + (v1[2] * v1[2] + v1[3] * v1[3]);
                    u32x4 w; w.x = cvt_pk_bf16(v0[0], v0[1]); w.y = cvt_pk_bf16(v0[2], v0[3]); w.z = cvt_pk_bf16(v1[0], v1[1]); w.w = cvt_pk_bf16(v1[2], v1[3]);
                    *(GAS u32x4*)(xb + off) = w; }
                s += __shfl_xor(s, 16); s += __shfl_xor(s, 32);
                if (fq == 0) ssq[(size_t)row * 16 + u.pn * 4 + wc] = s; }
            asm volatile("" ::: "memory"); }
    }
};
struct EpiLogits {
    static constexpr bool PERM = true;
    GAS float* L; const GAS float* ssqp;
    __device__ __forceinline__ void operator()(const f32x4 (&acc)[2][2][4][2], const Unit& u, int wr, int wc, int fr, int fq) const {
        if (u.pn != 0 || wc > 1) return;
#pragma unroll
        for (int ai = 0; ai < 2; ++ai) { f32x4 pp[4][4];
#pragma unroll
            for (int m = 0; m < 4; ++m) { const GAS f32x4* p = (const GAS f32x4*)(ssqp + (size_t)EPI_ROW(ai, m) * 16); pp[m][0] = p[0]; pp[m][1] = p[1]; pp[m][2] = p[2]; pp[m][3] = p[3]; }
#pragma unroll
            for (int m = 0; m < 4; ++m) { const int row = EPI_ROW(ai, m); const f32x4 a = pp[m][0], b = pp[m][1], c = pp[m][2], d = pp[m][3];
                const float sc = __builtin_amdgcn_rsqf((((a.x + a.y) + (a.z + a.w)) + ((b.x + b.y) + (b.z + b.w)) + ((c.x + c.y) + (c.z + c.w)) + ((d.x + d.y) + (d.z + d.w))) * (1.0f / 1024.0f) + EPS);
#pragma unroll
                for (int n = 0; n < 2; ++n) { const int col = wc * 32 + 8 * fq + 4 * n; if (col < 36) *(GAS f32x4*)(L + (size_t)row * 64 + col) = acc[ai][0][m][n] * sc; } } }
    }
};
struct EpiGateUp {
    static constexpr bool PERM = true;
    GAS bf16_t* act; const GAS float* tabf; const LAS int* pend; const LAS int* pcnt; float wsc;
    __device__ __forceinline__ void operator()(const f32x4 (&acc)[2][2][4][2], const Unit& u, int wr, int wc, int fr, int fq) const {
        int e = 0; while (e < NEXP - 1 && pend[e] <= u.pm) ++e;
        const int lp = u.pm - (e ? pend[e - 1] : 0), cnt = pcnt[e] - lp * 256; const unsigned base = (unsigned)(e * MOE_CAP + lp * 256);
        float sc[2][4];
#pragma unroll
        for (int ai = 0; ai < 2; ++ai)
#pragma unroll
            for (int m = 0; m < 4; ++m) { const int r = ai * 128 + wr * 64 + m * 16 + fr; const float v = tabf[(size_t)(base + r) * 4 + 1]; sc[ai][m] = (r < cnt) ? v : 0.f; }
#pragma unroll
        for (int ai = 0; ai < 2; ++ai)
#pragma unroll
            for (int m = 0; m < 4; ++m) { const int row = EPI_ROW(ai, m); const float s = sc[ai][m] * wsc; f32x4 a[2];
#pragma unroll
                for (int n = 0; n < 2; ++n) { const f32x4 gg = acc[ai][0][m][n] * s, uu = acc[ai][1][m][n] * s;
#pragma unroll
                    for (int i = 0; i < 4; ++i) a[n][i] = gg[i] * fsigmoid(gg[i]) * uu[i]; }
                u32x4 w; w.x = cvt_pk_bf16(a[0][0], a[0][1]); w.y = cvt_pk_bf16(a[0][2], a[0][3]); w.z = cvt_pk_bf16(a[1][0], a[1][1]); w.w = cvt_pk_bf16(a[1][2], a[1][3]);
                *(GAS u32x4*)(act + (size_t)row * 256 + u.pn * 128 + wc * 32 + 8 * fq) = w; }
    }
};
struct EpiDown {
    static constexpr bool PERM = true;
    GAS bf16_t* ybuf; const GAS int* tabi; const LAS int* pend; const LAS int* pcnt;
    __device__ __forceinline__ void operator()(const f32x4 (&acc)[2][2][4][2], const Unit& u, int wr, int wc, int fr, int fq) const {
        int e = 0; while (e < NEXP - 1 && pend[e] <= u.pm) ++e;
        const int lp = u.pm - (e ? pend[e - 1] : 0), cnt = pcnt[e] - lp * 256; const unsigned base = (unsigned)(e * MOE_CAP + lp * 256);
        int yd[2][4]; float sw[2][4];
#pragma unroll
        for (int ai = 0; ai < 2; ++ai)
#pragma unroll
            for (int m = 0; m < 4; ++m) { const int r = ai * 128 + wr * 64 + m * 16 + fr; const GAS int* en = tabi + (size_t)(base + r) * 4; const int y_ = en[2]; const float w_ = __int_as_float(en[3]);
                yd[ai][m] = (r < cnt) ? y_ : -1; sw[ai][m] = w_; }
#pragma unroll
        for (int ai = 0; ai < 2; ++ai)
#pragma unroll
            for (int m = 0; m < 4; ++m) { const float sc = sw[ai][m];
                if (yd[ai][m] >= 0) {
#pragma unroll
                    for (int bj = 0; bj < 2; ++bj) { const f32x4 v0 = acc[ai][bj][m][0] * sc, v1 = acc[ai][bj][m][1] * sc;
                        u32x4 w; w.x = cvt_pk_bf16(v0[0], v0[1]); w.y = cvt_pk_bf16(v0[2], v0[3]); w.z = cvt_pk_bf16(v1[0], v1[1]); w.w = cvt_pk_bf16(v1[2], v1[3]);
                        *(GAS u32x4*)(ybuf + (size_t)yd[ai][m] * 1024 + EPI_COL(bj)) = w; } } }
    }
};

typedef int v4i32_t __attribute__((ext_vector_type(4)));
typedef long i64x2_t __attribute__((ext_vector_type(2)));
template <class Epi, class Sched, bool I8 = false, bool MID = false, bool F8 = false, bool ALIGN_EPI = true, bool SP2 = true>
__device__ __forceinline__ void gemm_phase(LAS unsigned char* lds, const Gemm g, const Sched& S, const Epi& E) {
    int tid_ = threadIdx.x; asm volatile("" : "+v"(tid_));
    const int tid = tid_, wid = __builtin_amdgcn_readfirstlane(tid >> 6), lane = tid & 63, wr = wid >> 2, wc = wid & 3, fr = lane & 15, fq = lane >> 4;
    int K_ = g.K; asm volatile("" : "+s"(K_));
    const int K = K_, nt = K / BK;
    unsigned voffA[2], voffB[2];
#pragma unroll
    for (int i = 0; i < 2; ++i) { int R, C; stage_rc(tid * 16 + i * 8192, R, C); const int Rb = Epi::PERM ? ((R & ~31) + perm32(R & 31)) : R;
        voffA[i] = (unsigned)(R * g.lda + C) * 2u; voffB[i] = (unsigned)(Rb * g.ldb + C) * 2u; }
    const size_t kstep = (size_t)(BK * 2);
    const size_t hstepA = (size_t)HALF * g.lda * 2, hstepB = (size_t)HALF * g.ldb * 2;
    const unsigned ldsw = (unsigned)wid * 1024u;
    const int aoff = lds_byte(wr * 64 + fr, fq * 8), boff = lds_byte(wc * 32 + fr, fq * 8);
#define PG8_SA(b, h) (((b) * 2 + (h)) * HTB)
#define PG8_SB(b, h) ((4 + (b) * 2 + (h)) * HTB)
#define PG8_STAGE(bufoff, gbase, voff) do { _Pragma("unroll") for (int _i = 0; _i < 2; ++_i) \
        __builtin_amdgcn_global_load_lds((const GAS unsigned*)((const char*)(gbase) + (voff)[_i]), (LAS unsigned*)(lds + (bufoff) + ldsw + _i * 8192), 16, 0, 0); } while (0)
#define PG8_LDA(dst, b, h) do { _Pragma("unroll") for (int m = 0; m < 4; ++m) _Pragma("unroll") for (int k = 0; k < 2; ++k) dst[m][k] = *(const LAS bf16x8*)(lds + PG8_SA(b, h) + aoff + m * 2048 + k * 1024); } while (0)
#define PG8_LDB(dst, b, h) do { _Pragma("unroll") for (int n = 0; n < 2; ++n) _Pragma("unroll") for (int k = 0; k < 2; ++k) dst[n][k] = *(const LAS bf16x8*)(lds + PG8_SB(b, h) + boff + n * 2048 + k * 1024); } while (0)
#define PG8_MMA(ai, bj, At, Bt) do { __builtin_amdgcn_s_setprio(1); _Pragma("unroll") for (int m = 0; m < 4; ++m) _Pragma("unroll") for (int n = 0; n < 2; ++n) _Pragma("unroll") for (int k = 0; k < 2; ++k) { \
        if constexpr (I8) acc[ai][bj][m][n] = __builtin_bit_cast(f32x4, __builtin_amdgcn_mfma_i32_16x16x64_i8(__builtin_bit_cast(v4i32_t, Bt[n][k]), __builtin_bit_cast(v4i32_t, At[m][k]), __builtin_bit_cast(v4i32_t, acc[ai][bj][m][n]), 0, 0, 0)); \
        else if constexpr (F8) { const i64x2_t b_ = __builtin_bit_cast(i64x2_t, Bt[n][k]), a_ = __builtin_bit_cast(i64x2_t, At[m][k]); \
            acc[ai][bj][m][n] = __builtin_amdgcn_mfma_f32_16x16x32_fp8_fp8(b_[0], a_[0], acc[ai][bj][m][n], 0, 0, 0); acc[ai][bj][m][n] = __builtin_amdgcn_mfma_f32_16x16x32_fp8_fp8(b_[1], a_[1], acc[ai][bj][m][n], 0, 0, 0); } \
        else acc[ai][bj][m][n] = __builtin_amdgcn_mfma_f32_16x16x32_bf16(Bt[n][k], At[m][k], acc[ai][bj][m][n], 0, 0, 0); } \
        __builtin_amdgcn_s_setprio(0); } while (0)
#define PG8_WAIT_V(n) asm volatile("s_waitcnt vmcnt(" #n ")" ::: "memory")
#define PG8_WAIT_L(n) asm volatile("s_waitcnt lgkmcnt(" #n ")" ::: "memory")
#define PG8_BAR __builtin_amdgcn_s_barrier()
#define PG8_SCHED __builtin_amdgcn_sched_barrier(0)
    Unit cur, nxt; int ui = 0;
    if (!S.next(0, cur)) return;
    unsigned gvc[2][2], gvn[2][2];
    if constexpr (Sched::GATHER) { S.gather(g, cur, tid, gvc); gvn[0][0] = gvc[0][0]; gvn[0][1] = gvc[0][1]; gvn[1][0] = gvc[1][0]; gvn[1][1] = gvc[1][1]; }
#define PG8_STAGE_A(b, h, aptr, ko, nx) do { if constexpr (Sched::GATHER) { unsigned sv_[2] = {(nx) ? gvn[h][0] : gvc[h][0], (nx) ? gvn[h][1] : gvc[h][1]}; PG8_STAGE(PG8_SA(b, h), (const char*)g.A + (ko), sv_); } \
        else PG8_STAGE(PG8_SA(b, h), (aptr), voffA); } while (0)
    f32x4 acc[2][2][4][2];
#pragma unroll
    for (int a = 0; a < 2; ++a)
#pragma unroll
        for (int b = 0; b < 2; ++b)
#pragma unroll
            for (int m = 0; m < 4; ++m)
#pragma unroll
                for (int n = 0; n < 2; ++n) acc[a][b][m][n] = (f32x4){0.f, 0.f, 0.f, 0.f};
    bf16x8 At[4][2], B0[2][2], B1[2][2];
    const char* cA = (const char*)g.A + S.aoff(g, cur); const char* cB = (const char*)g.Bt + S.boff(g, cur);
    const int ntm = nt - 1;
#define PG8_ROT(u_) ((MID || nt < 4) ? 0 : (((u_).pn & 3) * (nt >> 2)))
#define PG8_KO(rot_, t_) ((size_t)(((t_) + (rot_)) & ntm) * kstep)
    int rotc = PG8_ROT(cur);
    if constexpr (SP2) {
        PG8_STAGE(PG8_SB(0, 0), cB + PG8_KO(rotc, 0), voffB); PG8_STAGE(PG8_SB(0, 1), cB + hstepB + PG8_KO(rotc, 0), voffB); PG8_STAGE_A(0, 0, cA + PG8_KO(rotc, 0), PG8_KO(rotc, 0), false); PG8_STAGE_A(0, 1, cA + hstepA + PG8_KO(rotc, 0), PG8_KO(rotc, 0), false);
        if (wr == 1) PG8_BAR;
        PG8_WAIT_V(2); PG8_BAR;
        PG8_STAGE(PG8_SB(1, 0), cB + PG8_KO(rotc, 1), voffB); PG8_STAGE_A(1, 0, cA + PG8_KO(rotc, 1), PG8_KO(rotc, 1), false); PG8_STAGE(PG8_SB(1, 1), cB + hstepB + PG8_KO(rotc, 1), voffB);
        PG8_WAIT_V(6); PG8_BAR;
    }
    for (;;) {
        const bool has_next = S.next(ui + 1, nxt);
        const char* nA = has_next ? (const char*)g.A + S.aoff(g, nxt) : cA; const char* nB = has_next ? (const char*)g.Bt + S.boff(g, nxt) : cB;
        const int rotn = has_next ? PG8_ROT(nxt) : rotc;
        if constexpr (Sched::GATHER) { if (has_next) S.gather(g, nxt, tid, gvn); }
        for (int t = 0; t < nt; t += 2) {
            if constexpr (MID) { if (t == (nt >> 1)) E.mid(acc, cur, wr, wc, fr, fq); }
            const bool last = (t == nt - 2);
            const char* a1 = cA + PG8_KO(rotc, t + 1);
            const char* a2 = last ? nA + PG8_KO(rotn, 0) : cA + PG8_KO(rotc, t + 2); const char* b2 = last ? nB + PG8_KO(rotn, 0) : cB + PG8_KO(rotc, t + 2);
            const char* a3 = last ? nA + PG8_KO(rotn, 1) : cA + PG8_KO(rotc, t + 3); const char* b3 = last ? nB + PG8_KO(rotn, 1) : cB + PG8_KO(rotc, t + 3);
            const size_t ko1 = PG8_KO(rotc, t + 1), ko2 = last ? PG8_KO(rotn, 0) : PG8_KO(rotc, t + 2), ko3 = last ? PG8_KO(rotn, 1) : PG8_KO(rotc, t + 3); (void)ko1; (void)ko2; (void)ko3;
            PG8_LDB(B0, 0, 0); PG8_LDB(B1, 0, 1); PG8_SCHED; PG8_LDA(At, 0, 0); PG8_STAGE_A(1, 1, a1 + hstepA, ko1, false);
            PG8_WAIT_V(8); PG8_WAIT_L(0); PG8_BAR; PG8_MMA(0, 0, At, B0); PG8_MMA(0, 1, At, B1); PG8_BAR; PG8_SCHED;
            PG8_LDA(At, 0, 1); PG8_STAGE(PG8_SB(0, 0), b2, voffB); PG8_STAGE(PG8_SB(0, 1), b2 + hstepB, voffB); PG8_STAGE_A(0, 0, a2, ko2, last);
            PG8_WAIT_V(8); PG8_WAIT_L(0); PG8_BAR; PG8_MMA(1, 0, At, B0); PG8_MMA(1, 1, At, B1); PG8_BAR; PG8_SCHED;
            PG8_LDB(B0, 1, 0); PG8_LDB(B1, 1, 1); PG8_SCHED; PG8_LDA(At, 1, 0); PG8_STAGE_A(0, 1, a2 + hstepA, ko2, last);
            PG8_WAIT_V(8); PG8_WAIT_L(0); PG8_BAR; PG8_MMA(0, 0, At, B0); PG8_MMA(0, 1, At, B1); PG8_BAR; PG8_SCHED;
            PG8_LDA(At, 1, 1); PG8_STAGE(PG8_SB(1, 0), b3, voffB); PG8_STAGE(PG8_SB(1, 1), b3 + hstepB, voffB); PG8_STAGE_A(1, 0, a3, ko3, last);
            PG8_WAIT_V(8); PG8_WAIT_L(0); PG8_BAR; PG8_MMA(1, 0, At, B0); PG8_MMA(1, 1, At, B1); PG8_BAR; PG8_SCHED;
        }
        if constexpr (ALIGN_EPI) { if (wr == 0) PG8_BAR; }
        if constexpr (I8) {
#pragma unroll
            for (int a = 0; a < 2; ++a)
#pragma unroll
                for (int b = 0; b < 2; ++b)
#pragma unroll
                    for (int m = 0; m < 4; ++m)
#pragma unroll
                        for (int n = 0; n < 2; ++n) { const v4i32_t q = __builtin_bit_cast(v4i32_t, acc[a][b][m][n]); acc[a][b][m][n] = (f32x4){(float)q[0], (float)q[1], (float)q[2], (float)q[3]}; }
        }
        E(acc, cur, wr, wc, fr, fq);
        if (!has_next) break;
#pragma unroll
        for (int a = 0; a < 2; ++a)
#pragma unroll
            for (int b = 0; b < 2; ++b)
#pragma unroll
                for (int m = 0; m < 4; ++m)
#pragma unroll
                    for (int n = 0; n < 2; ++n) acc[a][b][m][n] = (f32x4){0.f, 0.f, 0.f, 0.f};
        cur = nxt; cA = nA; cB = nB; rotc = rotn; ++ui;
        if constexpr (Sched::GATHER) { gvc[0][0] = gvn[0][0]; gvc[0][1] = gvn[0][1]; gvc[1][0] = gvn[1][0]; gvc[1][1] = gvn[1][1]; }
        if constexpr (ALIGN_EPI) { if (wr == 1) PG8_BAR; }
    }
    PG8_WAIT_V(0);
    if constexpr (!ALIGN_EPI) { if (wr == 0) PG8_BAR; }
    PG8_BAR;
#undef PG8_SA
#undef PG8_SB
#undef PG8_STAGE
#undef PG8_STAGE_A
#undef PG8_LDA
#undef PG8_LDB
#undef PG8_MMA
#undef PG8_ROT
#undef PG8_KO
#undef PG8_WAIT_V
#undef PG8_WAIT_L
#undef PG8_BAR
#undef PG8_SCHED
}
}

namespace att {
typedef LAS const char* lds_cptr;
typedef short v4i16_t __attribute__((ext_vector_type(4)));
typedef float f32x2_t __attribute__((ext_vector_type(2))); typedef __bf16 bf16x2_t __attribute__((ext_vector_type(2)));
__device__ __forceinline__ int crow(int r, int hi) { return (r & 3) + 8 * (r >> 2) + 4 * hi; }
__device__ __forceinline__ void glds16(const GAS void* gsrc, unsigned lds_dst) { unsigned keep;
    asm volatile("s_mov_b32 %0, m0\n\ts_mov_b32 m0, %2\n\ts_nop 0\n\tglobal_load_lds_dwordx4 %1, off\n\ts_mov_b32 m0, %0" : "=&s"(keep) : "v"(gsrc), "s"(lds_dst) : "memory"); }
__device__ __forceinline__ void glds16s(const GAS void* sbase, unsigned voff, unsigned lds_dst) { unsigned keep;
    asm volatile("s_mov_b32 %0, m0\n\ts_mov_b32 m0, %3\n\ts_nop 0\n\tglobal_load_lds_dwordx4 %1, %2\n\ts_mov_b32 m0, %0" : "=&s"(keep) : "v"(voff), "s"(sbase), "s"(lds_dst) : "memory"); }
__device__ __forceinline__ unsigned cvtpk_s(float lo, float hi) { f32x2_t v = {lo, hi}; bf16x2_t b = __builtin_convertvector(v, bf16x2_t); return __builtin_bit_cast(unsigned, b); }
#define ATT_WAIT_BAR() asm volatile("s_waitcnt vmcnt(0) lgkmcnt(0)\n\ts_barrier" ::: "memory")
constexpr float THR = 8.0f;

template <int NQ> __device__ __forceinline__ void qk_tile(f32x16& p0, f32x16& p1, lds_cptr kslot, const bf16x8* qr, const f32x16& negm, int r32, int hi) {
    lds_cptr kb = kslot + hi * 1024 + r32 * 16;
    p0 = negm; p1 = negm;
#pragma unroll
    for (int d0 = 0; d0 < NQ; ++d0) {
        const bf16x8 b0 = *(const LAS bf16x8*)(kb + d0 * 2048);
        const bf16x8 b1 = *(const LAS bf16x8*)(kb + d0 * 2048 + 512);
        p0 = __builtin_amdgcn_mfma_f32_32x32x16_bf16(b0, qr[d0], p0, 0, 0, 0);
        p1 = __builtin_amdgcn_mfma_f32_32x32x16_bf16(b1, qr[d0], p1, 0, 0, 0);
    }
}
__device__ __forceinline__ void pv(f32x16* o, int vb, bf16x8 pa0, bf16x8 pa1, bf16x8 pa2, bf16x8 pa3) {
#pragma unroll
    for (int d0 = 0; d0 < 2; ++d0) { s16x4 lo[4], hi[4];
#pragma unroll
        for (int ks = 0; ks < 4; ++ks) {
            asm volatile("ds_read_b64_tr_b16 %0,%1 offset:%c2" : "=&v"(lo[ks]) : "v"(vb), "i"(d0 * 4096 + ks * 1024) : "memory");
            asm volatile("ds_read_b64_tr_b16 %0,%1 offset:%c2" : "=&v"(hi[ks]) : "v"(vb), "i"(d0 * 4096 + ks * 1024 + 512) : "memory"); }
        asm volatile("s_waitcnt lgkmcnt(0)" ::: "memory"); __builtin_amdgcn_sched_barrier(0);
#define PK(k) (bf16x8){lo[k][0], lo[k][1], lo[k][2], lo[k][3], hi[k][0], hi[k][1], hi[k][2], hi[k][3]}
        o[d0] = __builtin_amdgcn_mfma_f32_32x32x16_bf16(pa0, PK(0), o[d0], 0, 0, 0);
        o[d0] = __builtin_amdgcn_mfma_f32_32x32x16_bf16(pa1, PK(1), o[d0], 0, 0, 0);
        o[d0] = __builtin_amdgcn_mfma_f32_32x32x16_bf16(pa2, PK(2), o[d0], 0, 0, 0);
        o[d0] = __builtin_amdgcn_mfma_f32_32x32x16_bf16(pa3, PK(3), o[d0], 0, 0, 0);
#undef PK
    }
}
__device__ __forceinline__ void softmax_pv(f32x16& p0, f32x16& p1, float& mhat, float& l_reg, f32x16& negm, f32x16* o, bool first, LAS float* wsf, int vb, int r32, int hi) {
    float a = __builtin_fmaxf(p0[0], p1[0]);
#pragma unroll
    for (int r = 1; r < 16; ++r) a = __builtin_fmaxf(a, __builtin_fmaxf(p0[r], p1[r]));
    float rm = a;
    { auto rr = __builtin_amdgcn_permlane32_swap(__float_as_uint(rm), __float_as_uint(rm), false, false); rm = __builtin_fmaxf(__uint_as_float(rr[0]), __uint_as_float(rr[1])); }
    if (first) {
        const float dl = rm; mhat += dl;
#pragma unroll
        for (int r = 0; r < 16; ++r) { p0[r] -= dl; p1[r] -= dl; }
#pragma unroll
        for (int r = 0; r < 16; ++r) negm[r] = -mhat;
    } else if (__any(rm > THR)) {
        const float dl = __builtin_fmaxf(rm, 0.f); mhat += dl;
#pragma unroll
        for (int r = 0; r < 16; ++r) { p0[r] -= dl; p1[r] -= dl; }
#pragma unroll
        for (int r = 0; r < 16; ++r) negm[r] = -mhat;
        const float f = __builtin_amdgcn_exp2f(-dl); l_reg *= f;
        if (hi == 0) wsf[r32] = f;
        LDS_WAIT();
#pragma unroll
        for (int r = 0; r < 16; ++r) { const float fr_ = wsf[crow(r, hi)]; o[0][r] *= fr_; o[1][r] *= fr_; }
        LDS_WAIT();
    }
    float sacc = 0.f;
#pragma unroll
    for (int r = 0; r < 16; ++r) { p0[r] = __builtin_amdgcn_exp2f(p0[r]); p1[r] = __builtin_amdgcn_exp2f(p1[r]); sacc += p0[r] + p1[r]; }
    l_reg += sacc;
    u32x4 pw0, pw1, pw2, pw3;
    pw0 = (u32x4){cvtpk_s(p0[0], p0[1]), cvtpk_s(p0[2], p0[3]), cvtpk_s(p0[4], p0[5]), cvtpk_s(p0[6], p0[7])};
    pw1 = (u32x4){cvtpk_s(p0[8], p0[9]), cvtpk_s(p0[10], p0[11]), cvtpk_s(p0[12], p0[13]), cvtpk_s(p0[14], p0[15])};
    pw2 = (u32x4){cvtpk_s(p1[0], p1[1]), cvtpk_s(p1[2], p1[3]), cvtpk_s(p1[4], p1[5]), cvtpk_s(p1[6], p1[7])};
    pw3 = (u32x4){cvtpk_s(p1[8], p1[9]), cvtpk_s(p1[10], p1[11]), cvtpk_s(p1[12], p1[13]), cvtpk_s(p1[14], p1[15])};
    pv(o, vb, __builtin_bit_cast(bf16x8, pw0), __builtin_bit_cast(bf16x8, pw1), __builtin_bit_cast(bf16x8, pw2), __builtin_bit_cast(bf16x8, pw3));
}
__device__ __forceinline__ void softmax_pv_fixed(f32x16& p0, f32x16& p1, float& l_reg, f32x16* o, int vb) {
    float sacc = 0.f;
#pragma unroll
    for (int r = 0; r < 16; ++r) { p0[r] = __builtin_amdgcn_exp2f(p0[r]); p1[r] = __builtin_amdgcn_exp2f(p1[r]); sacc += p0[r] + p1[r]; }
    l_reg += sacc;
    u32x4 pw0, pw1, pw2, pw3;
    pw0 = (u32x4){cvtpk_s(p0[0], p0[1]), cvtpk_s(p0[2], p0[3]), cvtpk_s(p0[4], p0[5]), cvtpk_s(p0[6], p0[7])};
    pw1 = (u32x4){cvtpk_s(p0[8], p0[9]), cvtpk_s(p0[10], p0[11]), cvtpk_s(p0[12], p0[13]), cvtpk_s(p0[14], p0[15])};
    pw2 = (u32x4){cvtpk_s(p1[0], p1[1]), cvtpk_s(p1[2], p1[3]), cvtpk_s(p1[4], p1[5]), cvtpk_s(p1[6], p1[7])};
    pw3 = (u32x4){cvtpk_s(p1[8], p1[9]), cvtpk_s(p1[10], p1[11]), cvtpk_s(p1[12], p1[13]), cvtpk_s(p1[14], p1[15])};
    pv(o, vb, __builtin_bit_cast(bf16x8, pw0), __builtin_bit_cast(bf16x8, pw1), __builtin_bit_cast(bf16x8, pw2), __builtin_bit_cast(bf16x8, pw3));
}
__device__ __forceinline__ void store_o(const f32x16* o, float l_reg, LAS float* wsf, LAS bf16_t* stg, GAS bf16_t* Ow, int pitch, int lane, int r32, int hi) {
    { auto rr = __builtin_amdgcn_permlane32_swap(__float_as_uint(l_reg), __float_as_uint(l_reg), false, false); l_reg = __uint_as_float(rr[0]) + __uint_as_float(rr[1]); }
    if (hi == 0) wsf[32 + r32] = l_reg;
    LDS_WAIT();
    float rli[16];
#pragma unroll
    for (int r = 0; r < 16; ++r) rli[r] = __builtin_amdgcn_rcpf(wsf[32 + crow(r, hi)]);
#pragma unroll
    for (int r = 0; r < 16; ++r) { const int orow = crow(r, hi);
#pragma unroll
        for (int d0 = 0; d0 < 2; ++d0) stg[orow * 64 + d0 * 32 + r32] = (bf16_t)(cvt_pk_bf16(o[d0][r] * rli[r], 0.f) & 0xffffu); }
    LDS_WAIT();
#pragma unroll
    for (int i = 0; i < 4; ++i) { const int row = i * 8 + (lane >> 3), ch = lane & 7; const u32x4 v = *(const LAS u32x4*)(stg + row * 64 + ch * 8); *(GAS u32x4*)(Ow + (size_t)row * pitch + ch * 8) = v; }
    LDS_WAIT();
}

constexpr int M_NS = 4, M_KSLOT = 12288, M_VSLOT = 8192, M_LK = 0, M_LV = M_NS * M_KSLOT, M_LWS = M_LV + M_NS * M_VSLOT, M_LOST = M_LWS + 2048, M_LDS = M_LOST + 32768;
#define ATT_WAITN_BAR(N) asm volatile("s_waitcnt vmcnt(" #N ") lgkmcnt(0)\n\ts_barrier" ::: "memory")
__device__ __forceinline__ void mla_load_q(bf16x8 (&qr)[6], const GAS bf16_t* Qrow, const GAS float* gbq, const GAS float* rope, int pos, int hi) {
#pragma unroll
    for (int d0 = 0; d0 < 6; ++d0) qr[d0] = *(const GAS bf16x8*)(Qrow + d0 * 16 + hi * 8);
    float f[6][8]; float ss = 0.f;
#pragma unroll
    for (int d0 = 0; d0 < 6; ++d0) { const u32x4 w = __builtin_bit_cast(u32x4, qr[d0]);
        f[d0][0] = bflo(w.x); f[d0][1] = bfhi(w.x); f[d0][2] = bflo(w.y); f[d0][3] = bfhi(w.y); f[d0][4] = bflo(w.z); f[d0][5] = bfhi(w.z); f[d0][6] = bflo(w.w); f[d0][7] = bfhi(w.w);
#pragma unroll
        for (int j = 0; j < 8; ++j) ss += f[d0][j] * f[d0][j]; }
    ss += __shfl_xor(ss, 32);
    const float rs = __builtin_amdgcn_rsqf(ss * (1.0f / 96.0f) + EPS) * C2B;
#pragma unroll
    for (int d0 = 0; d0 < 6; ++d0) { const f32x4 g0 = *(const GAS f32x4*)(gbq + 16 * d0 + 8 * hi), g1 = *(const GAS f32x4*)(gbq + 16 * d0 + 8 * hi + 4);
        f[d0][0] *= rs * g0.x; f[d0][1] *= rs * g0.y; f[d0][2] *= rs * g0.z; f[d0][3] *= rs * g0.w; f[d0][4] *= rs * g1.x; f[d0][5] *= rs * g1.y; f[d0][6] *= rs * g1.z; f[d0][7] *= rs * g1.w; }
    { const GAS float* rp = rope + (size_t)pos * 32 + 8 * hi; const f32x4 c0 = *(const GAS f32x4*)rp, c1 = *(const GAS f32x4*)(rp + 4), s0 = *(const GAS f32x4*)(rp + 16), s1 = *(const GAS f32x4*)(rp + 20);
      const float cs[8] = {c0.x, c0.y, c0.z, c0.w, c1.x, c1.y, c1.z, c1.w}, sn[8] = {s0.x, s0.y, s0.z, s0.w, s1.x, s1.y, s1.z, s1.w};
#pragma unroll
      for (int j = 0; j < 8; ++j) { const float a = f[4][j], c = f[5][j]; f[4][j] = a * cs[j] - c * sn[j]; f[5][j] = a * sn[j] + c * cs[j]; } }
#pragma unroll
    for (int d0 = 0; d0 < 6; ++d0) { u32x4 w; w.x = cvt_pk_bf16(f[d0][0], f[d0][1]); w.y = cvt_pk_bf16(f[d0][2], f[d0][3]); w.z = cvt_pk_bf16(f[d0][4], f[d0][5]); w.w = cvt_pk_bf16(f[d0][6], f[d0][7]); qr[d0] = __builtin_bit_cast(bf16x8, w); }
}
__device__ __forceinline__ void qk_tile2(f32x16& a0, f32x16& a1, f32x16& b0, f32x16& b1, lds_cptr kslot, const bf16x8* qa, const bf16x8* qb, int r32, int hi) {
    lds_cptr kb = kslot + hi * 1024 + r32 * 16;
    a0 = f32x16{}; a1 = f32x16{}; b0 = f32x16{}; b1 = f32x16{};
    bf16x8 k0 = *(const LAS bf16x8*)(kb), k1 = *(const LAS bf16x8*)(kb + 512);
#pragma unroll
    for (int d0 = 0; d0 < 6; ++d0) {
        bf16x8 n0 = k0, n1 = k1;
        if (d0 < 5) { n0 = *(const LAS bf16x8*)(kb + (d0 + 1) * 2048); n1 = *(const LAS bf16x8*)(kb + (d0 + 1) * 2048 + 512); }
        __builtin_amdgcn_sched_barrier(0);
        a0 = __builtin_amdgcn_mfma_f32_32x32x16_bf16(k0, qa[d0], a0, 0, 0, 0);
        a1 = __builtin_amdgcn_mfma_f32_32x32x16_bf16(k1, qa[d0], a1, 0, 0, 0);
        b0 = __builtin_amdgcn_mfma_f32_32x32x16_bf16(k0, qb[d0], b0, 0, 0, 0);
        b1 = __builtin_amdgcn_mfma_f32_32x32x16_bf16(k1, qb[d0], b1, 0, 0, 0);
        __builtin_amdgcn_sched_barrier(0);
        k0 = n0; k1 = n1;
    }
}
__device__ __forceinline__ void exp_pack(f32x16& p0, f32x16& p1, float& l_reg, bf16x8 (&pa)[4], float sub) {
    float sacc = 0.f;
    if (sub != 0.f) {
#pragma unroll
        for (int r = 0; r < 16; ++r) { p0[r] -= sub; p1[r] -= sub; } }
#pragma unroll
    for (int r = 0; r < 16; ++r) { p0[r] = __builtin_amdgcn_exp2f(p0[r]); p1[r] = __builtin_amdgcn_exp2f(p1[r]); sacc += p0[r] + p1[r]; }
    l_reg += sacc;
    pa[0] = __builtin_bit_cast(bf16x8, (u32x4){cvtpk_s(p0[0], p0[1]), cvtpk_s(p0[2], p0[3]), cvtpk_s(p0[4], p0[5]), cvtpk_s(p0[6], p0[7])});
    pa[1] = __builtin_bit_cast(bf16x8, (u32x4){cvtpk_s(p0[8], p0[9]), cvtpk_s(p0[10], p0[11]), cvtpk_s(p0[12], p0[13]), cvtpk_s(p0[14], p0[15])});
    pa[2] = __builtin_bit_cast(bf16x8, (u32x4){cvtpk_s(p1[0], p1[1]), cvtpk_s(p1[2], p1[3]), cvtpk_s(p1[4], p1[5]), cvtpk_s(p1[6], p1[7])});
    pa[3] = __builtin_bit_cast(bf16x8, (u32x4){cvtpk_s(p1[8], p1[9]), cvtpk_s(p1[10], p1[11]), cvtpk_s(p1[12], p1[13]), cvtpk_s(p1[14], p1[15])});
}
__device__ __forceinline__ void pv2(f32x16* oa, f32x16* ob, int vb, const bf16x8 (&pa)[4], const bf16x8 (&pb)[4], bool doA, bool doB) {
    s16x4 lo[2][4], hi[2][4];
#pragma unroll
    for (int d0 = 0; d0 < 2; ++d0)
#pragma unroll
        for (int ks = 0; ks < 4; ++ks) {
            asm volatile("ds_read_b64_tr_b16 %0,%1 offset:%c2" : "=&v"(lo[d0][ks]) : "v"(vb), "i"(d0 * 4096 + ks * 1024) : "memory");
            asm volatile("ds_read_b64_tr_b16 %0,%1 offset:%c2" : "=&v"(hi[d0][ks]) : "v"(vb), "i"(d0 * 4096 + ks * 1024 + 512) : "memory"); }
#define PK(d, k) (bf16x8){lo[d][k][0], lo[d][k][1], lo[d][k][2], lo[d][k][3], hi[d][k][0], hi[d][k][1], hi[d][k][2], hi[d][k][3]}
#pragma unroll
    for (int d0 = 0; d0 < 2; ++d0) {
        if (d0 == 0) asm volatile("s_waitcnt lgkmcnt(8)" ::: "memory"); else asm volatile("s_waitcnt lgkmcnt(0)" ::: "memory");
        __builtin_amdgcn_sched_barrier(0);
        if (doA) {
#pragma unroll
            for (int k = 0; k < 4; ++k) oa[d0] = __builtin_amdgcn_mfma_f32_32x32x16_bf16(pa[k], PK(d0, k), oa[d0], 0, 0, 0); }
        if (doB) {
#pragma unroll
            for (int k = 0; k < 4; ++k) ob[d0] = __builtin_amdgcn_mfma_f32_32x32x16_bf16(pb[k], PK(d0, k), ob[d0], 0, 0, 0); }
    }
#undef PK
}
__device__ __forceinline__ void qk_one(f32x16& a0, f32x16& a1, lds_cptr kslot, const bf16x8* qa, int r32, int hi) {
    lds_cptr kb = kslot + hi * 1024 + r32 * 16;
    a0 = f32x16{}; a1 = f32x16{};
    bf16x8 k0 = *(const LAS bf16x8*)(kb), k1 = *(const LAS bf16x8*)(kb + 512);
#pragma unroll
    for (int d0 = 0; d0 < 6; ++d0) {
        bf16x8 n0 = k0, n1 = k1;
        if (d0 < 5) { n0 = *(const LAS bf16x8*)(kb + (d0 + 1) * 2048); n1 = *(const LAS bf16x8*)(kb + (d0 + 1) * 2048 + 512); }
        __builtin_amdgcn_sched_barrier(0);
        a0 = __builtin_amdgcn_mfma_f32_32x32x16_bf16(k0, qa[d0], a0, 0, 0, 0);
        a1 = __builtin_amdgcn_mfma_f32_32x32x16_bf16(k1, qa[d0], a1, 0, 0, 0);
        __builtin_amdgcn_sched_barrier(0);
        k0 = n0; k1 = n1;
    }
}
__device__ __forceinline__ void qkB_expA(f32x16& b0, f32x16& b1, f32x16& pA0, f32x16& pA1, float& la, bf16x8 (&pa)[4], lds_cptr kslot, const bf16x8* qb, int r32, int hi) {
    lds_cptr kb = kslot + hi * 1024 + r32 * 16;
    b0 = f32x16{}; b1 = f32x16{};
    bf16x8 k0 = *(const LAS bf16x8*)(kb), k1 = *(const LAS bf16x8*)(kb + 512);
    float sacc = 0.f;
#define EXPG(g) do { f32x16& P_ = ((g) < 4) ? pA0 : pA1; constexpr int r0_ = 4 * ((g) & 3); \
        float e0_ = __builtin_amdgcn_exp2f(P_[r0_]), e1_ = __builtin_amdgcn_exp2f(P_[r0_ + 1]), e2_ = __builtin_amdgcn_exp2f(P_[r0_ + 2]), e3_ = __builtin_amdgcn_exp2f(P_[r0_ + 3]); \
        sacc += (e0_ + e1_) + (e2_ + e3_); asm volatile("" : "+v"(e0_), "+v"(e1_), "+v"(e2_), "+v"(e3_), "+v"(sacc)); P_[r0_] = e0_; P_[r0_ + 1] = e1_; P_[r0_ + 2] = e2_; P_[r0_ + 3] = e3_; } while (0)
#define PACK(j) do { const f32x16& P_ = ((j) < 2) ? pA0 : pA1; constexpr int r0_ = 8 * ((j) & 1); u32x4 w_ = {cvtpk_s(P_[r0_], P_[r0_ + 1]), cvtpk_s(P_[r0_ + 2], P_[r0_ + 3]), cvtpk_s(P_[r0_ + 4], P_[r0_ + 5]), cvtpk_s(P_[r0_ + 6], P_[r0_ + 7])}; \
        asm volatile("" : "+v"(w_)); pa[j] = __builtin_bit_cast(bf16x8, w_); } while (0)
#pragma unroll
    for (int d0 = 0; d0 < 6; ++d0) {
        bf16x8 n0 = k0, n1 = k1;
        if (d0 < 5) { n0 = *(const LAS bf16x8*)(kb + (d0 + 1) * 2048); n1 = *(const LAS bf16x8*)(kb + (d0 + 1) * 2048 + 512); }
        __builtin_amdgcn_sched_barrier(0);
        b0 = __builtin_amdgcn_mfma_f32_32x32x16_bf16(k0, qb[d0], b0, 0, 0, 0);
        if (d0 == 0) EXPG(0); else if (d0 == 1) EXPG(2); else if (d0 == 2) EXPG(4); else if (d0 == 3) EXPG(6); else if (d0 == 4) PACK(0); else PACK(2);
        __builtin_amdgcn_sched_barrier(0);
        b1 = __builtin_amdgcn_mfma_f32_32x32x16_bf16(k1, qb[d0], b1, 0, 0, 0);
        if (d0 == 0) EXPG(1); else if (d0 == 1) EXPG(3); else if (d0 == 2) EXPG(5); else if (d0 == 3) EXPG(7); else if (d0 == 4) PACK(1); else PACK(3);
        __builtin_amdgcn_sched_barrier(0);
        k0 = n0; k1 = n1;
    }
#undef EXPG
#undef PACK
    la += sacc;
}
__device__ __forceinline__ void tail_pvA_expB_pvB(f32x16& pB0, f32x16& pB1, float& lb, const bf16x8 (&pa)[4], f32x16* oa, f32x16* ob, int vb) {
    s16x4 lo[2][4], hi[2][4];
#pragma unroll
    for (int d0 = 0; d0 < 2; ++d0)
#pragma unroll
        for (int ks = 0; ks < 4; ++ks) {
            asm volatile("ds_read_b64_tr_b16 %0,%1 offset:%c2" : "=&v"(lo[d0][ks]) : "v"(vb), "i"(d0 * 4096 + ks * 1024) : "memory");
            asm volatile("ds_read_b64_tr_b16 %0,%1 offset:%c2" : "=&v"(hi[d0][ks]) : "v"(vb), "i"(d0 * 4096 + ks * 1024 + 512) : "memory"); }
#define PK(d, k) (bf16x8){lo[d][k][0], lo[d][k][1], lo[d][k][2], lo[d][k][3], hi[d][k][0], hi[d][k][1], hi[d][k][2], hi[d][k][3]}
#define EXPG(g) do { f32x16& P_ = ((g) < 4) ? pB0 : pB1; constexpr int r0_ = 4 * ((g) & 3); \
        float e0_ = __builtin_amdgcn_exp2f(P_[r0_]), e1_ = __builtin_amdgcn_exp2f(P_[r0_ + 1]), e2_ = __builtin_amdgcn_exp2f(P_[r0_ + 2]), e3_ = __builtin_amdgcn_exp2f(P_[r0_ + 3]); \
        sacc += (e0_ + e1_) + (e2_ + e3_); asm volatile("" : "+v"(e0_), "+v"(e1_), "+v"(e2_), "+v"(e3_), "+v"(sacc)); P_[r0_] = e0_; P_[r0_ + 1] = e1_; P_[r0_ + 2] = e2_; P_[r0_ + 3] = e3_; } while (0)
    float sacc = 0.f;
    EXPG(0);
    asm volatile("s_waitcnt lgkmcnt(8)" ::: "memory"); __builtin_amdgcn_sched_barrier(0);
#define STEP(g) do { oa[(g) >> 2] = __builtin_amdgcn_mfma_f32_32x32x16_bf16(pa[(g) & 3], PK((g) >> 2, (g) & 3), oa[(g) >> 2], 0, 0, 0); \
        if ((g) + 1 < 8) EXPG((g) + 1); if ((g) == 3) asm volatile("s_waitcnt lgkmcnt(0)" ::: "memory"); __builtin_amdgcn_sched_barrier(0); } while (0)
    STEP(0); STEP(1); STEP(2); STEP(3); STEP(4); STEP(5); STEP(6); STEP(7);
#undef STEP
#undef EXPG
    lb += sacc;
    bf16x8 pb[4];
    pb[0] = __builtin_bit_cast(bf16x8, (u32x4){cvtpk_s(pB0[0], pB0[1]), cvtpk_s(pB0[2], pB0[3]), cvtpk_s(pB0[4], pB0[5]), cvtpk_s(pB0[6], pB0[7])});
    pb[1] = __builtin_bit_cast(bf16x8, (u32x4){cvtpk_s(pB0[8], pB0[9]), cvtpk_s(pB0[10], pB0[11]), cvtpk_s(pB0[12], pB0[13]), cvtpk_s(pB0[14], pB0[15])});
    pb[2] = __builtin_bit_cast(bf16x8, (u32x4){cvtpk_s(pB1[0], pB1[1]), cvtpk_s(pB1[2], pB1[3]), cvtpk_s(pB1[4], pB1[5]), cvtpk_s(pB1[6], pB1[7])});
    pb[3] = __builtin_bit_cast(bf16x8, (u32x4){cvtpk_s(pB1[8], pB1[9]), cvtpk_s(pB1[10], pB1[11]), cvtpk_s(pB1[12], pB1[13]), cvtpk_s(pB1[14], pB1[15])});
#pragma unroll
    for (int d0 = 0; d0 < 2; ++d0)
#pragma unroll
        for (int k = 0; k < 4; ++k) ob[d0] = __builtin_amdgcn_mfma_f32_32x32x16_bf16(pb[k], PK(d0, k), ob[d0], 0, 0, 0);
#undef PK
}
__device__ __forceinline__ void store_o8(const f32x16* o, float l_reg, LAS float* wsf, LAS unsigned char* stg, GAS unsigned char* Ow8, int pitch, int lane, int r32, int hi) {
    { auto rr = __builtin_amdgcn_permlane32_swap(__float_as_uint(l_reg), __float_as_uint(l_reg), false, false); l_reg = __uint_as_float(rr[0]) + __uint_as_float(rr[1]); }
    if (hi == 0) wsf[32 + r32] = l_reg;
    LDS_WAIT();
    float rli[16];
#pragma unroll
    for (int r = 0; r < 16; ++r) rli[r] = __builtin_amdgcn_rcpf(wsf[32 + crow(r, hi)]);
#pragma unroll
    for (int r = 0; r < 16; ++r) { const int orow = crow(r, hi);
        const int p = __builtin_amdgcn_cvt_pk_fp8_f32(o[0][r] * rli[r], o[1][r] * rli[r], 0, false);
        stg[orow * 64 + r32] = (unsigned char)(p & 0xff); stg[orow * 64 + 32 + r32] = (unsigned char)((p >> 8) & 0xff); }
    LDS_WAIT();
    { const int row = lane >> 1, hf = lane & 1; const u32x4 v0 = *(const LAS u32x4*)(stg + row * 64 + hf * 32), v1 = *(const LAS u32x4*)(stg + row * 64 + hf * 32 + 16);
      GAS unsigned char* d = Ow8 + (size_t)row * pitch + hf * 32; *(GAS u32x4*)d = v0; *(GAS u32x4*)(d + 16) = v1; }
    LDS_WAIT();
}
__device__ __forceinline__ void mla_unit(int b, int h, int qb, const GAS bf16_t* Q, const GAS bf16_t* K, const GAS bf16_t* V, GAS bf16_t* O, char* shm, float mfix, const GAS float* gbq, const GAS float* rope) {
    int tid_ = threadIdx.x; asm volatile("" : "+v"(tid_));
    const int tid = tid_, lane = tid & 63, r32 = lane & 31, hi = lane >> 5; const int wid = __builtin_amdgcn_readfirstlane(tid >> 6);
    const long rowbase = (long)b * SEQ; const int q0 = qb * 512;
    const unsigned lds0 = (unsigned)(uintptr_t)shm;
    const lds_cptr shm3 = (lds_cptr)shm;
    LAS float* wsf = (LAS float*)(shm3 + M_LWS) + wid * 64;
    const GAS bf16_t* Kb = K + (size_t)((b * 8 + h) * 64) * 12 * 512; const GAS bf16_t* Vb = V + rowbase * 1024 + h * 128 + 64;
    const unsigned kof0 = (unsigned)(lane * 8) * 2u;
    const unsigned vof = (unsigned)((16 * (wid & 3) + (lane >> 2)) * 1024 + (wid >> 2) * 32 + (lane & 3) * 8) * 2u;
    const int vb0 = (int)(lds0 + M_LV) + ((lane >> 4) & 1) * 32 + (lane & 3) * 8 + (4 * hi + ((lane & 15) >> 2)) * 64;
#define MLA_DMA(t, s) do { const GAS bf16_t* kt_ = Kb + (size_t)(t) * 12 * 512; const GAS bf16_t* vt_ = Vb + (size_t)(t) * 64 * 1024; \
        glds16s(kt_ + wid * 512, kof0, (unsigned)__builtin_amdgcn_readfirstlane(lds0 + M_LK + (s) * M_KSLOT + wid * 1024)); \
        glds16s(kt_ + (8 + (wid & 3)) * 512, kof0, (unsigned)__builtin_amdgcn_readfirstlane(lds0 + M_LK + (s) * M_KSLOT + (8 + (wid & 3)) * 1024)); \
        glds16s(vt_, vof, (unsigned)__builtin_amdgcn_readfirstlane(lds0 + M_LV + (s) * M_VSLOT + wid * 1024)); } while (0)
    const int NT = 8 * (qb + 1);
    MLA_DMA(0, 0); MLA_DMA(1, 1); MLA_DMA(2, 2);
    bf16x8 qa[6], qbb[6];
    mla_load_q(qa, Q + (rowbase + q0 + wid * 64 + r32) * 768 + h * 96, gbq, rope, q0 + wid * 64 + r32, hi);
    mla_load_q(qbb, Q + (rowbase + q0 + wid * 64 + 32 + r32) * 768 + h * 96, gbq, rope, q0 + wid * 64 + 32 + r32, hi);
    float la = 0.f, lb = 0.f; f32x16 oa[2], ob[2]; oa[0] = f32x16{}; oa[1] = f32x16{}; ob[0] = f32x16{}; ob[1] = f32x16{};
    const float sub = __builtin_fmaxf(mfix - 40.0f, 0.0f);
    const int qrelA = wid * 64 + r32, qrelB = qrelA + 32;
    const int NTw = NT - 7 + wid;
    for (int t = 0; t < NT; ++t) {
        const int rem = NT - 1 - t;
        if (rem >= 2) ATT_WAITN_BAR(6); else if (rem == 1) ATT_WAITN_BAR(3); else ATT_WAITN_BAR(0);
        if (t + 3 < NT) MLA_DMA(t + 3, (t + 3) & 3);
        if (t >= NTw) continue;
        const int s = t & 3, jb = t - (NT - 8);
        f32x16 pA0, pA1, pB0, pB1; bf16x8 pa[4];
        const int kb = 64 * jb + 4 * hi;
        qk_one(pA0, pA1, shm3 + M_LK + s * M_KSLOT, qa, r32, hi);
        if (jb >= 0) {
#pragma unroll
            for (int r = 0; r < 16; ++r) { const int kv = kb + (r & 3) + 8 * (r >> 2); if (kv > qrelA) pA0[r] = -INFINITY; if (kv + 32 > qrelA) pA1[r] = -INFINITY; } }
        if (sub != 0.f) {
#pragma unroll
            for (int r = 0; r < 16; ++r) { pA0[r] -= sub; pA1[r] -= sub; } }
        qkB_expA(pB0, pB1, pA0, pA1, la, pa, shm3 + M_LK + s * M_KSLOT, qbb, r32, hi);
        if (jb >= 0) {
#pragma unroll
            for (int r = 0; r < 16; ++r) { const int kv = kb + (r & 3) + 8 * (r >> 2); if (kv > qrelB) pB0[r] = -INFINITY; if (kv + 32 > qrelB) pB1[r] = -INFINITY; } }
        if (sub != 0.f) {
#pragma unroll
            for (int r = 0; r < 16; ++r) { pB0[r] -= sub; pB1[r] -= sub; } }
        tail_pvA_expB_pvB(pB0, pB1, lb, pa, oa, ob, vb0 + s * M_VSLOT);
    }
    store_o8(oa, la, wsf, (LAS unsigned char*)(shm3 + M_LOST) + wid * 4096, (GAS unsigned char*)O + (rowbase + q0 + wid * 64) * 1024 + 512 + h * 64, 1024, lane, r32, hi);
    store_o8(ob, lb, wsf, (LAS unsigned char*)(shm3 + M_LOST) + wid * 4096, (GAS unsigned char*)O + (rowbase + q0 + wid * 64 + 32) * 1024 + 512 + h * 64, 1024, lane, r32, hi);
    ATT_WAIT_BAR();
#undef MLA_DMA
}

constexpr int S_LK = 0, S_LV = 32768, S_LBIAS = 65536, S_LWS = S_LBIAS + 4096, S_LOST = S_LWS + 2048, S_LDS = S_LOST + 32768;
__device__ __forceinline__ void swa_unit(int b, int n, int g, const GAS bf16_t* P, GAS bf16_t* O, const GAS float* sinks, char* shm, float sbound) {
    int tid_ = threadIdx.x; asm volatile("" : "+v"(tid_));
    const int tid = tid_, lane = tid & 63, r32 = lane & 31, hi = lane >> 5; const int wid = __builtin_amdgcn_readfirstlane(tid >> 6);
    const unsigned lds0 = (unsigned)(uintptr_t)shm;
    const lds_cptr shm3 = (lds_cptr)shm;
    LAS float* wsf = (LAS float*)(shm3 + S_LWS) + wid * 64;
    const LAS float* biasl = (const LAS float*)(shm3 + S_LBIAS);
    const long kb0 = (long)b * SEQ + 128 * (n - 1);
    const int tt0 = (n == 0) ? 2 : 0;
    for (int tt = tt0; tt < 4; ++tt) {
        glds16(P + (kb0 + 64 * tt + lane) * NPROJ1 + C_KA + 64 * g + wid * 8, (unsigned)__builtin_amdgcn_readfirstlane(lds0 + S_LK + tt * 8192 + wid * 1024));
        glds16(P + (kb0 + 64 * tt + 16 * (wid & 3) + (lane >> 2)) * NPROJ1 + C_VA + 64 * g + (wid >> 2) * 32 + (lane & 3) * 8, (unsigned)__builtin_amdgcn_readfirstlane(lds0 + S_LV + tt * 8192 + wid * 1024));
    }
    const int vb0 = (int)(lds0 + S_LV) + ((lane >> 4) & 1) * 32 + (lane & 3) * 8 + (4 * hi + ((lane & 15) >> 2)) * 64;
    ATT_WAIT_BAR();
    for (int pass = 0; pass < 2; ++pass) {
        const int bq = wid + 8 * pass, hg = bq >> 2, j = bq & 3, head = 4 * g + hg;
        const long qrow0 = (long)b * SEQ + 128 * n + 32 * j;
        bf16x8 qr[4];
        { const GAS bf16_t* Qw = P + (qrow0 + r32) * NPROJ1 + C_QA + 64 * head + hi * 8;
#pragma unroll
          for (int d0 = 0; d0 < 4; ++d0) qr[d0] = *(const GAS bf16x8*)(Qw + d0 * 16); }
        const float sink2 = sinks[head] * LOG2E, mfix = __builtin_fmaxf(sbound, sink2);
        float l_reg = (hi == 0) ? __builtin_amdgcn_exp2f(sink2 - mfix) : 0.0f; f32x16 o[2]; o[0] = f32x16{}; o[1] = f32x16{}; f32x16 negm;
#pragma unroll
        for (int r = 0; r < 16; ++r) negm[r] = -mfix;
        const int ts = (j < 2) ? 0 : 1;
        for (int tt = ts; tt < ts + 3; ++tt) {
            if (tt < tt0) continue;
            f32x16 p0, p1;
            qk_tile<4>(p0, p1, shm3 + S_LK + tt * 8192, qr, negm, r32, hi);
            const int dbase = 32 * j + r32 + 128 - 64 * tt - 4 * hi;
#pragma unroll
            for (int r = 0; r < 16; ++r) { const int d0_ = dbase - ((r & 3) + 8 * (r >> 2)), d1_ = d0_ - 32;
                const float b0 = biasl[head * 128 + (d0_ & 127)], b1 = biasl[head * 128 + (d1_ & 127)];
                p0[r] = (d0_ >= 0 && d0_ < 128) ? p0[r] + b0 : -INFINITY;
                p1[r] = (d1_ >= 0 && d1_ < 128) ? p1[r] + b1 : -INFINITY; }
            softmax_pv_fixed(p0, p1, l_reg, o, vb0 + tt * 8192);
        }
        store_o8(o, l_reg, wsf, (LAS unsigned char*)(shm3 + S_LOST) + wid * 4096, (GAS unsigned char*)O + qrow0 * 1024 + 64 * head, 1024, lane, r32, hi);
    }
    ATT_WAIT_BAR();
}
}

#define XB_TMO      128
#define XB_XCNT(j)  (256  + 64 * (j))
#define XB_XSUB(j)  (1280 + 64 * (j))
#define XB_XGEN(j)  (2304 + 64 * (j))
#define XB_TOP      3328
#define XB_TOPGEN   3392
#define XCD_BAR_WORDS 3456
#define XB_SPIN_CAP (1u << 22)
__device__ __forceinline__ unsigned xb_ld(unsigned* p)              { return __hip_atomic_load(p, __ATOMIC_RELAXED, __HIP_MEMORY_SCOPE_AGENT); }
__device__ __forceinline__ unsigned xb_add(unsigned* p, unsigned v) { return __hip_atomic_fetch_add(p, v, __ATOMIC_RELAXED, __HIP_MEMORY_SCOPE_AGENT); }
__device__ __forceinline__ unsigned xb_xcc_id() { return (unsigned)__builtin_amdgcn_s_getreg((3 << 11) | 20) & 0xFu; }
#define XB_SPIN(cond, bar) do { unsigned _sp = 0; while (cond) { __builtin_amdgcn_s_sleep(1); \
    if ((++_sp & 255u) == 0u) { if (xb_ld(&(bar)[XB_TMO])) break; if (_sp > XB_SPIN_CAP) { atomicAdd(&(bar)[XB_TMO], 1u); break; } } } } while (0)
struct XcdBarrier { unsigned* bar; unsigned x; volatile LAS unsigned* st; };
__device__ __forceinline__ XcdBarrier xcd_barrier_post(unsigned* bar, volatile LAS unsigned* st) {
    XcdBarrier b; b.bar = bar; b.x = xb_xcc_id(); b.st = st;
    if (threadIdx.x == 0) (void)xb_add(&bar[XB_XCNT(b.x)], 1u);
    return b;
}
__device__ __forceinline__ void xcd_barrier_complete(unsigned* bar, unsigned x, unsigned& nloc, unsigned& nx) {
    const unsigned G = gridDim.x * gridDim.y * gridDim.z;
    unsigned sum, cnt, mine, sp = 0u;
    for (;;) {
        sum = 0u; cnt = 0u; mine = 0u;
#pragma unroll
        for (unsigned j = 0; j < 16; ++j) { const unsigned c = xb_ld(&bar[XB_XCNT(j)]); sum += c; cnt += (c > 0u) ? 1u : 0u; mine = (j == x) ? c : mine; }
        if (sum == G) break;
        __builtin_amdgcn_s_sleep(1);
        if ((++sp & 255u) == 0u) { if (xb_ld(&bar[XB_TMO])) break; if (sp > XB_SPIN_CAP) { atomicAdd(&bar[XB_TMO], 1u); break; } }
    }
    nloc = mine > 0u ? mine : 1u; nx = cnt > 0u ? cnt : 1u;
}
__device__ __forceinline__ void xcd_barrier(const XcdBarrier& b) {
    asm volatile("s_waitcnt vmcnt(0)" ::: "memory");
    __syncthreads();
    if (threadIdx.x == 0) {
        unsigned* bar = b.bar;
        __builtin_amdgcn_s_waitcnt(0);
        unsigned nloc = b.st[0], nx = b.st[1];
        if (nloc == 0u) { xcd_barrier_complete(bar, b.x, nloc, nx); b.st[0] = nloc; b.st[1] = nx; }
        const unsigned old = xb_add(&bar[XB_XSUB(b.x)], 1u);
        const unsigned gen = old / nloc;
        if (old + 1u == (gen + 1u) * nloc) {
            __builtin_amdgcn_fence(__ATOMIC_RELEASE, "agent");
            asm volatile("s_waitcnt vmcnt(0)" ::: "memory");
            const unsigned og = xb_add(&bar[XB_TOP], 1u);
            const unsigned tg = og / nx;
            if (og + 1u == (tg + 1u) * nx) xb_add(&bar[XB_TOPGEN], 1u);
            else XB_SPIN(xb_ld(&bar[XB_TOPGEN]) == tg, bar);
            __builtin_amdgcn_fence(__ATOMIC_ACQUIRE, "agent");
            xb_add(&bar[XB_XGEN(b.x)], 1u);
            asm volatile("s_waitcnt vmcnt(0)" ::: "memory");
        } else {
            XB_SPIN(xb_ld(&bar[XB_XGEN(b.x)]) == gen, bar);
            __builtin_amdgcn_fence(__ATOMIC_ACQUIRE, "agent");
            asm volatile("s_waitcnt vmcnt(0)" ::: "memory");
        }
    }
    __syncthreads();
}

enum { MAP_NAT = 0, MAP_GU = 1, MAP_ROUTER = 2 };
template <int Q8 = 0> __device__ __forceinline__ void cvt_item(const GAS float* sp, int ns, const GAS float* gain, GAS bf16_t* dst, int ldd, int k0, int n0, LAS float* scr, int lane, float qs = 1.f) {
    { float vv[32], gg[32];
#pragma unroll
      for (int i = 0; i < 32; ++i) { const int kk = 2 * i + (lane >> 5); vv[i] = sp ? sp[(size_t)(k0 + kk) * ns] : 0.f; gg[i] = gain ? gain[k0 + kk] : 1.f; }
#pragma unroll
      for (int i = 0; i < 32; ++i) { const int kk = 2 * i + (lane >> 5); scr[kk * 33 + (lane & 31)] = vv[i] * gg[i]; } }
    LDS_WAIT(); asm volatile("" ::: "memory");
    const int ch = lane & 7;
#pragma unroll
    for (int j = 0; j < 4; ++j) { const int n = (lane >> 3) + 8 * j; const LAS float* s = scr + (8 * ch) * 33 + n;
        if constexpr (Q8 == 2) { u32x2 o; o.x = pk4_fp8(s[0 * 33] * qs, s[1 * 33] * qs, s[2 * 33] * qs, s[3 * 33] * qs); o.y = pk4_fp8(s[4 * 33] * qs, s[5 * 33] * qs, s[6 * 33] * qs, s[7 * 33] * qs);
            *(GAS u32x2*)((GAS unsigned char*)dst + (size_t)(n0 + n) * ldd + k0 + 8 * ch) = o; }
        else if constexpr (Q8 == 1) { u32x2 o; o.x = pk4_i8(s[0 * 33], s[1 * 33], s[2 * 33], s[3 * 33], qs); o.y = pk4_i8(s[4 * 33], s[5 * 33], s[6 * 33], s[7 * 33], qs);
            *(GAS u32x2*)((GAS unsigned char*)dst + (size_t)(n0 + n) * ldd + k0 + 8 * ch) = o; }
        else { u32x4 o; o.x = cvt_pk_bf16(s[0 * 33], s[1 * 33]); o.y = cvt_pk_bf16(s[2 * 33], s[3 * 33]); o.z = cvt_pk_bf16(s[4 * 33], s[5 * 33]); o.w = cvt_pk_bf16(s[6 * 33], s[7 * 33]);
            *(GAS u32x4*)(dst + (size_t)(n0 + n) * ldd + k0 + 8 * ch) = o; } }
    LDS_WAIT(); asm volatile("" ::: "memory");
}
template <int Q8 = 0> __device__ __forceinline__ void cvt_nat(const GAS float* src, int Nsrc, int coff, int nvalid, const GAS float* gain, GAS bf16_t* dst, int K, int Ndst, int item, LAS float* scr, int lane, float qs = 1.f) {
    const int nblk = Ndst / 32, kb = item / nblk, nb = item % nblk, n0 = 32 * nb, np = n0 + (lane & 31);
    cvt_item<Q8>(np < nvalid ? src + coff + np : nullptr, Nsrc, gain, dst, K, 64 * kb, n0, scr, lane, qs);
}

struct Args { const GAS float* in[25]; GAS float* out; unsigned char* ws; int ph_lo, ph_hi; };
constexpr int NPH_LAYER = 15, NPHASES = 1 + 2 * NPH_LAYER;

__global__ void __launch_bounds__(512, 2) fwd(Args args) {
    extern __shared__ __attribute__((aligned(16))) unsigned char lds[];
    LAS unsigned char* L = (LAS unsigned char*)lds;
    volatile LAS unsigned* MISC = (volatile LAS unsigned*)(L + MISC_OFF);
    LAS int* pend = (LAS int*)(L + MISC_OFF + 64);
    LAS int* pcnt = (LAS int*)(L + MISC_OFF + 256);
    const int tid = threadIdx.x, lane = tid & 63, wave = __builtin_amdgcn_readfirstlane(tid >> 6);
    const int G = gridDim.x, bx = blockIdx.x;
    const int vcu = (G % 8 == 0) ? (bx % 8) * (G / 8) + bx / 8 : bx;
    const int gw = vcu * 8 + wave, NGW = G * 8;
    typedef __attribute__((address_space(4))) const unsigned long long* karg_t;
    const karg_t ka0 = (karg_t)__builtin_amdgcn_kernarg_segment_ptr();
    unsigned char* ws = (unsigned char*)ka0[26];
    unsigned* ctl = (unsigned*)(ws + WS_CTL);
    for (int u = tid; u < 256; u += 512) ((LAS unsigned*)(L + MISC_OFF))[u] = 0u;
    __syncthreads();
#if ONE_LAUNCH
    XcdBarrier bar = xcd_barrier_post(ctl + CW_BAR, MISC);
#define GRID_BAR() xcd_barrier(bar)
#else
#define GRID_BAR() do {} while (0)
#endif
    const int lo = args.ph_lo, hi = args.ph_hi;
#ifndef PHONLY
#define PHONLY -1
#endif
#define PHSEL(k) (PHONLY < 0 || (((k) == 0 ? 0 : (((k) - 1) % 15) + 1)) == PHONLY)
#define IN(k) (PHSEL(k) && lo <= (k) && (k) < hi)
#define SEAM(k) do { if (IN(k) && IN((k) + 1)) GRID_BAR(); } while (0)
#define PH_BEGIN int tid = threadIdx.x; asm volatile("" : "+v"(tid)); const int lane = tid & 63; (void)lane; karg_t ka = ka0; asm volatile("" : "+s"(ka)); unsigned char* lw = (unsigned char*)ka[26]; GAS float* out = (GAS float*)ka[25]; (void)lw; (void)out;
#define INP(k) ((const GAS float*)ka[k])
#define SSQX ((GAS float*)(lw + WS_SSQX))
#define SSQP ((GAS float*)(lw + WS_SSQP))
#define WMAXP ((GAS float*)(lw + WS_SSQP))
#define WABSV ((GAS float*)(lw + 7 * MiB))
#define XSC ((GAS float*)(lw + WS_RSMID))
#define ROPE ((GAS float*)(lw + WS_ROPE))
#define ASE ((GAS int*)(lw + WS_ASE))
#define ASP ((GAS int*)(lw + WS_ASP))
#define ASW ((GAS float*)(lw + WS_ASW))
#define MY ((GAS int*)(lw + WS_MY))
#define MW ((GAS float*)(lw + WS_MW))
#define MRS ((GAS float*)(lw + WS_MRS))
#define LOGITS ((GAS float*)(lw + WS_LOGITS))
#define PCQ ((GAS float*)(lw + WS_LOGITS))
#define PCKV ((GAS float*)(lw + WS_LOGITS + MiB))
#define PKPE ((GAS float*)(lw + WS_LOGITS + 2 * MiB))
#define XB ((GAS bf16_t*)(lw + WS_XB))
#define XB8 ((GAS unsigned char*)(lw + WS_XB8))
#define PROJ1 ((GAS bf16_t*)(lw + WS_PROJ1))
#define QB ((GAS bf16_t*)(lw + WS_QB))
#define KVB ((GAS bf16_t*)(lw + WS_KVB))
#define KB ((GAS bf16_t*)(lw + WS_KB))
#define OB ((GAS bf16_t*)(lw + WS_O))
#define GATES ((GAS bf16_t*)(lw + WS_GATES))
#define MB ((GAS bf16_t*)(lw + WS_M))
#define XM8 ((GAS unsigned char*)(lw + WS_XR))
#define TAB ((GAS int*)(lw + WS_XR + 64 * MiB))
#define ACT ((GAS bf16_t*)(lw + WS_ACT))
#define YBUF ((GAS bf16_t*)(lw + WS_YBUF))

    if (IN(0)) {
        PH_BEGIN
        {
          float mx_in0 = 0.f, mx_in1 = 0.f;
          { const int l = gw >> 10, k = gw & 1023;
            for (int rr = gw; rr < 2048; rr += NGW) { const int l2 = rr >> 10, k2 = rr & 1023; const GAS float* row = INP(2) + ((size_t)l2 * 1024 + k2) * IN_COLS; float mx = 0.f;
                for (int c = lane * 4; c < IN_COLS; c += 256) { const f32x4 q = *(const GAS f32x4*)(row + c); mx = __builtin_fmaxf(mx, __builtin_fmaxf(__builtin_fmaxf(__builtin_fabsf(q.x), __builtin_fabsf(q.y)), __builtin_fmaxf(__builtin_fabsf(q.z), __builtin_fabsf(q.w)))); }
                mx = wave_max(mx) * __builtin_fabsf(INP(1)[l2 * 1024 + k2]);
                if (l2 == 0) mx_in0 = __builtin_fmaxf(mx_in0, mx); else mx_in1 = __builtin_fmaxf(mx_in1, mx); }
            (void)l; (void)k; }
          for (int l2 = 0; l2 < 2; ++l2) { float mxw = 0.f;
            for (int r0 = gw * 4; r0 < 2 * NEXP * 1024; r0 += NGW * 4) { f32x4 q[4];
#pragma unroll
                for (int r = 0; r < 4; ++r) { const int rr = r0 + r, which = rr >> 15, ek = rr & 32767; q[r] = ((const GAS f32x4*)((which ? INP(23) : INP(22)) + ((size_t)l2 * NEXP * 1024 + ek) * 256) + lane)[0]; }
#pragma unroll
                for (int r = 0; r < 4; ++r) { const int k2 = (r0 + r) & 1023; const float g = __builtin_fabsf(INP(17)[l2 * 1024 + k2]);
                    mxw = __builtin_fmaxf(mxw, g * __builtin_fmaxf(__builtin_fmaxf(__builtin_fabsf(q[r].x), __builtin_fabsf(q[r].y)), __builtin_fmaxf(__builtin_fabsf(q[r].z), __builtin_fabsf(q[r].w)))); } }
            mxw = wave_max(mxw);
            if (lane == 0) WMAXP[(l2 * 2 + 1) * 2048 + gw] = mxw; }
          if (lane == 0) { WMAXP[0 * 2048 + gw] = mx_in0; WMAXP[2 * 2048 + gw] = mx_in1; } }
        { const GAS float* x_in = INP(0);
        for (int m0 = gw * 8; m0 < T; m0 += NGW * 8) {
            f32x4 v[8][4];
#pragma unroll
            for (int r = 0; r < 8; ++r)
#pragma unroll
                for (int j = 0; j < 4; ++j) v[r][j] = ((const GAS f32x4*)(x_in + (size_t)(m0 + r) * DM) + lane)[64 * j];
#pragma unroll
            for (int r = 0; r < 8; ++r) { float s = 0.f, mx = 0.f;
#pragma unroll
                for (int j = 0; j < 4; ++j) { const f32x4 q = v[r][j]; s += (q.x * q.x + q.y * q.y) + (q.z * q.z + q.w * q.w);
                    mx = __builtin_fmaxf(mx, __builtin_fmaxf(__builtin_fmaxf(__builtin_fabsf(q.x), __builtin_fabsf(q.y)), __builtin_fmaxf(__builtin_fabsf(q.z), __builtin_fabsf(q.w))));
                    }
                s = wave_sum(s); mx = wave_max(mx); mx = mx > 0.f ? mx : 1.f; const float qs = 127.0f / mx;
#pragma unroll
                for (int j = 0; j < 4; ++j) { const f32x4 q = v[r][j]; ((GAS unsigned*)(XB8 + (size_t)(m0 + r) * DM) + lane)[64 * j] = pk4_i8(q.x, q.y, q.z, q.w, qs); }
                if (lane == 0) { SSQX[m0 + r] = s; XSC[m0 + r] = mx * (1.0f / 127.0f); } }
        } }
        for (int e = bx * 512 + tid; e < SEQ * 16; e += G * 512) { const int pos = e >> 4, i = e & 15;
            const int i4 = i & 3; const double m4 = (i4 == 0) ? 1.0 : (i4 == 1) ? 0.5623413251903491 : (i4 == 2) ? 0.31622776601683794 : 0.1778279410038923;
            const int i16 = i >> 2; const double d4 = (i16 == 0) ? 1.0 : (i16 == 1) ? 0.1 : (i16 == 2) ? 0.01 : 0.001;
            const float ang = (float)pos * (float)(m4 * d4);
            double rev = (double)ang * 0.15915494309189535; rev -= __builtin_rint(rev); const float fr_ = (float)rev;
            ROPE[pos * 32 + i] = __builtin_amdgcn_cosf(fr_); ROPE[pos * 32 + 16 + i] = __builtin_amdgcn_sinf(fr_); }
            GRID_BAR();
        float wabs[4];
#pragma unroll
        for (int q = 0; q < 4; ++q) { float m = 0.f; for (int i = lane; i < NGW; i += 64) m = __builtin_fmaxf(m, WMAXP[q * 2048 + i]); m = wave_max(m); wabs[q] = m > 0.f ? m : 1.f; }
        if (bx == 0 && tid == 0) { WABSV[0] = wabs[0]; WABSV[1] = wabs[1]; WABSV[2] = wabs[2]; WABSV[3] = wabs[3]; }
#define WDQ(l_, t_) (WABSV[2 * (l_) + (t_)] * (1.0f / 127.0f))
#define WQS(l_, t_) (127.0f / wabs[2 * (l_) + (t_)])
        const float qs_in0 = WQS(0, 0), qs_in1 = WQS(1, 0), qs_gu0 = WQS(0, 1), qs_gu1 = WQS(1, 1);
        LAS float* scr = (LAS float*)(L + wave * 16384);
        constexpr int I_WIN1 = 16 * 40, I_WG = 16 * 64, I_WQB = 4 * 24, I_WKVB = 2 * 32, I_WOA = 8 * 32, I_WO = 16 * 32, I_WR = 16 * 8, I_WGU = 32 * 16 * 16, I_WD = 32 * 4 * 32;
        constexpr int NIT = I_WIN1 + I_WG + I_WQB + I_WKVB + 2 * I_WOA + I_WO + I_WR + I_WGU + I_WD;
        for (int it = gw; it < 2 * NIT; it += NGW) {
            const int l = it >= NIT ? 1 : 0; int r = it - l * NIT;
            if (r < I_WIN1) {
                const int kb = r / 40, nb = r % 40, n0 = 32 * nb, np = n0 + (lane & 31);
                int sc_ = np; if (np < 768) { const int pn = np >> 8, q = np & 255; sc_ = 64 * (4 * pn + ((q >> 5) & 3)) + 32 * (q >> 7) + (q & 31); }
                cvt_item<1>(np < C_GATE ? INP(2) + (size_t)l * 1024 * IN_COLS + sc_ : nullptr, IN_COLS, INP(1) + l * 1024, (GAS bf16_t*)(lw + WS_WIN1 + (size_t)l * 1280 * 1024), 1024, 64 * kb, n0, scr, lane, (l ? qs_in1 : qs_in0)); continue; } r -= I_WIN1;
            if (r < I_WG) {
                const int kb = r / 64, nb = r % 64, n0 = 32 * nb, np = n0 + (lane & 31);
                const int q = np >> 8, p = np & 255, cc = 128 * q + (p & 127) + ((p >> 7) ? 1024 : 0);
                cvt_item<1>(INP(2) + (size_t)l * 1024 * IN_COLS + C_GATE + cc, IN_COLS, INP(1) + l * 1024, (GAS bf16_t*)(lw + WS_WG + (size_t)l * 2048 * 1024), 1024, 64 * kb, n0, scr, lane, (l ? qs_in1 : qs_in0)); continue; } r -= I_WG;
            if (r < I_WQB) { cvt_nat(INP(10) + (size_t)l * 256 * 768, 768, 0, 768, INP(9) + l * 256, (GAS bf16_t*)(lw + WS_WQB) + (size_t)l * 768 * 256, 256, 768, r, scr, lane); continue; } r -= I_WQB;
            if (r < I_WKVB) {
                const int kb = r / 32, nb = r % 32, n0 = 32 * nb, np = n0 + (lane & 31);
                const int pn = np >> 8, q = np & 255, wc_ = (q >> 5) & 3; const int sc_ = 128 * (2 * pn + (wc_ & 1)) + 64 * (wc_ >> 1) + 32 * (q >> 7) + (q & 31);
                cvt_item(INP(12) + (size_t)l * 128 * 1024 + sc_, 1024, INP(11) + l * 128, (GAS bf16_t*)(lw + WS_WKVB) + (size_t)l * 1024 * 128, 128, 64 * kb, n0, scr, lane); continue; } r -= I_WKVB;
            if (r < 2 * I_WOA) {
                const int half = r >= I_WOA, r2 = r - half * I_WOA, kb = r2 / 32, nb = r2 % 32, n0 = 32 * nb;
                cvt_item<2>((half ? INP(15) : INP(8)) + (size_t)l * 512 * 1024 + pg8::col16_src(n0 + (lane & 31)), 1024, nullptr, (GAS bf16_t*)(lw + WS_WOA + (size_t)l * 1024 * 1024 + half * 512), 1024, 64 * kb, n0, scr, lane, W8S); continue; } r -= 2 * I_WOA;
            if (r < I_WO) { const int kb = r / 32, nb = r % 32, n0 = 32 * nb;
                cvt_item<2>(INP(16) + (size_t)l * 1024 * 1024 + pg8::col16_src(n0 + (lane & 31)), 1024, nullptr, (GAS bf16_t*)(lw + WS_WO + (size_t)l * 1024 * 1024), 1024, 64 * kb, n0, scr, lane, W8S); continue; } r -= I_WO;
            if (r < I_WR) {
                const int kb = r / 8, nb = r % 8, n0 = 32 * nb, np = n0 + (lane & 31);
                const GAS float* sp = nullptr; int ns = 32;
                if (np < 32) { sp = INP(20) + (size_t)l * 1024 * 32 + np; ns = 32; } else if (np < 36) { sp = INP(18) + (size_t)l * 1024 * 4 + (np - 32); ns = 4; }
                cvt_item(sp, ns, INP(17) + l * 1024, (GAS bf16_t*)(lw + WS_WR) + (size_t)l * 256 * 1024, 1024, 64 * kb, n0, scr, lane); continue; } r -= I_WR;
            if (r < I_WGU) {
                const int e = r / 256, r2 = r % 256, kb = r2 / 16, nb = r2 % 16, n0 = 32 * nb, np = n0 + (lane & 31);
                const int pn = np >> 8, q = np & 255, n = q >> 7;
                const int cc = 128 * pn + (q & 127);
                const GAS float* sp = (n ? INP(23) : INP(22)) + ((size_t)l * NEXP + e) * 1024 * 256 + cc;
                cvt_item<1>(sp, 256, INP(17) + l * 1024, (GAS bf16_t*)(lw + WS_WGU + ((size_t)l * NEXP + e) * 512 * 1024), 1024, 64 * kb, n0, scr, lane, (l ? qs_gu1 : qs_gu0)); continue; } r -= I_WGU;
            { const int e = r / 128; cvt_nat(INP(24) + ((size_t)l * NEXP + e) * 256 * 1024, 1024, 0, 1024, nullptr, (GAS bf16_t*)(lw + WS_WD) + ((size_t)l * NEXP + e) * 1024 * 256, 256, 1024, r % 128, scr, lane); }
        }
    }
    SEAM(0);

    for (int l = 0; l < 2; ++l) {
        const int pb = 1 + NPH_LAYER * l;
        if (IN(pb + 0)) { PH_BEGIN
            pg8::Gemm g{(const GAS bf16_t*)XB8, (const GAS bf16_t*)(lw + WS_WIN1 + (size_t)l * 1280 * 1024), 512, 512, 512}; pg8::StaticOrder S; S.init(T, NPROJ1, G, bx);
            pg8::EpiProj1 E{PROJ1, SSQX, XSC, WDQ(l, 0), INP(4) + l * 64, INP(5) + l * 64, PCQ, PCKV, PKPE};
            pg8::gemm_phase<pg8::EpiProj1, pg8::StaticOrder, true>(L, g, S, E);
        }
        SEAM(pb + 0);
        if (IN(pb + 2)) { PH_BEGIN
            { pg8::Gemm g{PROJ1 + C_CQ, (const GAS bf16_t*)(lw + WS_WQB) + (size_t)l * 768 * 256, NPROJ1, 256, 256}; pg8::StaticOrder S; S.init(T, 768, G, bx);
              pg8::EpiRowNorm4 E{QB, 768, PCQ, 1.0f / 256.0f};
              pg8::gemm_phase<pg8::EpiRowNorm4, pg8::StaticOrder>(L, g, S, E); }
            { pg8::Gemm g{PROJ1 + C_CKV, (const GAS bf16_t*)(lw + WS_WKVB) + (size_t)l * 1024 * 128, NPROJ1, 128, 128}; pg8::StaticOrder S; S.init(T, 1024, G, bx);
              pg8::EpiKv E{KB, KVB, PCKV, PKPE, PROJ1, INP(14) + l * 96, ROPE};
              pg8::gemm_phase<pg8::EpiKv, pg8::StaticOrder>(L, g, S, E); }
        }
        SEAM(pb + 2);
        if (IN(pb + 4)) { PH_BEGIN
            char* shm = (char*)lds;
            float mfixB, sboundA;
            { const GAS float* gq = INP(13) + l * 96; const GAS float* gk = INP(14) + l * 96; float a = 0.f, c = 0.f;
              for (int i = lane; i < 96; i += 64) { a = __builtin_fmaxf(a, __builtin_fabsf(gq[i])); c = __builtin_fmaxf(c, __builtin_fabsf(gk[i])); }
              a = wave_max(a); c = wave_max(c); mfixB = __uint_as_float(__builtin_amdgcn_readfirstlane(__float_as_uint(__builtin_fminf(96.0f * C2B * a * c + 0.5f, 60.0f)))); }
            { const GAS float* gq = INP(4) + l * 64; const GAS float* gk = INP(5) + l * 64; const GAS float* rel = INP(7);
              float a = __builtin_fabsf(gq[lane]), c = __builtin_fabsf(gk[lane]), bm = 0.f;
              for (int i = lane; i < 256; i += 64) bm = __builtin_fmaxf(bm, __builtin_fabsf(rel[i]));
              a = wave_max(a); c = wave_max(c); bm = wave_max(bm); sboundA = __uint_as_float(__builtin_amdgcn_readfirstlane(__float_as_uint(__builtin_fminf(64.0f * C2A * a * c + bm * LOG2E + 0.5f, 60.0f)))); }
            for (int v = vcu; v < 256; v += G) {
                const int bh = v >> 1, s0 = 2 * (v & 1);
                for (int i = 0; i < 4; ++i) { const int s = s0 + (i >> 1), qb = (i & 1) ? 7 - s : s; att::mla_unit(bh >> 3, bh & 7, qb, QB, KB, KVB, OB, shm, mfixB, INP(13) + l * 96, ROPE); }
            }
            { LAS float* biasl = (LAS float*)(L + att::S_LBIAS); const GAS float* rel = INP(7);
              for (int e = tid; e < 8 * 128; e += 512) { const int hd = e >> 7, d = e & 127; int bk = d;
                  if (d >= 16) { bk = 16 + (int)(__logf((float)d * (1.0f / 16.0f)) / 2.0794415416798357f * 16.0f); bk = bk > 31 ? 31 : bk; }
                  biasl[e] = rel[bk * 8 + hd] * LOG2E; }
              __syncthreads(); }
            for (int u = vcu; u < NB * 32 * 2; u += G) { const int g2 = u & 1, n = (u >> 1) & 31, b = u >> 6; att::swa_unit(b, n, g2, PROJ1, OB, INP(6) + l * 8, shm, sboundA); }
        }
        SEAM(pb + 4);
        if (IN(pb + 5)) { PH_BEGIN
            pg8::Gemm g{(const GAS bf16_t*)XB8, (const GAS bf16_t*)(lw + WS_WG + (size_t)l * 2048 * 1024), 512, 512, 512}; pg8::StaticOrder S; S.init(T, 2048, G, bx);
            pg8::EpiGates2 E{GATES, GATES + (size_t)T * 1024, SSQX, INP(3) + l * 2048, XSC, WDQ(l, 0)};
            pg8::gemm_phase<pg8::EpiGates2, pg8::StaticOrder, true>(L, g, S, E);
        }
        SEAM(pb + 5);
        if (IN(pb + 6)) { PH_BEGIN
            pg8::Gemm g{OB, (const GAS bf16_t*)(lw + WS_WOA + (size_t)l * 1024 * 1024), 512, 512, 512}; pg8::StaticOrder S; S.init(T, 1024, G, bx);
            pg8::EpiMerge E{MB, GATES, GATES + (size_t)T * 1024};
            pg8::gemm_phase<pg8::EpiMerge, pg8::StaticOrder, false, true, true>(L, g, S, E);
        }
        SEAM(pb + 6);
        if (IN(pb + 7)) { PH_BEGIN
            pg8::Gemm g{MB, (const GAS bf16_t*)(lw + WS_WO + (size_t)l * 1024 * 1024), 512, 512, 512}; pg8::StaticOrder S; S.init(T, 1024, G, bx);
            pg8::EpiResid E{(l == 0) ? INP(0) : (const GAS float*)nullptr, XB, SSQP};
            pg8::gemm_phase<pg8::EpiResid, pg8::StaticOrder, false, false, true>(L, g, S, E);
        }
        SEAM(pb + 7);
        if (IN(pb + 9)) { PH_BEGIN
            pg8::Gemm g{XB, (const GAS bf16_t*)(lw + WS_WR) + (size_t)l * 256 * 1024, 1024, 1024, 1024}; pg8::StaticOrder S; S.init(T, 256, G, bx);
            pg8::EpiLogits E{LOGITS, SSQP};
            pg8::gemm_phase<pg8::EpiLogits, pg8::StaticOrder>(L, g, S, E);
            VM_WAIT(); __syncthreads();
            LAS int* cnt = (LAS int*)L; LAS int* basep = cnt + 32;
            const GAS float* brg = INP(19) + l * 4; const GAS float* bre = INP(21) + l * 32;
            GAS unsigned* gcnt = (GAS unsigned*)(lw + WS_CTL) + CW_CNT + 64 * l;
            pg8::Unit ru;
            LAS float* rsc = (LAS float*)(L + 4096);
            for (int iu = 0; S.next(iu, ru); ++iu) {
                if (tid < 32) cnt[tid] = 0;
                {
                    const int wv = tid >> 6;
                    for (int rr = 0; rr < 32; rr += 4) { u32x4 v0[4], v1[4]; float rsm[4];
#pragma unroll
                        for (int r = 0; r < 4; ++r) { const int t = ru.pm * 256 + wv * 32 + rr + r; const GAS u32x4* s = (const GAS u32x4*)(XB + (size_t)t * DM) + lane; v0[r] = s[0]; v1[r] = s[64];
                            const GAS f32x4* pp = (const GAS f32x4*)(SSQP + (size_t)t * 16); const f32x4 a = pp[0], b = pp[1], c = pp[2], d = pp[3];
                            rsm[r] = __builtin_amdgcn_rsqf((((a.x + a.y) + (a.z + a.w)) + ((b.x + b.y) + (b.z + b.w)) + ((c.x + c.y) + (c.z + c.w)) + ((d.x + d.y) + (d.z + d.w))) * (1.0f / 1024.0f) + EPS); }
#pragma unroll
                        for (int r = 0; r < 4; ++r) { const int t = ru.pm * 256 + wv * 32 + rr + r; const u32x4 a = v0[r], b = v1[r];
                            const float f[16] = {bflo(a.x), bfhi(a.x), bflo(a.y), bfhi(a.y), bflo(a.z), bfhi(a.z), bflo(a.w), bfhi(a.w), bflo(b.x), bfhi(b.x), bflo(b.y), bfhi(b.y), bflo(b.z), bfhi(b.z), bflo(b.w), bfhi(b.w)};
                            float mx = 0.f;
#pragma unroll
                            for (int i = 0; i < 16; ++i) mx = __builtin_fmaxf(mx, __builtin_fabsf(f[i]));
                            mx = wave_max(mx); mx = mx > 0.f ? mx : 1.f; const float qs = 127.0f / mx;
                            u32x2 q0, q1; q0.x = pk4_i8(f[0], f[1], f[2], f[3], qs); q0.y = pk4_i8(f[4], f[5], f[6], f[7], qs); q1.x = pk4_i8(f[8], f[9], f[10], f[11], qs); q1.y = pk4_i8(f[12], f[13], f[14], f[15], qs);
                            { GAS u32x2* d = (GAS u32x2*)(XM8 + (size_t)t * DM) + lane; d[0] = q0; d[64] = q1; }
                            if (lane == 0) rsc[wv * 32 + rr + r] = rsm[r] * mx * (1.0f / 127.0f); } }
                }
                __syncthreads();
                const bool act = tid < 256; const int t = ru.pm * 256 + (tid & 255); const GAS float* lg = LOGITS + (size_t)t * 64;
                float gl[4]; float gmx = -INFINITY; int gi = 0;
#pragma unroll
                for (int q = 0; q < 4; ++q) { gl[q] = lg[32 + q] + brg[q]; if (gl[q] > gmx) { gmx = gl[q]; gi = q; } }
                float gs = 0.f;
#pragma unroll
                for (int q = 0; q < 4; ++q) gs += __expf(gl[q] - gmx);
                const float gp = 1.0f / gs;
                float el[8]; float e0 = -INFINITY; int i0 = 0;
#pragma unroll
                for (int q = 0; q < 8; ++q) { el[q] = lg[8 * gi + q] + bre[8 * gi + q]; if (el[q] > e0) { e0 = el[q]; i0 = q; } }
                float e1 = -INFINITY; int i1 = 0;
#pragma unroll
                for (int q = 0; q < 8; ++q) if (q != i0 && el[q] > e1) { e1 = el[q]; i1 = q; }
                const float w1 = 1.0f / (1.0f + __expf(e0 - e1)), w0 = 1.0f - w1;
                const int ex0 = 8 * gi + i0, ex1 = 8 * gi + i1;
                int r0 = 0, r1 = 0;
                if (act) { r0 = __hip_atomic_fetch_add(&cnt[ex0], 1, __ATOMIC_RELAXED, __HIP_MEMORY_SCOPE_WORKGROUP); r1 = __hip_atomic_fetch_add(&cnt[ex1], 1, __ATOMIC_RELAXED, __HIP_MEMORY_SCOPE_WORKGROUP); }
                __syncthreads();
                if (tid < 32) basep[tid] = (int)__hip_atomic_fetch_add(gcnt + tid, (unsigned)cnt[tid], __ATOMIC_RELAXED, __HIP_MEMORY_SCOPE_AGENT);
                __syncthreads();
                if (act) { const unsigned sb = __float_as_uint(rsc[tid]);
                    *(GAS u32x4*)(TAB + (size_t)(ex0 * MOE_CAP + basep[ex0] + r0) * 4) = (u32x4){(unsigned)t, sb, (unsigned)(2 * t), __float_as_uint(gp * w0)};
                    *(GAS u32x4*)(TAB + (size_t)(ex1 * MOE_CAP + basep[ex1] + r1) * 4) = (u32x4){(unsigned)t, sb, (unsigned)(2 * t + 1), __float_as_uint(gp * w1)}; }
                __syncthreads();
            }
        }
        SEAM(pb + 10);
        if (IN(pb + 12) || IN(pb + 13)) {
            PH_BEGIN
            if (tid == 0) { const GAS unsigned* gcnt = (const GAS unsigned*)(lw + WS_CTL) + CW_CNT + 64 * l; int acc = 0;
                for (int e = 0; e < NEXP; ++e) { const int c = (int)__hip_atomic_load(gcnt + e, __ATOMIC_RELAXED, __HIP_MEMORY_SCOPE_AGENT); acc += (c + 255) >> 8; pend[e] = acc; pcnt[e] = c; } }
            __syncthreads();
        }
        if (IN(pb + 12)) { PH_BEGIN
            pg8::Gemm g{(const GAS bf16_t*)XM8, (const GAS bf16_t*)(lw + WS_WGU + (size_t)l * NEXP * 512 * 1024), 512, 512, 512};
            pg8::MoeGather S{pend[NEXP - 1] * 2, 2, G, bx, pend, (size_t)512 * 1024, TAB, pcnt};
            pg8::EpiGateUp E{ACT, (const GAS float*)TAB, pend, pcnt, WDQ(l, 1)};
            pg8::gemm_phase<pg8::EpiGateUp, pg8::MoeGather, true>(L, g, S, E);
        }
        SEAM(pb + 12);
        if (IN(pb + 13)) { PH_BEGIN
            pg8::Gemm g{ACT, (const GAS bf16_t*)(lw + WS_WD) + (size_t)l * NEXP * 1024 * 256, 256, 256, 256};
            pg8::MoeOrder S{pend[NEXP - 1] * 4, 4, G, bx, pend, (size_t)1024 * 256 * 2, TAB, pcnt};
            pg8::EpiDown E{YBUF, TAB, pend, pcnt};
            pg8::gemm_phase<pg8::EpiDown, pg8::MoeOrder>(L, g, S, E);
        }
        SEAM(pb + 13);
        if (IN(pb + 14)) { PH_BEGIN
            for (int m0 = gw * 4; m0 < T; m0 += NGW * 4) {
                u32x2 xm[4][4], ya[4][4], yb[4][4]; f32x4 xv[4][4];
#pragma unroll
                for (int r = 0; r < 4; ++r) { const int m = m0 + r;
#pragma unroll
                    for (int j = 0; j < 4; ++j) { xm[r][j] = ((const GAS u32x2*)(XB + (size_t)m * DM) + lane)[64 * j];
                        ya[r][j] = ((const GAS u32x2*)(YBUF + (size_t)(2 * m) * DM) + lane)[64 * j]; yb[r][j] = ((const GAS u32x2*)(YBUF + (size_t)(2 * m + 1) * DM) + lane)[64 * j]; } }
#pragma unroll
                for (int r = 0; r < 4; ++r) { const int m = m0 + r; float s = 0.f, mx = 0.f;
#pragma unroll
                    for (int j = 0; j < 4; ++j) { const u32x2 x = xm[r][j], a = ya[r][j], b = yb[r][j]; f32x4 v;
                        v.x = bflo(x.x) + bflo(a.x) + bflo(b.x); v.y = bfhi(x.x) + bfhi(a.x) + bfhi(b.x); v.z = bflo(x.y) + bflo(a.y) + bflo(b.y); v.w = bfhi(x.y) + bfhi(a.y) + bfhi(b.y); xv[r][j] = v;
                        if (l == 1) ((GAS f32x4*)(out + (size_t)m * DM) + lane)[64 * j] = v;
                        else { u32x2 w; w.x = cvt_pk_bf16(v.x, v.y); w.y = cvt_pk_bf16(v.z, v.w); ((GAS u32x2*)(XB + (size_t)m * DM) + lane)[64 * j] = w; }
                        s += (v.x * v.x + v.y * v.y) + (v.z * v.z + v.w * v.w);
                        mx = __builtin_fmaxf(mx, __builtin_fmaxf(__builtin_fmaxf(__builtin_fabsf(v.x), __builtin_fabsf(v.y)), __builtin_fmaxf(__builtin_fabsf(v.z), __builtin_fabsf(v.w)))); }
                    if (l == 0) {
                    s = wave_sum(s); mx = wave_max(mx); mx = mx > 0.f ? mx : 1.f; const float qs = 127.0f / mx;
#pragma unroll
                    for (int j = 0; j < 4; ++j) { const f32x4 v = xv[r][j]; ((GAS unsigned*)(XB8 + (size_t)m * DM) + lane)[64 * j] = pk4_i8(v.x, v.y, v.z, v.w, qs); }
                    if (lane == 0) { SSQX[m] = s; XSC[m] = mx * (1.0f / 127.0f); } } }
            }
        }
        SEAM(pb + 14);
    }
}

extern "C" void kernel_launch(void* const* d_in, const GAS int* in_sizes, int n_in, void* d_out, int out_size, void* d_ws, size_t ws_size, hipStream_t stream) {
    static int grid = 0;
    if (grid == 0) {
        if (n_in != 25 || in_sizes[0] != T * DM || out_size != T * DM || ws_size < WS_END) { fprintf(stderr, "kernel_launch: unexpected shapes / workspace (%d inputs, ws %zu)\n", n_in, ws_size); grid = -1; return; }
        int dev = 0, cus = 0, per_cu = 0;
        if (hipGetDevice(&dev) != hipSuccess || hipDeviceGetAttribute(&cus, hipDeviceAttributeMultiprocessorCount, dev) != hipSuccess) { grid = -1; return; }
        if (hipFuncSetAttribute((const void*)fwd, hipFuncAttributeMaxDynamicSharedMemorySize, LDS_BYTES) != hipSuccess) { fprintf(stderr, "kernel_launch: hipFuncSetAttribute failed\n"); grid = -1; return; }
        if (hipOccupancyMaxActiveBlocksPerMultiprocessor(&per_cu, (const void*)fwd, 512, LDS_BYTES) != hipSuccess || per_cu < 1) fprintf(stderr, "kernel_launch: occupancy query reports %d\n", per_cu);
        (void)hipGetLastError();
        grid = cus;
    }
    if (grid < 0) return;
    if (hipMemsetAsync((char*)d_ws + WS_CTL, 0, CTL_ZERO_BYTES, stream) != hipSuccess) return;
    Args a{};
    for (int i = 0; i < 25; ++i) a.in[i] = (const GAS float*)d_in[i];
    a.out = (GAS float*)d_out; a.ws = (unsigned char*)d_ws;
#if ONE_LAUNCH
    a.ph_lo = 0; a.ph_hi = NPHASES;
    hipLaunchKernelGGL(fwd, dim3(grid), dim3(512), LDS_BYTES, stream, a);
#else
    for (int ph = 0; ph < NPHASES; ++ph) { a.ph_lo = ph; a.ph_hi = ph + 1; hipLaunchKernelGGL(fwd, dim3(grid), dim3(512), LDS_BYTES, stream, a); }
#endif
}
```

```cpp
#include <hip/hip_runtime.h>
#include <cstdio>
#include <cstdint>

#ifndef ONE_LAUNCH
#define ONE_LAUNCH 1
#endif

#define GAS __attribute__((address_space(1)))
#define LAS __attribute__((address_space(3)))
typedef unsigned short bf16_t;
typedef short bf16x8 __attribute__((ext_vector_type(8)));
typedef short s16x4 __attribute__((ext_vector_type(4)));
typedef float f32x4 __attribute__((ext_vector_type(4)));
typedef float f32x2 __attribute__((ext_vector_type(2)));
typedef float f32x16 __attribute__((ext_vector_type(16)));
typedef unsigned u32x4 __attribute__((ext_vector_type(4)));
typedef unsigned u32x2 __attribute__((ext_vector_type(2)));

constexpr int T = 65536, DM = 1024, SEQ = 4096, NB = 16;
constexpr int NPROJ1 = 1280;
constexpr int C_QA = 0, C_KA = 512, C_VA = 640, C_CQ = 768, C_CKV = 1024, C_KPE = 1152, C_GATE = 1184, IN_COLS = 3232;
constexpr int NEXP = 32, DEXP = 256;
constexpr int MOE_CAP = 65536;
constexpr float W8S = 32.0f, W8I = 1.0f / 32.0f;
constexpr int A_PAD = 2 * T + NEXP * 256;
constexpr float EPS = 1e-6f;
constexpr float LOG2E = 1.4426950408889634f;
constexpr float Y8S = 16.0f, Y8I = 1.0f / 16.0f;
constexpr float C2A = 0.125f * LOG2E;
constexpr float C2B = 0.10206207261596575f * LOG2E;

constexpr size_t MiB = 1u << 20;
constexpr size_t WS_CTL = 0, CTL_ZERO_BYTES = 2 * MiB;
constexpr size_t WS_SSQX = 2 * MiB;
constexpr size_t WS_RSMID = WS_SSQX + 256 * 1024;
constexpr size_t WS_ROPE = WS_RSMID + 256 * 1024;
constexpr size_t WS_ASE = 3 * MiB, WS_ASP = WS_ASE + 512 * 1024, WS_ASW = WS_ASP + 512 * 1024;
constexpr size_t WS_MY = WS_ASW + 512 * 1024, WS_MW = WS_MY + 768 * 1024, WS_MRS = WS_MW + 768 * 1024;
constexpr size_t WS_LOGITS = 8 * MiB;
constexpr size_t WS_WIN1 = 24 * MiB;
constexpr size_t WS_WG = 29 * MiB;
constexpr size_t WS_WQB = 37 * MiB;
constexpr size_t WS_WKVB = WS_WQB + 768 * 1024;
constexpr size_t WS_WOA = WS_WKVB + 768 * 1024;
constexpr size_t WS_WOB = WS_WOA + 2 * MiB;
constexpr size_t WS_WO = WS_WOB + 2 * MiB;
constexpr size_t WS_WR = WS_WO + 4 * MiB;
constexpr size_t WS_WGU = 48 * MiB;
constexpr size_t WS_WD = 112 * MiB;
constexpr size_t WS_XB = 144 * MiB;
constexpr size_t WS_PROJ1 = 272 * MiB;
constexpr size_t WS_QB = 432 * MiB;
constexpr size_t WS_KVB = 528 * MiB;
constexpr size_t WS_KB = 656 * MiB;
constexpr size_t WS_O = 752 * MiB;
constexpr size_t WS_GATES = 432 * MiB;
constexpr size_t WS_M = 272 * MiB;
constexpr size_t WS_XR = 272 * MiB;
constexpr size_t WS_ACT = 544 * MiB;
constexpr size_t WS_YBUF = 612 * MiB;
constexpr size_t WS_SSQP = 880 * MiB;
constexpr size_t WS_XB8 = 884 * MiB;
constexpr size_t WS_END = 948 * MiB;
static_assert(WS_MRS + 768 * 1024 <= WS_LOGITS && WS_LOGITS + (size_t)T * 64 * 4 <= WS_WIN1, "ws map");
static_assert(WS_WR + 1 * MiB <= WS_WGU && WS_WD + 32 * MiB <= WS_XB, "ws map");
static_assert(WS_XR + (size_t)A_PAD * 1024 * 2 <= WS_ACT && WS_ACT + (size_t)A_PAD * 256 * 2 <= WS_YBUF && WS_YBUF + (size_t)2 * T * 1024 * 2 <= WS_END, "ws map");

constexpr int CW_BAR = 4096;
constexpr int CW_WMAX = 20480;
constexpr int CW_CNT = 16384;

constexpr int RING_BYTES = 131072;
constexpr int MISC_OFF = RING_BYTES;
constexpr int LDS_BYTES = 147456;

#define LDS_WAIT() asm volatile("s_waitcnt lgkmcnt(0)" ::: "memory")
#define VM_WAIT() asm volatile("s_waitcnt vmcnt(0)" ::: "memory")

typedef float f32x2_cv __attribute__((ext_vector_type(2))); typedef __bf16 bf16x2_cv __attribute__((ext_vector_type(2)));
__device__ __forceinline__ unsigned cvt_pk_bf16(float lo, float hi) { const f32x2_cv v = {lo, hi}; const bf16x2_cv b = __builtin_convertvector(v, bf16x2_cv); return __builtin_bit_cast(unsigned, b); }
__device__ __forceinline__ unsigned pk4_i8(float a, float b, float c, float d, float s) {
    int q0 = (int)__builtin_rintf(a * s), q1 = (int)__builtin_rintf(b * s), q2 = (int)__builtin_rintf(c * s), q3 = (int)__builtin_rintf(d * s);
    q0 = q0 < -127 ? -127 : (q0 > 127 ? 127 : q0); q1 = q1 < -127 ? -127 : (q1 > 127 ? 127 : q1); q2 = q2 < -127 ? -127 : (q2 > 127 ? 127 : q2); q3 = q3 < -127 ? -127 : (q3 > 127 ? 127 : q3);
    return (unsigned)(q0 & 255) | ((unsigned)(q1 & 255) << 8) | ((unsigned)(q2 & 255) << 16) | ((unsigned)q3 << 24); }
__device__ __forceinline__ float wave_max(float v) {
#pragma unroll
    for (int o = 1; o < 64; o <<= 1) v = __builtin_fmaxf(v, __shfl_xor(v, o));
    return v;
}
__device__ __forceinline__ unsigned pk4_fp8(float a, float b, float c, float d) { int p = __builtin_amdgcn_cvt_pk_fp8_f32(a, b, 0, false); p = __builtin_amdgcn_cvt_pk_fp8_f32(c, d, p, true); return (unsigned)p; }
__device__ __forceinline__ float bflo(unsigned u) { return __uint_as_float(u << 16); }
__device__ __forceinline__ float bfhi(unsigned u) { return __uint_as_float(u & 0xffff0000u); }
__device__ __forceinline__ float bf1(bf16_t h) { return __uint_as_float((unsigned)h << 16); }
__device__ __forceinline__ float wave_sum(float v) {
#pragma unroll
    for (int o = 1; o < 64; o <<= 1) v += __shfl_xor(v, o);
    return v;
}
__device__ __forceinline__ float fsigmoid(float v) { return __builtin_amdgcn_rcpf(1.0f + __builtin_amdgcn_exp2f(-v * LOG2E)); }

namespace pg8 {
constexpr int BM = 256, BK = 64, HALF = 128, HTB = HALF * BK * 2, STAGE_BYTES = 8 * HTB, NXCD = 8, WGM = 8;
__host__ __device__ __forceinline__ int lds_byte(int r, int c) { const int st = (r >> 4) * 2 + (c >> 5), rr = r & 15, cc = c & 31, ob = rr * 64 + cc * 2; return st * 1024 + (ob ^ (((ob >> 9) & 1) << 5)); }
__host__ __device__ __forceinline__ void stage_rc(int b, int& R, int& C) { const int st = b / 1024, sb = b % 1024, swz = sb ^ (((sb >> 9) & 1) << 5); R = (st >> 1) * 16 + swz / 64; C = (st & 1) * 32 + (swz % 64) / 2; }
__host__ __device__ __forceinline__ int perm32(int rho) { const int n = rho >> 4, i = rho & 15; return 8 * (i >> 2) + 4 * n + (i & 3); }

struct Unit { int pm, pn; };
struct Gemm { const GAS bf16_t* A; const GAS bf16_t* Bt; int lda, ldb, K; };

struct StaticOrder {
    static constexpr bool GATHER = false;
    int nM, nN, nwg, G, c;
    __device__ void init(int M, int N, int G_, int c_) { nM = M / BM; nN = N / BM; nwg = nM * nN; G = G_; c = c_; }
    __device__ __forceinline__ bool next(int i, Unit& u) const {
        const long L = (long)i * G + c; if (L >= nwg) return false;
        int wgid = (int)L; { const int q = nwg / NXCD, r = nwg % NXCD, xcd = wgid % NXCD, off = wgid / NXCD; wgid = (xcd < r ? xcd * (q + 1) : r * (q + 1) + (xcd - r) * q) + off; }
        const int nig = WGM * nN, gid = wgid / nig, fm = gid * WGM, gsz = (nM - fm) < WGM ? (nM - fm) : WGM;
        u.pm = fm + ((wgid % nig) % gsz); u.pn = (wgid % nig) / gsz; return true;
    }
    __device__ __forceinline__ size_t aoff(const Gemm& g, const Unit& u) const { return (size_t)u.pm * BM * g.lda * 2; }
    __device__ __forceinline__ size_t boff(const Gemm& g, const Unit& u) const { return (size_t)u.pn * BM * g.ldb * 2; }
};
template <bool GA> struct MoeOrderT {
    static constexpr bool GATHER = GA;
    int nunits, npn, G, c; const LAS int* pend; size_t estride; const GAS int* tab; const LAS int* pcnt;
    __device__ bool next(int i, Unit& u) const { const long L = (long)i * G + c; if (L >= nunits) return false; u.pm = (int)(L / npn); u.pn = (int)(L % npn); return true; }
    __device__ __forceinline__ int expert(int pm) const { int e = 0; while (e < NEXP - 1 && pend[e] <= pm) ++e; return e; }
    __device__ __forceinline__ size_t aoff(const Gemm& g, const Unit& u) const { return (size_t)u.pm * BM * g.lda * 2; }
    __device__ __forceinline__ size_t boff(const Gemm& g, const Unit& u) const { return (size_t)expert(u.pm) * estride + (size_t)u.pn * BM * g.ldb * 2; }
    __device__ __forceinline__ void gather(const Gemm& g, const Unit& u, int tid, unsigned (&o)[2][2]) const {
        const int e = expert(u.pm), lp = u.pm - (e ? pend[e - 1] : 0), cnt = pcnt[e];
#pragma unroll
        for (int i = 0; i < 2; ++i) { int R, C; stage_rc(tid * 16 + i * 8192, R, C);
#pragma unroll
            for (int h = 0; h < 2; ++h) { const int pos = lp * 256 + h * HALF + R; int tok = 0; if (pos < cnt) tok = tab[(size_t)(e * MOE_CAP + pos) * 4];
                o[h][i] = (unsigned)tok * (unsigned)(g.lda * 2) + (unsigned)C * 2u; } }
    }
};
typedef MoeOrderT<false> MoeOrder; typedef MoeOrderT<true> MoeGather;

#define EPI_ROW(ai, m) (u.pm * 256 + (ai) * 128 + wr * 64 + (m) * 16 + fr)
#define EPI_COL(bj) (u.pn * 256 + (bj) * 128 + wc * 32 + 8 * fq)
#define EPI_COL16 (u.pn * 256 + wc * 64 + 16 * fq)
__device__ __forceinline__ int col16_src(int np) { const int j = np & 255; return (np & ~255) + 64 * ((j >> 5) & 3) + 16 * ((j >> 3) & 3) + 8 * (j >> 7) + (j & 7); }

template <bool SCALED> struct EpiScaleBf16T {
    static constexpr bool PERM = true;
    GAS bf16_t* O; int ldc; const GAS float* ssq; float invn; const GAS float* rowmul; float wsc;
    __device__ __forceinline__ void operator()(const f32x4 (&acc)[2][2][4][2], const Unit& u, int wr, int wc, int fr, int fq) const {
        float sc[2][4];
        if constexpr (SCALED) { float a[2][4], r[2][4];
#pragma unroll
            for (int ai = 0; ai < 2; ++ai)
#pragma unroll
                for (int m = 0; m < 4; ++m) { const int row = EPI_ROW(ai, m); a[ai][m] = ssq[row]; r[ai][m] = rowmul[row]; }
#pragma unroll
            for (int ai = 0; ai < 2; ++ai)
#pragma unroll
                for (int m = 0; m < 4; ++m) sc[ai][m] = __builtin_amdgcn_rsqf(a[ai][m] * invn + EPS) * r[ai][m] * wsc;
        }
#pragma unroll
        for (int ai = 0; ai < 2; ++ai)
#pragma unroll
            for (int m = 0; m < 4; ++m) { const int row = EPI_ROW(ai, m); const float s = SCALED ? sc[ai][m] : 1.0f;
#pragma unroll
                for (int bj = 0; bj < 2; ++bj) { const f32x4 v0 = acc[ai][bj][m][0] * s, v1 = acc[ai][bj][m][1] * s;
                    u32x4 w; w.x = cvt_pk_bf16(v0[0], v0[1]); w.y = cvt_pk_bf16(v0[2], v0[3]); w.z = cvt_pk_bf16(v1[0], v1[1]); w.w = cvt_pk_bf16(v1[2], v1[3]);
                    *(GAS u32x4*)(O + (size_t)row * ldc + EPI_COL(bj)) = w; } }
    }
};
typedef EpiScaleBf16T<true> EpiScaleBf16; typedef EpiScaleBf16T<false> EpiPlainBf16;
struct EpiProj1 {
    static constexpr bool PERM = true;
    GAS bf16_t* P; const GAS float* ssq; const GAS float* xsc; float wsc; const GAS float* gq; const GAS float* gk; GAS float* pcq; GAS float* pckv; GAS float* pkpe;
    __device__ __forceinline__ void operator()(const f32x4 (&acc)[2][2][4][2], const Unit& u, int wr, int wc, int fr, int fq) const {
        float sc[2][4];
        { float a[2][4], r[2][4];
#pragma unroll
          for (int ai = 0; ai < 2; ++ai)
#pragma unroll
              for (int m = 0; m < 4; ++m) { const int row = EPI_ROW(ai, m); a[ai][m] = ssq[row]; r[ai][m] = xsc[row]; }
#pragma unroll
          for (int ai = 0; ai < 2; ++ai)
#pragma unroll
              for (int m = 0; m < 4; ++m) sc[ai][m] = __builtin_amdgcn_rsqf(a[ai][m] * (1.0f / 1024.0f) + EPS) * r[ai][m] * wsc; }
        if (u.pn < 3) {
            const int head8 = 4 * u.pn + wc; const bool norm = head8 < 10;
            f32x4 g[2][2];
            if (norm) { const GAS float* gp = (head8 < 8 ? gq : gk) + 8 * fq; const float gs = head8 < 8 ? C2A : 1.0f;
#pragma unroll
                for (int bj = 0; bj < 2; ++bj)
#pragma unroll
                    for (int n = 0; n < 2; ++n) g[bj][n] = *(const GAS f32x4*)(gp + 32 * bj + 4 * n) * gs; }
#pragma unroll
            for (int ai = 0; ai < 2; ++ai)
#pragma unroll
                for (int m = 0; m < 4; ++m) { const int row = EPI_ROW(ai, m); f32x4 v[2][2];
#pragma unroll
                    for (int bj = 0; bj < 2; ++bj)
#pragma unroll
                        for (int n = 0; n < 2; ++n) v[bj][n] = acc[ai][bj][m][n] * sc[ai][m];
                    if (norm) { float s = 0.f;
#pragma unroll
                        for (int bj = 0; bj < 2; ++bj)
#pragma unroll
                            for (int n = 0; n < 2; ++n) s += (v[bj][n][0] * v[bj][n][0] + v[bj][n][1] * v[bj][n][1]) + (v[bj][n][2] * v[bj][n][2] + v[bj][n][3] * v[bj][n][3]);
                        s += __shfl_xor(s, 16); s += __shfl_xor(s, 32);
                        const float rs = __builtin_amdgcn_rsqf(s * (1.0f / 64.0f) + EPS);
#pragma unroll
                        for (int bj = 0; bj < 2; ++bj)
#pragma unroll
                            for (int n = 0; n < 2; ++n) v[bj][n] = v[bj][n] * rs * g[bj][n]; }
#pragma unroll
                    for (int bj = 0; bj < 2; ++bj) { u32x4 w; w.x = cvt_pk_bf16(v[bj][0][0], v[bj][0][1]); w.y = cvt_pk_bf16(v[bj][0][2], v[bj][0][3]); w.z = cvt_pk_bf16(v[bj][1][0], v[bj][1][1]); w.w = cvt_pk_bf16(v[bj][1][2], v[bj][1][3]);
                        *(GAS u32x4*)(P + (size_t)row * NPROJ1 + 64 * head8 + 32 * bj + 8 * fq) = w; } }
        } else {
#pragma unroll
            for (int ai = 0; ai < 2; ++ai)
#pragma unroll
                for (int m = 0; m < 4; ++m) { const int row = EPI_ROW(ai, m); float s0 = 0.f, s1 = 0.f;
#pragma unroll
                    for (int bj = 0; bj < 2; ++bj) { const f32x4 v0 = acc[ai][bj][m][0] * sc[ai][m], v1 = acc[ai][bj][m][1] * sc[ai][m];
                        const float q = (v0[0] * v0[0] + v0[1] * v0[1]) + (v0[2] * v0[2] + v0[3] * v0[3]) + (v1[0] * v1[0] + v1[1] * v1[1]) + (v1[2] * v1[2] + v1[3] * v1[3]);
                        if (bj == 0) s0 = q; else s1 = q;
                        u32x4 w; w.x = cvt_pk_bf16(v0[0], v0[1]); w.y = cvt_pk_bf16(v0[2], v0[3]); w.z = cvt_pk_bf16(v1[0], v1[1]); w.w = cvt_pk_bf16(v1[2], v1[3]);
                        *(GAS u32x4*)(P + (size_t)row * NPROJ1 + EPI_COL(bj)) = w; }
                    float s = (u.pn == 3) ? s0 + s1 : s0;
                    s += __shfl_xor(s, 16); s += __shfl_xor(s, 32);
                    if (fq == 0) ((u.pn == 3) ? pcq : pckv)[(size_t)row * 4 + wc] = s;
                    if (u.pn == 4 && wc == 0) { float t = s1; t += __shfl_xor(t, 16); t += __shfl_xor(t, 32); if (fq == 0) pkpe[row] = t; } }
        }
    }
};
struct EpiRowNorm4 {
    static constexpr bool PERM = true;
    GAS bf16_t* O; int ldc; const GAS float* part; float invn;
    __device__ __forceinline__ void operator()(const f32x4 (&acc)[2][2][4][2], const Unit& u, int wr, int wc, int fr, int fq) const {
        f32x4 p[2][4];
#pragma unroll
        for (int ai = 0; ai < 2; ++ai)
#pragma unroll
            for (int m = 0; m < 4; ++m) p[ai][m] = *(const GAS f32x4*)(part + (size_t)EPI_ROW(ai, m) * 4);
#pragma unroll
        for (int ai = 0; ai < 2; ++ai)
#pragma unroll
            for (int m = 0; m < 4; ++m) { const int row = EPI_ROW(ai, m); const float s = __builtin_amdgcn_rsqf(((p[ai][m].x + p[ai][m].y) + (p[ai][m].z + p[ai][m].w)) * invn + EPS);
#pragma unroll
                for (int bj = 0; bj < 2; ++bj) { const f32x4 v0 = acc[ai][bj][m][0] * s, v1 = acc[ai][bj][m][1] * s;
                    u32x4 w; w.x = cvt_pk_bf16(v0[0], v0[1]); w.y = cvt_pk_bf16(v0[2], v0[3]); w.z = cvt_pk_bf16(v1[0], v1[1]); w.w = cvt_pk_bf16(v1[2], v1[3]);
                    *(GAS u32x4*)(O + (size_t)row * ldc + EPI_COL(bj)) = w; } }
    }
};
struct EpiGates {
    static constexpr bool PERM = true;
    GAS bf16_t* O; const GAS float* ssq; const GAS float* bias; const GAS float* rowmul; float wsc;
    __device__ __forceinline__ void operator()(const f32x4 (&acc)[2][2][4][2], const Unit& u, int wr, int wc, int fr, int fq) const {
        f32x4 bv[2][2]; float a[2][4], r[2][4], sc[2][4];
#pragma unroll
        for (int bj = 0; bj < 2; ++bj)
#pragma unroll
            for (int n = 0; n < 2; ++n) bv[bj][n] = *(const GAS f32x4*)(bias + EPI_COL(bj) + 4 * n);
#pragma unroll
        for (int ai = 0; ai < 2; ++ai)
#pragma unroll
            for (int m = 0; m < 4; ++m) { const int row = EPI_ROW(ai, m); a[ai][m] = ssq[row]; r[ai][m] = rowmul[row]; }
#pragma unroll
        for (int ai = 0; ai < 2; ++ai)
#pragma unroll
            for (int m = 0; m < 4; ++m) sc[ai][m] = __builtin_amdgcn_rsqf(a[ai][m] * (1.0f / 1024.0f) + EPS) * r[ai][m] * wsc;
#pragma unroll
        for (int ai = 0; ai < 2; ++ai)
#pragma unroll
            for (int m = 0; m < 4; ++m) { const int row = EPI_ROW(ai, m); const float s = sc[ai][m];
#pragma unroll
                for (int bj = 0; bj < 2; ++bj) { f32x4 v0 = acc[ai][bj][m][0] * s + bv[bj][0], v1 = acc[ai][bj][m][1] * s + bv[bj][1];
#pragma unroll
                    for (int i = 0; i < 4; ++i) { v0[i] = fsigmoid(v0[i]); v1[i] = fsigmoid(v1[i]); }
                    u32x4 w; w.x = cvt_pk_bf16(v0[0], v0[1]); w.y = cvt_pk_bf16(v0[2], v0[3]); w.z = cvt_pk_bf16(v1[0], v1[1]); w.w = cvt_pk_bf16(v1[2], v1[3]);
                    *(GAS u32x4*)(O + (size_t)row * 2048 + EPI_COL(bj)) = w; } }
    }
};
struct EpiKv {
    static constexpr bool PERM = true;
    GAS bf16_t* KBo; GAS bf16_t* Vo; const GAS float* pckv; const GAS float* pkpe; const GAS bf16_t* P; const GAS float* gbk; const GAS float* rope;
    __device__ __forceinline__ void operator()(const f32x4 (&acc)[2][2][4][2], const Unit& u, int wr, int wc, int fr, int fq) const {
        asm volatile("" : "+v"(fr), "+v"(fq));
        float rc[2][4];
        { f32x4 p[2][4];
#pragma unroll
          for (int ai = 0; ai < 2; ++ai)
#pragma unroll
              for (int m = 0; m < 4; ++m) p[ai][m] = *(const GAS f32x4*)(pckv + (unsigned)(EPI_ROW(ai, m) * 4));
#pragma unroll
          for (int ai = 0; ai < 2; ++ai)
#pragma unroll
              for (int m = 0; m < 4; ++m) rc[ai][m] = __builtin_amdgcn_rsqf(((p[ai][m].x + p[ai][m].y) + (p[ai][m].z + p[ai][m].w)) * (1.0f / 128.0f) + EPS); }
        const int head = 2 * u.pn + (wc & 1);
        if (wc >= 2) {
#pragma unroll
            for (int ai = 0; ai < 2; ++ai)
#pragma unroll
                for (int m = 0; m < 4; ++m) { const int row = EPI_ROW(ai, m);
#pragma unroll
                    for (int bj = 0; bj < 2; ++bj) { const f32x4 v0 = acc[ai][bj][m][0] * rc[ai][m], v1 = acc[ai][bj][m][1] * rc[ai][m];
                        u32x4 w; w.x = cvt_pk_bf16(v0[0], v0[1]); w.y = cvt_pk_bf16(v0[2], v0[3]); w.z = cvt_pk_bf16(v1[0], v1[1]); w.w = cvt_pk_bf16(v1[2], v1[3]);
                        *(GAS u32x4*)(Vo + (unsigned)(row * 1024 + 128 * head + 64 + 32 * bj + 8 * fq)) = w; } }
        } else {
            float rsh[2][4];
            {
                float sk[2][4];
#pragma unroll
                for (int ai = 0; ai < 2; ++ai)
#pragma unroll
                    for (int m = 0; m < 4; ++m) sk[ai][m] = pkpe[(unsigned)EPI_ROW(ai, m)];
                f32x4 g[2][2];
#pragma unroll
                for (int bj = 0; bj < 2; ++bj)
#pragma unroll
                    for (int n = 0; n < 2; ++n) g[bj][n] = *(const GAS f32x4*)(gbk + (unsigned)(32 * bj + 8 * fq + 4 * n));
#pragma unroll
                for (int ai = 0; ai < 2; ++ai)
#pragma unroll
                    for (int m = 0; m < 4; ++m) { const int row = EPI_ROW(ai, m); f32x4 v[2][2]; float s = 0.f;
#pragma unroll
                        for (int bj = 0; bj < 2; ++bj)
#pragma unroll
                            for (int n = 0; n < 2; ++n) { v[bj][n] = acc[ai][bj][m][n] * rc[ai][m]; s += (v[bj][n][0] * v[bj][n][0] + v[bj][n][1] * v[bj][n][1]) + (v[bj][n][2] * v[bj][n][2] + v[bj][n][3] * v[bj][n][3]); }
                        s += __shfl_xor(s, 16); s += __shfl_xor(s, 32);
                        const float rs = __builtin_amdgcn_rsqf((s + sk[ai][m]) * (1.0f / 96.0f) + EPS); rsh[ai][m] = rs;
                        const unsigned dof = (unsigned)((((row >> 12) * 8 + head) * 64 + ((row & (SEQ - 1)) >> 6)) * 12 * 512 + (row & 63) * 8);
#pragma unroll
                        for (int bj = 0; bj < 2; ++bj) { const f32x4 a0 = v[bj][0] * rs * g[bj][0], a1 = v[bj][1] * rs * g[bj][1];
                            u32x4 w; w.x = cvt_pk_bf16(a0[0], a0[1]); w.y = cvt_pk_bf16(a0[2], a0[3]); w.z = cvt_pk_bf16(a1[0], a1[1]); w.w = cvt_pk_bf16(a1[2], a1[3]);
                            *(GAS u32x4*)(KBo + (dof + (4 * bj + fq) * 512)) = w; }
                        }
            }
            asm volatile("" : "+v"(fq), "+v"(fr) :: "memory");
            {
                const f32x4 gr0 = *(const GAS f32x4*)(gbk + (unsigned)(64 + 4 * fq)), gr1 = *(const GAS f32x4*)(gbk + (unsigned)(80 + 4 * fq));
#pragma unroll
                for (int ai = 0; ai < 2; ++ai) { u32x2 kp0[4], kp1[4]; f32x4 cs[4], sn[4];
#pragma unroll
                    for (int m = 0; m < 4; ++m) { const int row = EPI_ROW(ai, m);
                        const unsigned pof = (unsigned)(row * NPROJ1 + C_KPE + 4 * fq); kp0[m] = *(const GAS u32x2*)(P + pof); kp1[m] = *(const GAS u32x2*)(P + (pof + 16));
                        const unsigned rof = (unsigned)((row & (SEQ - 1)) * 32 + 4 * fq); cs[m] = *(const GAS f32x4*)(rope + rof); sn[m] = *(const GAS f32x4*)(rope + (rof + 16)); }
#pragma unroll
                    for (int m = 0; m < 4; ++m) { const int row = EPI_ROW(ai, m); const float rs = rsh[ai][m]; const unsigned dof = (unsigned)((((row >> 12) * 8 + head) * 64 + ((row & (SEQ - 1)) >> 6)) * 12 * 512 + (row & 63) * 8);
                        const f32x4 x1 = (f32x4){bflo(kp0[m].x), bfhi(kp0[m].x), bflo(kp0[m].y), bfhi(kp0[m].y)} * rs * gr0, x2 = (f32x4){bflo(kp1[m].x), bfhi(kp1[m].x), bflo(kp1[m].y), bfhi(kp1[m].y)} * rs * gr1;
                        const f32x4 o1 = x1 * cs[m] - x2 * sn[m], o2 = x1 * sn[m] + x2 * cs[m];
                        u32x2 w1, w2; w1.x = cvt_pk_bf16(o1[0], o1[1]); w1.y = cvt_pk_bf16(o1[2], o1[3]); w2.x = cvt_pk_bf16(o2[0], o2[1]); w2.y = cvt_pk_bf16(o2[2], o2[3]);
                        *(GAS u32x2*)(KBo + (dof + (8 + (fq >> 1)) * 512 + 4 * (fq & 1))) = w1; *(GAS u32x2*)(KBo + (dof + (10 + (fq >> 1)) * 512 + 4 * (fq & 1))) = w2; }
                    asm volatile("" ::: "memory"); }
            }
        }
    }
};
struct EpiGates2 {
    static constexpr bool PERM = true;
    GAS bf16_t* GR; GAS bf16_t* GBo; const GAS float* ssq; const GAS float* bias; const GAS float* rowmul; float wsc;
    __device__ __forceinline__ void operator()(const f32x4 (&acc)[2][2][4][2], const Unit& u, int wr, int wc, int fr, int fq) const {
        f32x4 ba[2], bb[2]; float a[2][4], r[2][4], sc[2][4];
        const int c0 = u.pn * 128 + wc * 32 + 8 * fq;
#pragma unroll
        for (int n = 0; n < 2; ++n) { ba[n] = *(const GAS f32x4*)(bias + c0 + 4 * n) * (-LOG2E); bb[n] = *(const GAS f32x4*)(bias + 1024 + c0 + 4 * n) * (-LOG2E); }
#pragma unroll
        for (int ai = 0; ai < 2; ++ai)
#pragma unroll
            for (int m = 0; m < 4; ++m) { const int row = EPI_ROW(ai, m); a[ai][m] = ssq[row]; r[ai][m] = rowmul[row]; }
#pragma unroll
        for (int ai = 0; ai < 2; ++ai)
#pragma unroll
            for (int m = 0; m < 4; ++m) sc[ai][m] = __builtin_amdgcn_rsqf(a[ai][m] * (1.0f / 1024.0f) + EPS) * r[ai][m] * (wsc * -LOG2E);
#pragma unroll
        for (int ai = 0; ai < 2; ++ai)
#pragma unroll
            for (int m = 0; m < 4; ++m) { const int row = EPI_ROW(ai, m); const float s = sc[ai][m]; f32x4 rr[2], gb[2];
#pragma unroll
                for (int n = 0; n < 2; ++n) { const f32x4 la = acc[ai][0][m][n] * s + ba[n], lb = acc[ai][1][m][n] * s + bb[n];
#pragma unroll
                    for (int i = 0; i < 4; ++i) { const float ea = __builtin_amdgcn_exp2f(la[i]), eb = __builtin_amdgcn_exp2f(lb[i]);
                        gb[n][i] = __builtin_amdgcn_rcpf(1.0f + eb); rr[n][i] = (1.0f + eb) * __builtin_amdgcn_rcpf(1.0f + ea); } }
                const size_t off = (size_t)row * 1024 + c0;
                u32x4 w; w.x = cvt_pk_bf16(rr[0][0], rr[0][1]); w.y = cvt_pk_bf16(rr[0][2], rr[0][3]); w.z = cvt_pk_bf16(rr[1][0], rr[1][1]); w.w = cvt_pk_bf16(rr[1][2], rr[1][3]); *(GAS u32x4*)(GR + off) = w;
                w.x = cvt_pk_bf16(gb[0][0], gb[0][1]); w.y = cvt_pk_bf16(gb[0][2], gb[0][3]); w.z = cvt_pk_bf16(gb[1][0], gb[1][1]); w.w = cvt_pk_bf16(gb[1][2], gb[1][3]); *(GAS u32x4*)(GBo + off) = w; }
    }
};
struct EpiMerge {
    static constexpr bool PERM = true; static constexpr bool HAS_MID = true;
    GAS bf16_t* Mo; const GAS bf16_t* GR; const GAS bf16_t* GBi;
    template <bool FIN> __device__ __forceinline__ void apply(f32x4 (&acc)[2][2][4][2], const Unit& u, int wr, int wc, int fr, int fq) const {
        const GAS bf16_t* G_ = FIN ? GBi : GR;
        u32x4 gv[2][4][2];
#pragma unroll
        for (int ai = 0; ai < 2; ++ai)
#pragma unroll
            for (int m = 0; m < 4; ++m)
#pragma unroll
                for (int bj = 0; bj < 2; ++bj) gv[ai][m][bj] = *(const GAS u32x4*)(G_ + (size_t)EPI_ROW(ai, m) * 1024 + EPI_COL16 + 8 * bj);
#pragma unroll
        for (int ai = 0; ai < 2; ++ai) {
#pragma unroll
            for (int m = 0; m < 4; ++m) { u32x4 w;
#pragma unroll
                for (int bj = 0; bj < 2; ++bj) { const u32x4 g = gv[ai][m][bj]; f32x4 v0 = acc[ai][bj][m][0], v1 = acc[ai][bj][m][1];
                    v0[0] *= bflo(g.x); v0[1] *= bfhi(g.x); v0[2] *= bflo(g.y); v0[3] *= bfhi(g.y); v1[0] *= bflo(g.z); v1[1] *= bfhi(g.z); v1[2] *= bflo(g.w); v1[3] *= bfhi(g.w);
                    if constexpr (FIN) { v0 = v0 * W8I; v1 = v1 * W8I; const unsigned lo_ = pk4_fp8(v0[0], v0[1], v0[2], v0[3]), hi_ = pk4_fp8(v1[0], v1[1], v1[2], v1[3]);
                        if (bj == 0) { w.x = lo_; w.y = hi_; } else { w.z = lo_; w.w = hi_; } }
                    else { acc[ai][bj][m][0] = v0; acc[ai][bj][m][1] = v1; } }
                if constexpr (FIN) *(GAS u32x4*)((GAS unsigned char*)Mo + (size_t)EPI_ROW(ai, m) * 1024 + EPI_COL16) = w; }
            asm volatile("" ::: "memory"); }
    }
    __device__ __forceinline__ void mid(f32x4 (&acc)[2][2][4][2], const Unit& u, int wr, int wc, int fr, int fq) const { apply<false>(acc, u, wr, wc, fr, fq); }
    __device__ __forceinline__ void operator()(f32x4 (&acc)[2][2][4][2], const Unit& u, int wr, int wc, int fr, int fq) const { apply<true>(acc, u, wr, wc, fr, fq); }
};
template <bool ACCUM> struct EpiGateMul {
    static constexpr bool PERM = true;
    GAS bf16_t* Mo; const GAS bf16_t* gates; int goff;
    __device__ __forceinline__ void operator()(const f32x4 (&acc)[2][2][4][2], const Unit& u, int wr, int wc, int fr, int fq) const {
#pragma unroll
        for (int ai = 0; ai < 2; ++ai) { u32x4 gv[4][2], pv[4][2];
#pragma unroll
            for (int m = 0; m < 4; ++m) { const int row = EPI_ROW(ai, m);
#pragma unroll
                for (int bj = 0; bj < 2; ++bj) { const int col = EPI_COL(bj); gv[m][bj] = *(const GAS u32x4*)(gates + (size_t)row * 2048 + goff + col);
                    if (ACCUM) pv[m][bj] = *(const GAS u32x4*)(Mo + (size_t)row * 1024 + col); } }
#pragma unroll
            for (int m = 0; m < 4; ++m) { const int row = EPI_ROW(ai, m);
#pragma unroll
                for (int bj = 0; bj < 2; ++bj) { const int col = EPI_COL(bj); const u32x4 g = gv[m][bj];
                    f32x4 v0 = acc[ai][bj][m][0], v1 = acc[ai][bj][m][1];
                    v0[0] *= bflo(g.x); v0[1] *= bfhi(g.x); v0[2] *= bflo(g.y); v0[3] *= bfhi(g.y);
                    v1[0] *= bflo(g.z); v1[1] *= bfhi(g.z); v1[2] *= bflo(g.w); v1[3] *= bfhi(g.w);
                    if (ACCUM) { const u32x4 p = pv[m][bj];
                        v0[0] += bflo(p.x); v0[1] += bfhi(p.x); v0[2] += bflo(p.y); v0[3] += bfhi(p.y);
                        v1[0] += bflo(p.z); v1[1] += bfhi(p.z); v1[2] += bflo(p.w); v1[3] += bfhi(p.w); }
                    u32x4 w; w.x = cvt_pk_bf16(v0[0], v0[1]); w.y = cvt_pk_bf16(v0[2], v0[3]); w.z = cvt_pk_bf16(v1[0], v1[1]); w.w = cvt_pk_bf16(v1[2], v1[3]);
                    *(GAS u32x4*)(Mo + (size_t)row * 1024 + col) = w; } }
            asm volatile("" ::: "memory"); }
    }
};
struct EpiResid {
    static constexpr bool PERM = true;
    const GAS float* xres; GAS bf16_t* xb; GAS float* ssq;
    __device__ __forceinline__ void operator()(const f32x4 (&acc)[2][2][4][2], const Unit& u, int wr, int wc, int fr, int fq) const {
#pragma unroll
        for (int ai = 0; ai < 2; ++ai) { f32x4 pre[4][2][2];
            if (xres) {
#pragma unroll
                for (int m = 0; m < 4; ++m) { const int row = EPI_ROW(ai, m);
#pragma unroll
                    for (int bj = 0; bj < 2; ++bj) { const size_t off = (size_t)row * 1024 + EPI_COL16 + 8 * bj; pre[m][bj][0] = *(const GAS f32x4*)(xres + off); pre[m][bj][1] = *(const GAS f32x4*)(xres + off + 4); } }
            } else {
                u32x4 pb[4][2];
#pragma unroll
                for (int m = 0; m < 4; ++m) { const int row = EPI_ROW(ai, m);
#pragma unroll
                    for (int bj = 0; bj < 2; ++bj) pb[m][bj] = *(const GAS u32x4*)(xb + (size_t)row * 1024 + EPI_COL16 + 8 * bj); }
#pragma unroll
                for (int m = 0; m < 4; ++m)
#pragma unroll
                    for (int bj = 0; bj < 2; ++bj) { const u32x4 p = pb[m][bj]; pre[m][bj][0] = (f32x4){bflo(p.x), bfhi(p.x), bflo(p.y), bfhi(p.y)}; pre[m][bj][1] = (f32x4){bflo(p.z), bfhi(p.z), bflo(p.w), bfhi(p.w)}; }
            }
#pragma unroll
            for (int m = 0; m < 4; ++m) { const int row = EPI_ROW(ai, m); float s = 0.f;
#pragma unroll
                for (int bj = 0; bj < 2; ++bj) { const size_t off = (size_t)row * 1024 + EPI_COL16 + 8 * bj;
                    const f32x4 v0 = acc[ai][bj][m][0] * W8I + pre[m][bj][0], v1 = acc[ai][bj][m][1] * W8I + pre[m][bj][1];
                    s += (v0[0] * v0[0] + v0[1] * v0[1]) + (v0[2] * v0[2] + v0[3] * v0[3]) + (v1[0] * v1[0] + v1[1] * v1[1]) + (v1[2] * v1[2] + v1[3] * v1[3]);
                    u32x4 w; w.x = cvt_pk_bf16(v0[0], v0[1]); w.y = cvt_pk_bf16(v0[2], v0[3]); w.z = cvt_pk_bf16(v1[0], v1[1]); w.w = cvt_pk_bf16(v1[2], v1[3]);
                    *(GAS u32x4*)(xb + off) = w; }
                s += __shfl_xor(s, 16); s += __shfl_xor(s, 32);
                if (fq == 0) ssq[(size_t)row * 16 + u.pn * 4 + wc] = s; }
            asm volatile("" ::: "memory"); }
    }
};
struct EpiLogits {
    static constexpr bool PERM = true;
    GAS float* L; const GAS float* ssqp;
    __device__ __forceinline__ void operator()(const f32x4 (&acc)[2][2][4][2], const Unit& u, int wr, int wc, int fr, int fq) const {
        if (u.pn != 0 || wc > 1) return;
#pragma unroll
        for (int ai = 0; ai < 2; ++ai) { f32x4 pp[4][4];
#pragma unroll
            for (int m = 0; m < 4; ++m) { const GAS f32x4* p = (const GAS f32x4*)(ssqp + (size_t)EPI_ROW(ai, m) * 16); pp[m][0] = p[0]; pp[m][1] = p[1]; pp[m][2] = p[2]; pp[m][3] = p[3]; }
#pragma unroll
            for (int m = 0; m < 4; ++m) { const int row = EPI_ROW(ai, m); const f32x4 a = pp[m][0], b = pp[m][1], c = pp[m][2], d = pp[m][3];
                const float sc = __builtin_amdgcn_rsqf((((a.x + a.y) + (a.z + a.w)) + ((b.x + b.y) + (b.z + b.w)) + ((c.x + c.y) + (c.z + c.w)) + ((d.x + d.y) + (d.z + d.w))) * (1.0f / 1024.0f) + EPS);
#pragma unroll
                for (int n = 0; n < 2; ++n) { const int col = wc * 32 + 8 * fq + 4 * n; if (col < 36) *(GAS f32x4*)(L + (size_t)row * 64 + col) = acc[ai][0][m][n] * sc; } } }
    }
};
struct EpiGateUp {
    static constexpr bool PERM = true;
    GAS bf16_t* act; const GAS float* tabf; const LAS int* pend; const LAS int* pcnt; float wsc;
    __device__ __forceinline__ void operator()(const f32x4 (&acc)[2][2][4][2], const Unit& u, int wr, int wc, int fr, int fq) const {
        int e = 0; while (e < NEXP - 1 && pend[e] <= u.pm) ++e;
        const int lp = u.pm - (e ? pend[e - 1] : 0), cnt = pcnt[e] - lp * 256; const unsigned base = (unsigned)(e * MOE_CAP + lp * 256);
        float sc[2][4];
#pragma unroll
        for (int ai = 0; ai < 2; ++ai)
#pragma unroll
            for (int m = 0; m < 4; ++m) { const int r = ai * 128 + wr * 64 + m * 16 + fr; const float v = tabf[(size_t)(base + r) * 4 + 1]; sc[ai][m] = (r < cnt) ? v : 0.f; }
#pragma unroll
        for (int ai = 0; ai < 2; ++ai)
#pragma unroll
            for (int m = 0; m < 4; ++m) { const int row = EPI_ROW(ai, m); const float s = sc[ai][m] * wsc; f32x4 a[2];
#pragma unroll
                for (int n = 0; n < 2; ++n) { const f32x4 gg = acc[ai][0][m][n] * s, uu = acc[ai][1][m][n] * s;
#pragma unroll
                    for (int i = 0; i < 4; ++i) a[n][i] = gg[i] * fsigmoid(gg[i]) * uu[i]; }
                u32x4 w; w.x = cvt_pk_bf16(a[0][0], a[0][1]); w.y = cvt_pk_bf16(a[0][2], a[0][3]); w.z = cvt_pk_bf16(a[1][0], a[1][1]); w.w = cvt_pk_bf16(a[1][2], a[1][3]);
                *(GAS u32x4*)(act + (size_t)row * 256 + u.pn * 128 + wc * 32 + 8 * fq) = w; }
    }
};
struct EpiDown {
    static constexpr bool PERM = true;
    GAS bf16_t* ybuf; const GAS int* tabi; const LAS int* pend; const LAS int* pcnt;
    __device__ __forceinline__ void operator()(const f32x4 (&acc)[2][2][4][2], const Unit& u, int wr, int wc, int fr, int fq) const {
        int e = 0; while (e < NEXP - 1 && pend[e] <= u.pm) ++e;
        const int lp = u.pm - (e ? pend[e - 1] : 0), cnt = pcnt[e] - lp * 256; const unsigned base = (unsigned)(e * MOE_CAP + lp * 256);
        int yd[2][4]; float sw[2][4];
#pragma unroll
        for (int ai = 0; ai < 2; ++ai)
#pragma unroll
            for (int m = 0; m < 4; ++m) { const int r = ai * 128 + wr * 64 + m * 16 + fr; const GAS int* en = tabi + (size_t)(base + r) * 4; const int y_ = en[2]; const float w_ = __int_as_float(en[3]);
                yd[ai][m] = (r < cnt) ? y_ : -1; sw[ai][m] = w_; }
#pragma unroll
        for (int ai = 0; ai < 2; ++ai)
#pragma unroll
            for (int m = 0; m < 4; ++m) { const float sc = sw[ai][m];
                if (yd[ai][m] >= 0) { const float s8 = sc * Y8S;
                    const f32x4 a0 = acc[ai][0][m][0] * s8, a1 = acc[ai][0][m][1] * s8, b0 = acc[ai][1][m][0] * s8, b1 = acc[ai][1][m][1] * s8;
                    u32x4 w; w.x = pk4_fp8(a0[0], a0[1], a0[2], a0[3]); w.y = pk4_fp8(a1[0], a1[1], a1[2], a1[3]); w.z = pk4_fp8(b0[0], b0[1], b0[2], b0[3]); w.w = pk4_fp8(b1[0], b1[1], b1[2], b1[3]);
                    *(GAS u32x4*)((GAS unsigned char*)ybuf + (size_t)yd[ai][m] * 1024 + EPI_COL16) = w; } }
    }
};

typedef int v4i32_t __attribute__((ext_vector_type(4)));
typedef long i64x2_t __attribute__((ext_vector_type(2)));
template <class Epi, class Sched, bool I8 = false, bool MID = false, bool F8 = false, bool ALIGN_EPI = true, bool SP2 = true>
__device__ __forceinline__ void gemm_phase(LAS unsigned char* lds, const Gemm g, const Sched& S, const Epi& E) {
    int tid_ = threadIdx.x; asm volatile("" : "+v"(tid_));
    const int tid = tid_, wid = __builtin_amdgcn_readfirstlane(tid >> 6), lane = tid & 63, wr = wid >> 2, wc = wid & 3, fr = lane & 15, fq = lane >> 4;
    int K_ = g.K; asm volatile("" : "+s"(K_));
    const int K = K_, nt = K / BK;
    unsigned voffA[2], voffB[2];
#pragma unroll
    for (int i = 0; i < 2; ++i) { int R, C; stage_rc(tid * 16 + i * 8192, R, C); const int Rb = Epi::PERM ? ((R & ~31) + perm32(R & 31)) : R;
        voffA[i] = (unsigned)(R * g.lda + C) * 2u; voffB[i] = (unsigned)(Rb * g.ldb + C) * 2u; }
    const size_t kstep = (size_t)(BK * 2);
    const size_t hstepA = (size_t)HALF * g.lda * 2, hstepB = (size_t)HALF * g.ldb * 2;
    const unsigned ldsw = (unsigned)wid * 1024u;
    const int aoff = lds_byte(wr * 64 + fr, fq * 8), boff = lds_byte(wc * 32 + fr, fq * 8);
#define PG8_SA(b, h) (((b) * 2 + (h)) * HTB)
#define PG8_SB(b, h) ((4 + (b) * 2 + (h)) * HTB)
#define PG8_STAGE(bufoff, gbase, voff) do { _Pragma("unroll") for (int _i = 0; _i < 2; ++_i) \
        __builtin_amdgcn_global_load_lds((const GAS unsigned*)((const char*)(gbase) + (voff)[_i]), (LAS unsigned*)(lds + (bufoff) + ldsw + _i * 8192), 16, 0, 0); } while (0)
#define PG8_LDA(dst, b, h) do { _Pragma("unroll") for (int m = 0; m < 4; ++m) _Pragma("unroll") for (int k = 0; k < 2; ++k) dst[m][k] = *(const LAS bf16x8*)(lds + PG8_SA(b, h) + aoff + m * 2048 + k * 1024); } while (0)
#define PG8_LDB(dst, b, h) do { _Pragma("unroll") for (int n = 0; n < 2; ++n) _Pragma("unroll") for (int k = 0; k < 2; ++k) dst[n][k] = *(const LAS bf16x8*)(lds + PG8_SB(b, h) + boff + n * 2048 + k * 1024); } while (0)
#define PG8_MMA(ai, bj, At, Bt) do { __builtin_amdgcn_s_setprio(1); _Pragma("unroll") for (int m = 0; m < 4; ++m) _Pragma("unroll") for (int n = 0; n < 2; ++n) _Pragma("unroll") for (int k = 0; k < 2; ++k) { \
        if constexpr (I8) acc[ai][bj][m][n] = __builtin_bit_cast(f32x4, __builtin_amdgcn_mfma_i32_16x16x64_i8(__builtin_bit_cast(v4i32_t, Bt[n][k]), __builtin_bit_cast(v4i32_t, At[m][k]), __builtin_bit_cast(v4i32_t, acc[ai][bj][m][n]), 0, 0, 0)); \
        else if constexpr (F8) { const i64x2_t b_ = __builtin_bit_cast(i64x2_t, Bt[n][k]), a_ = __builtin_bit_cast(i64x2_t, At[m][k]); \
            acc[ai][bj][m][n] = __builtin_amdgcn_mfma_f32_16x16x32_fp8_fp8(b_[0], a_[0], acc[ai][bj][m][n], 0, 0, 0); acc[ai][bj][m][n] = __builtin_amdgcn_mfma_f32_16x16x32_fp8_fp8(b_[1], a_[1], acc[ai][bj][m][n], 0, 0, 0); } \
        else acc[ai][bj][m][n] = __builtin_amdgcn_mfma_f32_16x16x32_bf16(Bt[n][k], At[m][k], acc[ai][bj][m][n], 0, 0, 0); } \
        __builtin_amdgcn_s_setprio(0); } while (0)
#define PG8_WAIT_V(n) asm volatile("s_waitcnt vmcnt(" #n ")" ::: "memory")
#define PG8_WAIT_L(n) asm volatile("s_waitcnt lgkmcnt(" #n ")" ::: "memory")
#define PG8_BAR __builtin_amdgcn_s_barrier()
#define PG8_SCHED __builtin_amdgcn_sched_barrier(0)
    Unit cur, nxt; int ui = 0;
    if (!S.next(0, cur)) return;
    unsigned gvc[2][2], gvn[2][2];
    if constexpr (Sched::GATHER) { S.gather(g, cur, tid, gvc); gvn[0][0] = gvc[0][0]; gvn[0][1] = gvc[0][1]; gvn[1][0] = gvc[1][0]; gvn[1][1] = gvc[1][1]; }
#define PG8_STAGE_A(b, h, aptr, ko, nx) do { if constexpr (Sched::GATHER) { unsigned sv_[2] = {(nx) ? gvn[h][0] : gvc[h][0], (nx) ? gvn[h][1] : gvc[h][1]}; PG8_STAGE(PG8_SA(b, h), (const char*)g.A + (ko), sv_); } \
        else PG8_STAGE(PG8_SA(b, h), (aptr), voffA); } while (0)
    f32x4 acc[2][2][4][2];
#pragma unroll
    for (int a = 0; a < 2; ++a)
#pragma unroll
        for (int b = 0; b < 2; ++b)
#pragma unroll
            for (int m = 0; m < 4; ++m)
#pragma unroll
                for (int n = 0; n < 2; ++n) acc[a][b][m][n] = (f32x4){0.f, 0.f, 0.f, 0.f};
    bf16x8 At[4][2], B0[2][2], B1[2][2];
    const char* cA = (const char*)g.A + S.aoff(g, cur); const char* cB = (const char*)g.Bt + S.boff(g, cur);
    const int ntm = nt - 1;
#define PG8_ROT(u_) ((MID || nt < 4) ? 0 : (((u_).pn & 3) * (nt >> 2)))
#define PG8_KO(rot_, t_) ((size_t)(((t_) + (rot_)) & ntm) * kstep)
    int rotc = PG8_ROT(cur);
    if constexpr (SP2) {
        PG8_STAGE(PG8_SB(0, 0), cB + PG8_KO(rotc, 0), voffB); PG8_STAGE(PG8_SB(0, 1), cB + hstepB + PG8_KO(rotc, 0), voffB); PG8_STAGE_A(0, 0, cA + PG8_KO(rotc, 0), PG8_KO(rotc, 0), false); PG8_STAGE_A(0, 1, cA + hstepA + PG8_KO(rotc, 0), PG8_KO(rotc, 0), false);
        if (wr == 1) PG8_BAR;
        PG8_WAIT_V(2); PG8_BAR;
        PG8_STAGE(PG8_SB(1, 0), cB + PG8_KO(rotc, 1), voffB); PG8_STAGE_A(1, 0, cA + PG8_KO(rotc, 1), PG8_KO(rotc, 1), false); PG8_STAGE(PG8_SB(1, 1), cB + hstepB + PG8_KO(rotc, 1), voffB);
        PG8_WAIT_V(6); PG8_BAR;
    }
    for (;;) {
        const bool has_next = S.next(ui + 1, nxt);
        const char* nA = has_next ? (const char*)g.A + S.aoff(g, nxt) : cA; const char* nB = has_next ? (const char*)g.Bt + S.boff(g, nxt) : cB;
        const int rotn = has_next ? PG8_ROT(nxt) : rotc;
        if constexpr (Sched::GATHER) { if (has_next) S.gather(g, nxt, tid, gvn); }
        for (int t = 0; t < nt; t += 2) {
            if constexpr (MID) { if (t == (nt >> 1)) E.mid(acc, cur, wr, wc, fr, fq); }
            const bool last = (t == nt - 2);
            const char* a1 = cA + PG8_KO(rotc, t + 1);
            const char* a2 = last ? nA + PG8_KO(rotn, 0) : cA + PG8_KO(rotc, t + 2); const char* b2 = last ? nB + PG8_KO(rotn, 0) : cB + PG8_KO(rotc, t + 2);
            const char* a3 = last ? nA + PG8_KO(rotn, 1) : cA + PG8_KO(rotc, t + 3); const char* b3 = last ? nB + PG8_KO(rotn, 1) : cB + PG8_KO(rotc, t + 3);
            const size_t ko1 = PG8_KO(rotc, t + 1), ko2 = last ? PG8_KO(rotn, 0) : PG8_KO(rotc, t + 2), ko3 = last ? PG8_KO(rotn, 1) : PG8_KO(rotc, t + 3); (void)ko1; (void)ko2; (void)ko3;
            PG8_LDB(B0, 0, 0); PG8_LDB(B1, 0, 1); PG8_SCHED; PG8_LDA(At, 0, 0); PG8_STAGE_A(1, 1, a1 + hstepA, ko1, false);
            PG8_WAIT_V(8); PG8_WAIT_L(0); PG8_BAR; PG8_MMA(0, 0, At, B0); PG8_MMA(0, 1, At, B1); PG8_BAR; PG8_SCHED;
            PG8_LDA(At, 0, 1); PG8_STAGE(PG8_SB(0, 0), b2, voffB); PG8_STAGE(PG8_SB(0, 1), b2 + hstepB, voffB); PG8_STAGE_A(0, 0, a2, ko2, last);
            PG8_WAIT_V(8); PG8_WAIT_L(0); PG8_BAR; PG8_MMA(1, 0, At, B0); PG8_MMA(1, 1, At, B1); PG8_BAR; PG8_SCHED;
            PG8_LDB(B0, 1, 0); PG8_LDB(B1, 1, 1); PG8_SCHED; PG8_LDA(At, 1, 0); PG8_STAGE_A(0, 1, a2 + hstepA, ko2, last);
            PG8_WAIT_V(8); PG8_WAIT_L(0); PG8_BAR; PG8_MMA(0, 0, At, B0); PG8_MMA(0, 1, At, B1); PG8_BAR; PG8_SCHED;
            PG8_LDA(At, 1, 1); PG8_STAGE(PG8_SB(1, 0), b3, voffB); PG8_STAGE(PG8_SB(1, 1), b3 + hstepB, voffB); PG8_STAGE_A(1, 0, a3, ko3, last);
            PG8_WAIT_V(8); PG8_WAIT_L(0); PG8_BAR; PG8_MMA(1, 0, At, B0); PG8_MMA(1, 1, At, B1); PG8_BAR; PG8_SCHED;
        }
        if constexpr (ALIGN_EPI) { if (wr == 0) PG8_BAR; }
        if constexpr (I8) {
#pragma unroll
            for (int a = 0; a < 2; ++a)
#pragma unroll
                for (int b = 0; b < 2; ++b)
#pragma unroll
                    for (int m = 0; m < 4; ++m)
#pragma unroll
                        for (int n = 0; n < 2; ++n) { const v4i32_t q = __builtin_bit_cast(v4i32_t, acc[a][b][m][n]); acc[a][b][m][n] = (f32x4){(float)q[0], (float)q[1], (float)q[2], (float)q[3]}; }
        }
        E(acc, cur, wr, wc, fr, fq);
        if (!has_next) break;
#pragma unroll
        for (int a = 0; a < 2; ++a)
#pragma unroll
            for (int b = 0; b < 2; ++b)
#pragma unroll
                for (int m = 0; m < 4; ++m)
#pragma unroll
                    for (int n = 0; n < 2; ++n) acc[a][b][m][n] = (f32x4){0.f, 0.f, 0.f, 0.f};
        cur = nxt; cA = nA; cB = nB; rotc = rotn; ++ui;
        if constexpr (Sched::GATHER) { gvc[0][0] = gvn[0][0]; gvc[0][1] = gvn[0][1]; gvc[1][0] = gvn[1][0]; gvc[1][1] = gvn[1][1]; }
        if constexpr (ALIGN_EPI) { if (wr == 1) PG8_BAR; }
    }
    PG8_WAIT_V(0);
    if constexpr (!ALIGN_EPI) { if (wr == 0) PG8_BAR; }
    PG8_BAR;
#undef PG8_SA
#undef PG8_SB
#undef PG8_STAGE
#undef PG8_STAGE_A
#undef PG8_LDA
#undef PG8_LDB
#undef PG8_MMA
#undef PG8_ROT
#undef PG8_KO
#undef PG8_WAIT_V
#undef PG8_WAIT_L
#undef PG8_BAR
#undef PG8_SCHED
}
}

namespace att {
typedef LAS const char* lds_cptr;
typedef short v4i16_t __attribute__((ext_vector_type(4)));
typedef float f32x2_t __attribute__((ext_vector_type(2))); typedef __bf16 bf16x2_t __attribute__((ext_vector_type(2)));
__device__ __forceinline__ int crow(int r, int hi) { return (r & 3) + 8 * (r >> 2) + 4 * hi; }
__device__ __forceinline__ void glds16(const GAS void* gsrc, unsigned lds_dst) { unsigned keep;
    asm volatile("s_mov_b32 %0, m0\n\ts_mov_b32 m0, %2\n\ts_nop 0\n\tglobal_load_lds_dwordx4 %1, off\n\ts_mov_b32 m0, %0" : "=&s"(keep) : "v"(gsrc), "s"(lds_dst) : "memory"); }
__device__ __forceinline__ void glds16s(const GAS void* sbase, unsigned voff, unsigned lds_dst) { unsigned keep;
    asm volatile("s_mov_b32 %0, m0\n\ts_mov_b32 m0, %3\n\ts_nop 0\n\tglobal_load_lds_dwordx4 %1, %2\n\ts_mov_b32 m0, %0" : "=&s"(keep) : "v"(voff), "s"(sbase), "s"(lds_dst) : "memory"); }
__device__ __forceinline__ unsigned cvtpk_s(float lo, float hi) { f32x2_t v = {lo, hi}; bf16x2_t b = __builtin_convertvector(v, bf16x2_t); return __builtin_bit_cast(unsigned, b); }
#define ATT_WAIT_BAR() asm volatile("s_waitcnt vmcnt(0) lgkmcnt(0)\n\ts_barrier" ::: "memory")
constexpr float THR = 8.0f;

template <int NQ> __device__ __forceinline__ void qk_tile(f32x16& p0, f32x16& p1, lds_cptr kslot, const bf16x8* qr, const f32x16& negm, int r32, int hi) {
    lds_cptr kb = kslot + hi * 1024 + r32 * 16;
    p0 = negm; p1 = negm;
#pragma unroll
    for (int d0 = 0; d0 < NQ; ++d0) {
        const bf16x8 b0 = *(const LAS bf16x8*)(kb + d0 * 2048);
        const bf16x8 b1 = *(const LAS bf16x8*)(kb + d0 * 2048 + 512);
        p0 = __builtin_amdgcn_mfma_f32_32x32x16_bf16(b0, qr[d0], p0, 0, 0, 0);
        p1 = __builtin_amdgcn_mfma_f32_32x32x16_bf16(b1, qr[d0], p1, 0, 0, 0);
    }
}
__device__ __forceinline__ void pv(f32x16* o, int vb, bf16x8 pa0, bf16x8 pa1, bf16x8 pa2, bf16x8 pa3) {
#pragma unroll
    for (int d0 = 0; d0 < 2; ++d0) { s16x4 lo[4], hi[4];
#pragma unroll
        for (int ks = 0; ks < 4; ++ks) {
            asm volatile("ds_read_b64_tr_b16 %0,%1 offset:%c2" : "=&v"(lo[ks]) : "v"(vb), "i"(d0 * 4096 + ks * 1024) : "memory");
            asm volatile("ds_read_b64_tr_b16 %0,%1 offset:%c2" : "=&v"(hi[ks]) : "v"(vb), "i"(d0 * 4096 + ks * 1024 + 512) : "memory"); }
        asm volatile("s_waitcnt lgkmcnt(0)" ::: "memory"); __builtin_amdgcn_sched_barrier(0);
#define PK(k) (bf16x8){lo[k][0], lo[k][1], lo[k][2], lo[k][3], hi[k][0], hi[k][1], hi[k][2], hi[k][3]}
        o[d0] = __builtin_amdgcn_mfma_f32_32x32x16_bf16(pa0, PK(0), o[d0], 0, 0, 0);
        o[d0] = __builtin_amdgcn_mfma_f32_32x32x16_bf16(pa1, PK(1), o[d0], 0, 0, 0);
        o[d0] = __builtin_amdgcn_mfma_f32_32x32x16_bf16(pa2, PK(2), o[d0], 0, 0, 0);
        o[d0] = __builtin_amdgcn_mfma_f32_32x32x16_bf16(pa3, PK(3), o[d0], 0, 0, 0);
#undef PK
    }
}
__device__ __forceinline__ void softmax_pv(f32x16& p0, f32x16& p1, float& mhat, float& l_reg, f32x16& negm, f32x16* o, bool first, LAS float* wsf, int vb, int r32, int hi) {
    float a = __builtin_fmaxf(p0[0], p1[0]);
#pragma unroll
    for (int r = 1; r < 16; ++r) a = __builtin_fmaxf(a, __builtin_fmaxf(p0[r], p1[r]));
    float rm = a;
    { auto rr = __builtin_amdgcn_permlane32_swap(__float_as_uint(rm), __float_as_uint(rm), false, false); rm = __builtin_fmaxf(__uint_as_float(rr[0]), __uint_as_float(rr[1])); }
    if (first) {
        const float dl = rm; mhat += dl;
#pragma unroll
        for (int r = 0; r < 16; ++r) { p0[r] -= dl; p1[r] -= dl; }
#pragma unroll
        for (int r = 0; r < 16; ++r) negm[r] = -mhat;
    } else if (__any(rm > THR)) {
        const float dl = __builtin_fmaxf(rm, 0.f); mhat += dl;
#pragma unroll
        for (int r = 0; r < 16; ++r) { p0[r] -= dl; p1[r] -= dl; }
#pragma unroll
        for (int r = 0; r < 16; ++r) negm[r] = -mhat;
        const float f = __builtin_amdgcn_exp2f(-dl); l_reg *= f;
        if (hi == 0) wsf[r32] = f;
        LDS_WAIT();
#pragma unroll
        for (int r = 0; r < 16; ++r) { const float fr_ = wsf[crow(r, hi)]; o[0][r] *= fr_; o[1][r] *= fr_; }
        LDS_WAIT();
    }
    float sacc = 0.f;
#pragma unroll
    for (int r = 0; r < 16; ++r) { p0[r] = __builtin_amdgcn_exp2f(p0[r]); p1[r] = __builtin_amdgcn_exp2f(p1[r]); sacc += p0[r] + p1[r]; }
    l_reg += sacc;
    u32x4 pw0, pw1, pw2, pw3;
    pw0 = (u32x4){cvtpk_s(p0[0], p0[1]), cvtpk_s(p0[2], p0[3]), cvtpk_s(p0[4], p0[5]), cvtpk_s(p0[6], p0[7])};
    pw1 = (u32x4){cvtpk_s(p0[8], p0[9]), cvtpk_s(p0[10], p0[11]), cvtpk_s(p0[12], p0[13]), cvtpk_s(p0[14], p0[15])};
    pw2 = (u32x4){cvtpk_s(p1[0], p1[1]), cvtpk_s(p1[2], p1[3]), cvtpk_s(p1[4], p1[5]), cvtpk_s(p1[6], p1[7])};
    pw3 = (u32x4){cvtpk_s(p1[8], p1[9]), cvtpk_s(p1[10], p1[11]), cvtpk_s(p1[12], p1[13]), cvtpk_s(p1[14], p1[15])};
    pv(o, vb, __builtin_bit_cast(bf16x8, pw0), __builtin_bit_cast(bf16x8, pw1), __builtin_bit_cast(bf16x8, pw2), __builtin_bit_cast(bf16x8, pw3));
}
__device__ __forceinline__ void softmax_pv_fixed(f32x16& p0, f32x16& p1, float& l_reg, f32x16* o, int vb) {
    float sacc = 0.f;
#pragma unroll
    for (int r = 0; r < 16; ++r) { p0[r] = __builtin_amdgcn_exp2f(p0[r]); p1[r] = __builtin_amdgcn_exp2f(p1[r]); sacc += p0[r] + p1[r]; }
    l_reg += sacc;
    u32x4 pw0, pw1, pw2, pw3;
    pw0 = (u32x4){cvtpk_s(p0[0], p0[1]), cvtpk_s(p0[2], p0[3]), cvtpk_s(p0[4], p0[5]), cvtpk_s(p0[6], p0[7])};
    pw1 = (u32x4){cvtpk_s(p0[8], p0[9]), cvtpk_s(p0[10], p0[11]), cvtpk_s(p0[12], p0[13]), cvtpk_s(p0[14], p0[15])};
    pw2 = (u32x4){cvtpk_s(p1[0], p1[1]), cvtpk_s(p1[2], p1[3]), cvtpk_s(p1[4], p1[5]), cvtpk_s(p1[6], p1[7])};
    pw3 = (u32x4){cvtpk_s(p1[8], p1[9]), cvtpk_s(p1[10], p1[11]), cvtpk_s(p1[12], p1[13]), cvtpk_s(p1[14], p1[15])};
    pv(o, vb, __builtin_bit_cast(bf16x8, pw0), __builtin_bit_cast(bf16x8, pw1), __builtin_bit_cast(bf16x8, pw2), __builtin_bit_cast(bf16x8, pw3));
}
__device__ __forceinline__ void store_o(const f32x16* o, float l_reg, LAS float* wsf, LAS bf16_t* stg, GAS bf16_t* Ow, int pitch, int lane, int r32, int hi) {
    { auto rr = __builtin_amdgcn_permlane32_swap(__float_as_uint(l_reg), __float_as_uint(l_reg), false, false); l_reg = __uint_as_float(rr[0]) + __uint_as_float(rr[1]); }
    if (hi == 0) wsf[32 + r32] = l_reg;
    LDS_WAIT();
    float rli[16];
#pragma unroll
    for (int r = 0; r < 16; ++r) rli[r] = __builtin_amdgcn_rcpf(wsf[32 + crow(r, hi)]);
#pragma unroll
    for (int r = 0; r < 16; ++r) { const int orow = crow(r, hi);
#pragma unroll
        for (int d0 = 0; d0 < 2; ++d0) stg[orow * 64 + d0 * 32 + r32] = (bf16_t)(cvt_pk_bf16(o[d0][r] * rli[r], 0.f) & 0xffffu); }
    LDS_WAIT();
#pragma unroll
    for (int i = 0; i < 4; ++i) { const int row = i * 8 + (lane >> 3), ch = lane & 7; const u32x4 v = *(const LAS u32x4*)(stg + row * 64 + ch * 8); *(GAS u32x4*)(Ow + (size_t)row * pitch + ch * 8) = v; }
    LDS_WAIT();
}

constexpr int M_NS = 4, M_KSLOT = 12288, M_VSLOT = 8192, M_LK = 0, M_LV = M_NS * M_KSLOT, M_LWS = M_LV + M_NS * M_VSLOT, M_LOST = M_LWS + 2048, M_LDS = M_LOST + 32768;
#define ATT_WAITN_BAR(N) asm volatile("s_waitcnt vmcnt(" #N ") lgkmcnt(0)\n\ts_barrier" ::: "memory")
__device__ __forceinline__ void mla_load_q(bf16x8 (&qr)[6], const GAS bf16_t* Qrow, const GAS float* gbq, const GAS float* rope, int pos, int hi) {
#pragma unroll
    for (int d0 = 0; d0 < 6; ++d0) qr[d0] = *(const GAS bf16x8*)(Qrow + d0 * 16 + hi * 8);
    float f[6][8]; float ss = 0.f;
#pragma unroll
    for (int d0 = 0; d0 < 6; ++d0) { const u32x4 w = __builtin_bit_cast(u32x4, qr[d0]);
        f[d0][0] = bflo(w.x); f[d0][1] = bfhi(w.x); f[d0][2] = bflo(w.y); f[d0][3] = bfhi(w.y); f[d0][4] = bflo(w.z); f[d0][5] = bfhi(w.z); f[d0][6] = bflo(w.w); f[d0][7] = bfhi(w.w);
#pragma unroll
        for (int j = 0; j < 8; ++j) ss += f[d0][j] * f[d0][j]; }
    ss += __shfl_xor(ss, 32);
    const float rs = __builtin_amdgcn_rsqf(ss * (1.0f / 96.0f) + EPS) * C2B;
#pragma unroll
    for (int d0 = 0; d0 < 6; ++d0) { const f32x4 g0 = *(const GAS f32x4*)(gbq + 16 * d0 + 8 * hi), g1 = *(const GAS f32x4*)(gbq + 16 * d0 + 8 * hi + 4);
        f[d0][0] *= rs * g0.x; f[d0][1] *= rs * g0.y; f[d0][2] *= rs * g0.z; f[d0][3] *= rs * g0.w; f[d0][4] *= rs * g1.x; f[d0][5] *= rs * g1.y; f[d0][6] *= rs * g1.z; f[d0][7] *= rs * g1.w; }
    { const GAS float* rp = rope + (size_t)pos * 32 + 8 * hi; const f32x4 c0 = *(const GAS f32x4*)rp, c1 = *(const GAS f32x4*)(rp + 4), s0 = *(const GAS f32x4*)(rp + 16), s1 = *(const GAS f32x4*)(rp + 20);
      const float cs[8] = {c0.x, c0.y, c0.z, c0.w, c1.x, c1.y, c1.z, c1.w}, sn[8] = {s0.x, s0.y, s0.z, s0.w, s1.x, s1.y, s1.z, s1.w};
#pragma unroll
      for (int j = 0; j < 8; ++j) { const float a = f[4][j], c = f[5][j]; f[4][j] = a * cs[j] - c * sn[j]; f[5][j] = a * sn[j] + c * cs[j]; } }
#pragma unroll
    for (int d0 = 0; d0 < 6; ++d0) { u32x4 w; w.x = cvt_pk_bf16(f[d0][0], f[d0][1]); w.y = cvt_pk_bf16(f[d0][2], f[d0][3]); w.z = cvt_pk_bf16(f[d0][4], f[d0][5]); w.w = cvt_pk_bf16(f[d0][6], f[d0][7]); qr[d0] = __builtin_bit_cast(bf16x8, w); }
}
__device__ __forceinline__ void qk_tile2(f32x16& a0, f32x16& a1, f32x16& b0, f32x16& b1, lds_cptr kslot, const bf16x8* qa, const bf16x8* qb, int r32, int hi) {
    lds_cptr kb = kslot + hi * 1024 + r32 * 16;
    a0 = f32x16{}; a1 = f32x16{}; b0 = f32x16{}; b1 = f32x16{};
    bf16x8 k0 = *(const LAS bf16x8*)(kb), k1 = *(const LAS bf16x8*)(kb + 512);
#pragma unroll
    for (int d0 = 0; d0 < 6; ++d0) {
        bf16x8 n0 = k0, n1 = k1;
        if (d0 < 5) { n0 = *(const LAS bf16x8*)(kb + (d0 + 1) * 2048); n1 = *(const LAS bf16x8*)(kb + (d0 + 1) * 2048 + 512); }
        __builtin_amdgcn_sched_barrier(0);
        a0 = __builtin_amdgcn_mfma_f32_32x32x16_bf16(k0, qa[d0], a0, 0, 0, 0);
        a1 = __builtin_amdgcn_mfma_f32_32x32x16_bf16(k1, qa[d0], a1, 0, 0, 0);
        b0 = __builtin_amdgcn_mfma_f32_32x32x16_bf16(k0, qb[d0], b0, 0, 0, 0);
        b1 = __builtin_amdgcn_mfma_f32_32x32x16_bf16(k1, qb[d0], b1, 0, 0, 0);
        __builtin_amdgcn_sched_barrier(0);
        k0 = n0; k1 = n1;
    }
}
__device__ __forceinline__ void exp_pack(f32x16& p0, f32x16& p1, float& l_reg, bf16x8 (&pa)[4], float sub) {
    float sacc = 0.f;
    if (sub != 0.f) {
#pragma unroll
        for (int r = 0; r < 16; ++r) { p0[r] -= sub; p1[r] -= sub; } }
#pragma unroll
    for (int r = 0; r < 16; ++r) { p0[r] = __builtin_amdgcn_exp2f(p0[r]); p1[r] = __builtin_amdgcn_exp2f(p1[r]); sacc += p0[r] + p1[r]; }
    l_reg += sacc;
    pa[0] = __builtin_bit_cast(bf16x8, (u32x4){cvtpk_s(p0[0], p0[1]), cvtpk_s(p0[2], p0[3]), cvtpk_s(p0[4], p0[5]), cvtpk_s(p0[6], p0[7])});
    pa[1] = __builtin_bit_cast(bf16x8, (u32x4){cvtpk_s(p0[8], p0[9]), cvtpk_s(p0[10], p0[11]), cvtpk_s(p0[12], p0[13]), cvtpk_s(p0[14], p0[15])});
    pa[2] = __builtin_bit_cast(bf16x8, (u32x4){cvtpk_s(p1[0], p1[1]), cvtpk_s(p1[2], p1[3]), cvtpk_s(p1[4], p1[5]), cvtpk_s(p1[6], p1[7])});
    pa[3] = __builtin_bit_cast(bf16x8, (u32x4){cvtpk_s(p1[8], p1[9]), cvtpk_s(p1[10], p1[11]), cvtpk_s(p1[12], p1[13]), cvtpk_s(p1[14], p1[15])});
}
__device__ __forceinline__ void pv2(f32x16* oa, f32x16* ob, int vb, const bf16x8 (&pa)[4], const bf16x8 (&pb)[4], bool doA, bool doB) {
    s16x4 lo[2][4], hi[2][4];
#pragma unroll
    for (int d0 = 0; d0 < 2; ++d0)
#pragma unroll
        for (int ks = 0; ks < 4; ++ks) {
            asm volatile("ds_read_b64_tr_b16 %0,%1 offset:%c2" : "=&v"(lo[d0][ks]) : "v"(vb), "i"(d0 * 4096 + ks * 1024) : "memory");
            asm volatile("ds_read_b64_tr_b16 %0,%1 offset:%c2" : "=&v"(hi[d0][ks]) : "v"(vb), "i"(d0 * 4096 + ks * 1024 + 512) : "memory"); }
#define PK(d, k) (bf16x8){lo[d][k][0], lo[d][k][1], lo[d][k][2], lo[d][k][3], hi[d][k][0], hi[d][k][1], hi[d][k][2], hi[d][k][3]}
#pragma unroll
    for (int d0 = 0; d0 < 2; ++d0) {
        if (d0 == 0) asm volatile("s_waitcnt lgkmcnt(8)" ::: "memory"); else asm volatile("s_waitcnt lgkmcnt(0)" ::: "memory");
        __builtin_amdgcn_sched_barrier(0);
        if (doA) {
#pragma unroll
            for (int k = 0; k < 4; ++k) oa[d0] = __builtin_amdgcn_mfma_f32_32x32x16_bf16(pa[k], PK(d0, k), oa[d0], 0, 0, 0); }
        if (doB) {
#pragma unroll
            for (int k = 0; k < 4; ++k) ob[d0] = __builtin_amdgcn_mfma_f32_32x32x16_bf16(pb[k], PK(d0, k), ob[d0], 0, 0, 0); }
    }
#undef PK
}
__device__ __forceinline__ void qk_one(f32x16& a0, f32x16& a1, lds_cptr kslot, const bf16x8* qa, int r32, int hi) {
    lds_cptr kb = kslot + hi * 1024 + r32 * 16;
    a0 = f32x16{}; a1 = f32x16{};
    bf16x8 k0 = *(const LAS bf16x8*)(kb), k1 = *(const LAS bf16x8*)(kb + 512);
#pragma unroll
    for (int d0 = 0; d0 < 6; ++d0) {
        bf16x8 n0 = k0, n1 = k1;
        if (d0 < 5) { n0 = *(const LAS bf16x8*)(kb + (d0 + 1) * 2048); n1 = *(const LAS bf16x8*)(kb + (d0 + 1) * 2048 + 512); }
        __builtin_amdgcn_sched_barrier(0);
        a0 = __builtin_amdgcn_mfma_f32_32x32x16_bf16(k0, qa[d0], a0, 0, 0, 0);
        a1 = __builtin_amdgcn_mfma_f32_32x32x16_bf16(k1, qa[d0], a1, 0, 0, 0);
        __builtin_amdgcn_sched_barrier(0);
        k0 = n0; k1 = n1;
    }
}
__device__ __forceinline__ void qkB_expA(f32x16& b0, f32x16& b1, f32x16& pA0, f32x16& pA1, float& la, bf16x8 (&pa)[4], lds_cptr kslot, const bf16x8* qb, int r32, int hi) {
    lds_cptr kb = kslot + hi * 1024 + r32 * 16;
    b0 = f32x16{}; b1 = f32x16{};
    bf16x8 k0 = *(const LAS bf16x8*)(kb), k1 = *(const LAS bf16x8*)(kb + 512);
    float sacc = 0.f;
#define EXPG(g) do { f32x16& P_ = ((g) < 4) ? pA0 : pA1; constexpr int r0_ = 4 * ((g) & 3); \
        float e0_ = __builtin_amdgcn_exp2f(P_[r0_]), e1_ = __builtin_amdgcn_exp2f(P_[r0_ + 1]), e2_ = __builtin_amdgcn_exp2f(P_[r0_ + 2]), e3_ = __builtin_amdgcn_exp2f(P_[r0_ + 3]); \
        sacc += (e0_ + e1_) + (e2_ + e3_); asm volatile("" : "+v"(e0_), "+v"(e1_), "+v"(e2_), "+v"(e3_), "+v"(sacc)); P_[r0_] = e0_; P_[r0_ + 1] = e1_; P_[r0_ + 2] = e2_; P_[r0_ + 3] = e3_; } while (0)
#define PACK(j) do { const f32x16& P_ = ((j) < 2) ? pA0 : pA1; constexpr int r0_ = 8 * ((j) & 1); u32x4 w_ = {cvtpk_s(P_[r0_], P_[r0_ + 1]), cvtpk_s(P_[r0_ + 2], P_[r0_ + 3]), cvtpk_s(P_[r0_ + 4], P_[r0_ + 5]), cvtpk_s(P_[r0_ + 6], P_[r0_ + 7])}; \
        asm volatile("" : "+v"(w_)); pa[j] = __builtin_bit_cast(bf16x8, w_); } while (0)
#pragma unroll
    for (int d0 = 0; d0 < 6; ++d0) {
        bf16x8 n0 = k0, n1 = k1;
        if (d0 < 5) { n0 = *(const LAS bf16x8*)(kb + (d0 + 1) * 2048); n1 = *(const LAS bf16x8*)(kb + (d0 + 1) * 2048 + 512); }
        __builtin_amdgcn_sched_barrier(0);
        b0 = __builtin_amdgcn_mfma_f32_32x32x16_bf16(k0, qb[d0], b0, 0, 0, 0);
        if (d0 == 0) EXPG(0); else if (d0 == 1) EXPG(2); else if (d0 == 2) EXPG(4); else if (d0 == 3) EXPG(6); else if (d0 == 4) PACK(0); else PACK(2);
        __builtin_amdgcn_sched_barrier(0);
        b1 = __builtin_amdgcn_mfma_f32_32x32x16_bf16(k1, qb[d0], b1, 0, 0, 0);
        if (d0 == 0) EXPG(1); else if (d0 == 1) EXPG(3); else if (d0 == 2) EXPG(5); else if (d0 == 3) EXPG(7); else if (d0 == 4) PACK(1); else PACK(3);
        __builtin_amdgcn_sched_barrier(0);
        k0 = n0; k1 = n1;
    }
#undef EXPG
#undef PACK
    la += sacc;
}
__device__ __forceinline__ void tail_pvA_expB_pvB(f32x16& pB0, f32x16& pB1, float& lb, const bf16x8 (&pa)[4], f32x16* oa, f32x16* ob, int vb) {
    s16x4 lo[2][4], hi[2][4];
#pragma unroll
    for (int d0 = 0; d0 < 2; ++d0)
#pragma unroll
        for (int ks = 0; ks < 4; ++ks) {
            asm volatile("ds_read_b64_tr_b16 %0,%1 offset:%c2" : "=&v"(lo[d0][ks]) : "v"(vb), "i"(d0 * 4096 + ks * 1024) : "memory");
            asm volatile("ds_read_b64_tr_b16 %0,%1 offset:%c2" : "=&v"(hi[d0][ks]) : "v"(vb), "i"(d0 * 4096 + ks * 1024 + 512) : "memory"); }
#define PK(d, k) (bf16x8){lo[d][k][0], lo[d][k][1], lo[d][k][2], lo[d][k][3], hi[d][k][0], hi[d][k][1], hi[d][k][2], hi[d][k][3]}
#define EXPG(g) do { f32x16& P_ = ((g) < 4) ? pB0 : pB1; constexpr int r0_ = 4 * ((g) & 3); \
        float e0_ = __builtin_amdgcn_exp2f(P_[r0_]), e1_ = __builtin_amdgcn_exp2f(P_[r0_ + 1]), e2_ = __builtin_amdgcn_exp2f(P_[r0_ + 2]), e3_ = __builtin_amdgcn_exp2f(P_[r0_ + 3]); \
        sacc += (e0_ + e1_) + (e2_ + e3_); asm volatile("" : "+v"(e0_), "+v"(e1_), "+v"(e2_), "+v"(e3_), "+v"(sacc)); P_[r0_] = e0_; P_[r0_ + 1] = e1_; P_[r0_ + 2] = e2_; P_[r0_ + 3] = e3_; } while (0)
    float sacc = 0.f;
    EXPG(0);
    asm volatile("s_waitcnt lgkmcnt(8)" ::: "memory"); __builtin_amdgcn_sched_barrier(0);
#define STEP(g) do { oa[(g) >> 2] = __builtin_amdgcn_mfma_f32_32x32x16_bf16(pa[(g) & 3], PK((g) >> 2, (g) & 3), oa[(g) >> 2], 0, 0, 0); \
        if ((g) + 1 < 8) EXPG((g) + 1); if ((g) == 3) asm volatile("s_waitcnt lgkmcnt(0)" ::: "memory"); __builtin_amdgcn_sched_barrier(0); } while (0)
    STEP(0); STEP(1); STEP(2); STEP(3); STEP(4); STEP(5); STEP(6); STEP(7);
#undef STEP
#undef EXPG
    lb += sacc;
    bf16x8 pb[4];
    pb[0] = __builtin_bit_cast(bf16x8, (u32x4){cvtpk_s(pB0[0], pB0[1]), cvtpk_s(pB0[2], pB0[3]), cvtpk_s(pB0[4], pB0[5]), cvtpk_s(pB0[6], pB0[7])});
    pb[1] = __builtin_bit_cast(bf16x8, (u32x4){cvtpk_s(pB0[8], pB0[9]), cvtpk_s(pB0[10], pB0[11]), cvtpk_s(pB0[12], pB0[13]), cvtpk_s(pB0[14], pB0[15])});
    pb[2] = __builtin_bit_cast(bf16x8, (u32x4){cvtpk_s(pB1[0], pB1[1]), cvtpk_s(pB1[2], pB1[3]), cvtpk_s(pB1[4], pB1[5]), cvtpk_s(pB1[6], pB1[7])});
    pb[3] = __builtin_bit_cast(bf16x8, (u32x4){cvtpk_s(pB1[8], pB1[9]), cvtpk_s(pB1[10], pB1[11]), cvtpk_s(pB1[12], pB1[13]), cvtpk_s(pB1[14], pB1[15])});
#pragma unroll
    for (int d0 = 0; d0 < 2; ++d0)
#pragma unroll
        for (int k = 0; k < 4; ++k) ob[d0] = __builtin_amdgcn_mfma_f32_32x32x16_bf16(pb[k], PK(d0, k), ob[d0], 0, 0, 0);
#undef PK
}
__device__ __forceinline__ void store_o8(const f32x16* o, float l_reg, LAS float* wsf, LAS unsigned char* stg, GAS unsigned char* Ow8, int pitch, int lane, int r32, int hi) {
    { auto rr = __builtin_amdgcn_permlane32_swap(__float_as_uint(l_reg), __float_as_uint(l_reg), false, false); l_reg = __uint_as_float(rr[0]) + __uint_as_float(rr[1]); }
    if (hi == 0) wsf[32 + r32] = l_reg;
    LDS_WAIT();
    float rli[16];
#pragma unroll
    for (int r = 0; r < 16; ++r) rli[r] = __builtin_amdgcn_rcpf(wsf[32 + crow(r, hi)]);
#pragma unroll
    for (int r = 0; r < 16; ++r) { const int orow = crow(r, hi);
        const int p = __builtin_amdgcn_cvt_pk_fp8_f32(o[0][r] * rli[r], o[1][r] * rli[r], 0, false);
        stg[orow * 64 + r32] = (unsigned char)(p & 0xff); stg[orow * 64 + 32 + r32] = (unsigned char)((p >> 8) & 0xff); }
    LDS_WAIT();
    { const int row = lane >> 1, hf = lane & 1; const u32x4 v0 = *(const LAS u32x4*)(stg + row * 64 + hf * 32), v1 = *(const LAS u32x4*)(stg + row * 64 + hf * 32 + 16);
      GAS unsigned char* d = Ow8 + (size_t)row * pitch + hf * 32; *(GAS u32x4*)d = v0; *(GAS u32x4*)(d + 16) = v1; }
    LDS_WAIT();
}
__device__ __forceinline__ void mla_unit(int b, int h, int qb, const GAS bf16_t* Q, const GAS bf16_t* K, const GAS bf16_t* V, GAS bf16_t* O, char* shm, float mfix, const GAS float* gbq, const GAS float* rope) {
    int tid_ = threadIdx.x; asm volatile("" : "+v"(tid_));
    const int tid = tid_, lane = tid & 63, r32 = lane & 31, hi = lane >> 5; const int wid = __builtin_amdgcn_readfirstlane(tid >> 6);
    const long rowbase = (long)b * SEQ; const int q0 = qb * 512;
    const unsigned lds0 = (unsigned)(uintptr_t)shm;
    const lds_cptr shm3 = (lds_cptr)shm;
    LAS float* wsf = (LAS float*)(shm3 + M_LWS) + wid * 64;
    const GAS bf16_t* Kb = K + (size_t)((b * 8 + h) * 64) * 12 * 512; const GAS bf16_t* Vb = V + rowbase * 1024 + h * 128 + 64;
    const unsigned kof0 = (unsigned)(lane * 8) * 2u;
    const unsigned vof = (unsigned)((16 * (wid & 3) + (lane >> 2)) * 1024 + (wid >> 2) * 32 + (lane & 3) * 8) * 2u;
    const int vb0 = (int)(lds0 + M_LV) + ((lane >> 4) & 1) * 32 + (lane & 3) * 8 + (4 * hi + ((lane & 15) >> 2)) * 64;
#define MLA_DMA(t, s) do { const GAS bf16_t* kt_ = Kb + (size_t)(t) * 12 * 512; const GAS bf16_t* vt_ = Vb + (size_t)(t) * 64 * 1024; \
        glds16s(kt_ + wid * 512, kof0, (unsigned)__builtin_amdgcn_readfirstlane(lds0 + M_LK + (s) * M_KSLOT + wid * 1024)); \
        glds16s(kt_ + (8 + (wid & 3)) * 512, kof0, (unsigned)__builtin_amdgcn_readfirstlane(lds0 + M_LK + (s) * M_KSLOT + (8 + (wid & 3)) * 1024)); \
        glds16s(vt_, vof, (unsigned)__builtin_amdgcn_readfirstlane(lds0 + M_LV + (s) * M_VSLOT + wid * 1024)); } while (0)
    const int NT = 8 * (qb + 1);
    MLA_DMA(0, 0); MLA_DMA(1, 1); MLA_DMA(2, 2);
    bf16x8 qa[6], qbb[6];
    mla_load_q(qa, Q + (rowbase + q0 + wid * 64 + r32) * 768 + h * 96, gbq, rope, q0 + wid * 64 + r32, hi);
    mla_load_q(qbb, Q + (rowbase + q0 + wid * 64 + 32 + r32) * 768 + h * 96, gbq, rope, q0 + wid * 64 + 32 + r32, hi);
    float la = 0.f, lb = 0.f; f32x16 oa[2], ob[2]; oa[0] = f32x16{}; oa[1] = f32x16{}; ob[0] = f32x16{}; ob[1] = f32x16{};
    const float sub = __builtin_fmaxf(mfix - 40.0f, 0.0f);
    const int qrelA = wid * 64 + r32, qrelB = qrelA + 32;
    const int NTw = NT - 7 + wid;
    for (int t = 0; t < NT; ++t) {
        const int rem = NT - 1 - t;
        if (rem >= 2) ATT_WAITN_BAR(6); else if (rem == 1) ATT_WAITN_BAR(3); else ATT_WAITN_BAR(0);
        if (t + 3 < NT) MLA_DMA(t + 3, (t + 3) & 3);
        if (t >= NTw) continue;
        const int s = t & 3, jb = t - (NT - 8);
        f32x16 pA0, pA1, pB0, pB1; bf16x8 pa[4];
        const int kb = 64 * jb + 4 * hi;
        qk_one(pA0, pA1, shm3 + M_LK + s * M_KSLOT, qa, r32, hi);
        if (jb >= 0) {
#pragma unroll
            for (int r = 0; r < 16; ++r) { const int kv = kb + (r & 3) + 8 * (r >> 2); if (kv > qrelA) pA0[r] = -INFINITY; if (kv + 32 > qrelA) pA1[r] = -INFINITY; } }
        if (sub != 0.f) {
#pragma unroll
            for (int r = 0; r < 16; ++r) { pA0[r] -= sub; pA1[r] -= sub; } }
        qkB_expA(pB0, pB1, pA0, pA1, la, pa, shm3 + M_LK + s * M_KSLOT, qbb, r32, hi);
        if (jb >= 0) {
#pragma unroll
            for (int r = 0; r < 16; ++r) { const int kv = kb + (r & 3) + 8 * (r >> 2); if (kv > qrelB) pB0[r] = -INFINITY; if (kv + 32 > qrelB) pB1[r] = -INFINITY; } }
        if (sub != 0.f) {
#pragma unroll
            for (int r = 0; r < 16; ++r) { pB0[r] -= sub; pB1[r] -= sub; } }
        tail_pvA_expB_pvB(pB0, pB1, lb, pa, oa, ob, vb0 + s * M_VSLOT);
    }
    store_o8(oa, la, wsf, (LAS unsigned char*)(shm3 + M_LOST) + wid * 4096, (GAS unsigned char*)O + (rowbase + q0 + wid * 64) * 1024 + 512 + h * 64, 1024, lane, r32, hi);
    store_o8(ob, lb, wsf, (LAS unsigned char*)(shm3 + M_LOST) + wid * 4096, (GAS unsigned char*)O + (rowbase + q0 + wid * 64 + 32) * 1024 + 512 + h * 64, 1024, lane, r32, hi);
    ATT_WAIT_BAR();
#undef MLA_DMA
}

constexpr int S_LK = 0, S_LV = 32768, S_LBIAS = 65536, S_LWS = S_LBIAS + 4096, S_LOST = S_LWS + 2048, S_LDS = S_LOST + 32768;
__device__ __forceinline__ void swa_unit(int b, int n, int g, const GAS bf16_t* P, GAS bf16_t* O, const GAS float* sinks, char* shm, float sbound) {
    int tid_ = threadIdx.x; asm volatile("" : "+v"(tid_));
    const int tid = tid_, lane = tid & 63, r32 = lane & 31, hi = lane >> 5; const int wid = __builtin_amdgcn_readfirstlane(tid >> 6);
    const unsigned lds0 = (unsigned)(uintptr_t)shm;
    const lds_cptr shm3 = (lds_cptr)shm;
    LAS float* wsf = (LAS float*)(shm3 + S_LWS) + wid * 64;
    const LAS float* biasl = (const LAS float*)(shm3 + S_LBIAS);
    const long kb0 = (long)b * SEQ + 128 * (n - 1);
    const int tt0 = (n == 0) ? 2 : 0;
    for (int tt = tt0; tt < 4; ++tt) {
        glds16(P + (kb0 + 64 * tt + lane) * NPROJ1 + C_KA + 64 * g + wid * 8, (unsigned)__builtin_amdgcn_readfirstlane(lds0 + S_LK + tt * 8192 + wid * 1024));
        glds16(P + (kb0 + 64 * tt + 16 * (wid & 3) + (lane >> 2)) * NPROJ1 + C_VA + 64 * g + (wid >> 2) * 32 + (lane & 3) * 8, (unsigned)__builtin_amdgcn_readfirstlane(lds0 + S_LV + tt * 8192 + wid * 1024));
    }
    const int vb0 = (int)(lds0 + S_LV) + ((lane >> 4) & 1) * 32 + (lane & 3) * 8 + (4 * hi + ((lane & 15) >> 2)) * 64;
    ATT_WAIT_BAR();
    for (int pass = 0; pass < 2; ++pass) {
        const int bq = wid + 8 * pass, hg = bq >> 2, j = bq & 3, head = 4 * g + hg;
        const long qrow0 = (long)b * SEQ + 128 * n + 32 * j;
        bf16x8 qr[4];
        { const GAS bf16_t* Qw = P + (qrow0 + r32) * NPROJ1 + C_QA + 64 * head + hi * 8;
#pragma unroll
          for (int d0 = 0; d0 < 4; ++d0) qr[d0] = *(const GAS bf16x8*)(Qw + d0 * 16); }
        const float sink2 = sinks[head] * LOG2E, mfix = __builtin_fmaxf(sbound, sink2);
        float l_reg = (hi == 0) ? __builtin_amdgcn_exp2f(sink2 - mfix) : 0.0f; f32x16 o[2]; o[0] = f32x16{}; o[1] = f32x16{}; f32x16 negm;
#pragma unroll
        for (int r = 0; r < 16; ++r) negm[r] = -mfix;
        const int ts = (j < 2) ? 0 : 1;
        for (int tt = ts; tt < ts + 3; ++tt) {
            if (tt < tt0) continue;
            f32x16 p0, p1;
            qk_tile<4>(p0, p1, shm3 + S_LK + tt * 8192, qr, negm, r32, hi);
            const int dbase = 32 * j + r32 + 128 - 64 * tt - 4 * hi;
#pragma unroll
            for (int r = 0; r < 16; ++r) { const int d0_ = dbase - ((r & 3) + 8 * (r >> 2)), d1_ = d0_ - 32;
                const float b0 = biasl[head * 128 + (d0_ & 127)], b1 = biasl[head * 128 + (d1_ & 127)];
                p0[r] = (d0_ >= 0 && d0_ < 128) ? p0[r] + b0 : -INFINITY;
                p1[r] = (d1_ >= 0 && d1_ < 128) ? p1[r] + b1 : -INFINITY; }
            softmax_pv_fixed(p0, p1, l_reg, o, vb0 + tt * 8192);
        }
        store_o8(o, l_reg, wsf, (LAS unsigned char*)(shm3 + S_LOST) + wid * 4096, (GAS unsigned char*)O + qrow0 * 1024 + 64 * head, 1024, lane, r32, hi);
    }
    ATT_WAIT_BAR();
}
}

#define XB_TMO      128
#define XB_XCNT(j)  (256  + 64 * (j))
#define XB_XSUB(j)  (1280 + 64 * (j))
#define XB_XGEN(j)  (2304 + 64 * (j))
#define XB_TOP      3328
#define XB_TOPGEN   3392
#define XCD_BAR_WORDS 3456
#define XB_SPIN_CAP (1u << 22)
__device__ __forceinline__ unsigned xb_ld(unsigned* p)              { return __hip_atomic_load(p, __ATOMIC_RELAXED, __HIP_MEMORY_SCOPE_AGENT); }
__device__ __forceinline__ unsigned xb_add(unsigned* p, unsigned v) { return __hip_atomic_fetch_add(p, v, __ATOMIC_RELAXED, __HIP_MEMORY_SCOPE_AGENT); }
__device__ __forceinline__ unsigned xb_xcc_id() { return (unsigned)__builtin_amdgcn_s_getreg((3 << 11) | 20) & 0xFu; }
#define XB_SPIN(cond, bar) do { unsigned _sp = 0; while (cond) { __builtin_amdgcn_s_sleep(1); \
    if ((++_sp & 255u) == 0u) { if (xb_ld(&(bar)[XB_TMO])) break; if (_sp > XB_SPIN_CAP) { atomicAdd(&(bar)[XB_TMO], 1u); break; } } } } while (0)
struct XcdBarrier { unsigned* bar; unsigned x; volatile LAS unsigned* st; };
__device__ __forceinline__ XcdBarrier xcd_barrier_post(unsigned* bar, volatile LAS unsigned* st) {
    XcdBarrier b; b.bar = bar; b.x = xb_xcc_id(); b.st = st;
    if (threadIdx.x == 0) (void)xb_add(&bar[XB_XCNT(b.x)], 1u);
    return b;
}
__device__ __forceinline__ void xcd_barrier_complete(unsigned* bar, unsigned x, unsigned& nloc, unsigned& nx) {
    const unsigned G = gridDim.x * gridDim.y * gridDim.z;
    unsigned sum, cnt, mine, sp = 0u;
    for (;;) {
        sum = 0u; cnt = 0u; mine = 0u;
#pragma unroll
        for (unsigned j = 0; j < 16; ++j) { const unsigned c = xb_ld(&bar[XB_XCNT(j)]); sum += c; cnt += (c > 0u) ? 1u : 0u; mine = (j == x) ? c : mine; }
        if (sum == G) break;
        __builtin_amdgcn_s_sleep(1);
        if ((++sp & 255u) == 0u) { if (xb_ld(&bar[XB_TMO])) break; if (sp > XB_SPIN_CAP) { atomicAdd(&bar[XB_TMO], 1u); break; } }
    }
    nloc = mine > 0u ? mine : 1u; nx = cnt > 0u ? cnt : 1u;
}
__device__ __forceinline__ void xcd_barrier(const XcdBarrier& b) {
    asm volatile("s_waitcnt vmcnt(0)" ::: "memory");
    __syncthreads();
    if (threadIdx.x == 0) {
        unsigned* bar = b.bar;
        __builtin_amdgcn_s_waitcnt(0);
        unsigned nloc = b.st[0], nx = b.st[1];
        if (nloc == 0u) { xcd_barrier_complete(bar, b.x, nloc, nx); b.st[0] = nloc; b.st[1] = nx; }
        const unsigned old = xb_add(&bar[XB_XSUB(b.x)], 1u);
        const unsigned gen = old / nloc;
        if (old + 1u == (gen + 1u) * nloc) {
            __builtin_amdgcn_fence(__ATOMIC_RELEASE, "agent");
            asm volatile("s_waitcnt vmcnt(0)" ::: "memory");
            const unsigned og = xb_add(&bar[XB_TOP], 1u);
            const unsigned tg = og / nx;
            if (og + 1u == (tg + 1u) * nx) xb_add(&bar[XB_TOPGEN], 1u);
            else XB_SPIN(xb_ld(&bar[XB_TOPGEN]) == tg, bar);
            __builtin_amdgcn_fence(__ATOMIC_ACQUIRE, "agent");
            xb_add(&bar[XB_XGEN(b.x)], 1u);
            asm volatile("s_waitcnt vmcnt(0)" ::: "memory");
        } else {
            XB_SPIN(xb_ld(&bar[XB_XGEN(b.x)]) == gen, bar);
            __builtin_amdgcn_fence(__ATOMIC_ACQUIRE, "agent");
            asm volatile("s_waitcnt vmcnt(0)" ::: "memory");
        }
    }
    __syncthreads();
}

enum { MAP_NAT = 0, MAP_GU = 1, MAP_ROUTER = 2 };
template <int Q8 = 0> __device__ __forceinline__ void cvt_item(const GAS float* sp, int ns, const GAS float* gain, GAS bf16_t* dst, int ldd, int k0, int n0, LAS float* scr, int lane, float qs = 1.f) {
    { float vv[32], gg[32];
#pragma unroll
      for (int i = 0; i < 32; ++i) { const int kk = 2 * i + (lane >> 5); vv[i] = sp ? sp[(size_t)(k0 + kk) * ns] : 0.f; gg[i] = gain ? gain[k0 + kk] : 1.f; }
#pragma unroll
      for (int i = 0; i < 32; ++i) { const int kk = 2 * i + (lane >> 5); scr[kk * 33 + (lane & 31)] = vv[i] * gg[i]; } }
    LDS_WAIT(); asm volatile("" ::: "memory");
    const int ch = lane & 7;
#pragma unroll
    for (int j = 0; j < 4; ++j) { const int n = (lane >> 3) + 8 * j; const LAS float* s = scr + (8 * ch) * 33 + n;
        if constexpr (Q8 == 2) { u32x2 o; o.x = pk4_fp8(s[0 * 33] * qs, s[1 * 33] * qs, s[2 * 33] * qs, s[3 * 33] * qs); o.y = pk4_fp8(s[4 * 33] * qs, s[5 * 33] * qs, s[6 * 33] * qs, s[7 * 33] * qs);
            *(GAS u32x2*)((GAS unsigned char*)dst + (size_t)(n0 + n) * ldd + k0 + 8 * ch) = o; }
        else if constexpr (Q8 == 1) { u32x2 o; o.x = pk4_i8(s[0 * 33], s[1 * 33], s[2 * 33], s[3 * 33], qs); o.y = pk4_i8(s[4 * 33], s[5 * 33], s[6 * 33], s[7 * 33], qs);
            *(GAS u32x2*)((GAS unsigned char*)dst + (size_t)(n0 + n) * ldd + k0 + 8 * ch) = o; }
        else { u32x4 o; o.x = cvt_pk_bf16(s[0 * 33], s[1 * 33]); o.y = cvt_pk_bf16(s[2 * 33], s[3 * 33]); o.z = cvt_pk_bf16(s[4 * 33], s[5 * 33]); o.w = cvt_pk_bf16(s[6 * 33], s[7 * 33]);
            *(GAS u32x4*)(dst + (size_t)(n0 + n) * ldd + k0 + 8 * ch) = o; } }
    LDS_WAIT(); asm volatile("" ::: "memory");
}
template <int Q8 = 0> __device__ __forceinline__ void cvt_nat(const GAS float* src, int Nsrc, int coff, int nvalid, const GAS float* gain, GAS bf16_t* dst, int K, int Ndst, int item, LAS float* scr, int lane, float qs = 1.f) {
    const int nblk = Ndst / 32, kb = item / nblk, nb = item % nblk, n0 = 32 * nb, np = n0 + (lane & 31);
    cvt_item<Q8>(np < nvalid ? src + coff + np : nullptr, Nsrc, gain, dst, K, 64 * kb, n0, scr, lane, qs);
}

struct Args { const GAS float* in[25]; GAS float* out; unsigned char* ws; int ph_lo, ph_hi; };
constexpr int NPH_LAYER = 15, NPHASES = 1 + 2 * NPH_LAYER;

__global__ void __launch_bounds__(512, 2) fwd(Args args) {
    extern __shared__ __attribute__((aligned(16))) unsigned char lds[];
    LAS unsigned char* L = (LAS unsigned char*)lds;
    volatile LAS unsigned* MISC = (volatile LAS unsigned*)(L + MISC_OFF);
    LAS int* pend = (LAS int*)(L + MISC_OFF + 64);
    LAS int* pcnt = (LAS int*)(L + MISC_OFF + 256);
    const int tid = threadIdx.x, lane = tid & 63, wave = __builtin_amdgcn_readfirstlane(tid >> 6);
    const int G = gridDim.x, bx = blockIdx.x;
    const int vcu = (G % 8 == 0) ? (bx % 8) * (G / 8) + bx / 8 : bx;
    const int gw = vcu * 8 + wave, NGW = G * 8;
    typedef __attribute__((address_space(4))) const unsigned long long* karg_t;
    const karg_t ka0 = (karg_t)__builtin_amdgcn_kernarg_segment_ptr();
    unsigned char* ws = (unsigned char*)ka0[26];
    unsigned* ctl = (unsigned*)(ws + WS_CTL);
    for (int u = tid; u < 256; u += 512) ((LAS unsigned*)(L + MISC_OFF))[u] = 0u;
    __syncthreads();
#if ONE_LAUNCH
    XcdBarrier bar = xcd_barrier_post(ctl + CW_BAR, MISC);
#define GRID_BAR() xcd_barrier(bar)
#else
#define GRID_BAR() do {} while (0)
#endif
    const int lo = args.ph_lo, hi = args.ph_hi;
#ifndef PHONLY
#define PHONLY -1
#endif
#define PHSEL(k) (PHONLY < 0 || (((k) == 0 ? 0 : (((k) - 1) % 15) + 1)) == PHONLY)
#define IN(k) (PHSEL(k) && lo <= (k) && (k) < hi)
#define SEAM(k) do { if (IN(k) && IN((k) + 1)) GRID_BAR(); } while (0)
#define PH_BEGIN int tid = threadIdx.x; asm volatile("" : "+v"(tid)); const int lane = tid & 63; (void)lane; karg_t ka = ka0; asm volatile("" : "+s"(ka)); unsigned char* lw = (unsigned char*)ka[26]; GAS float* out = (GAS float*)ka[25]; (void)lw; (void)out;
#define INP(k) ((const GAS float*)ka[k])
#define SSQX ((GAS float*)(lw + WS_SSQX))
#define SSQP ((GAS float*)(lw + WS_SSQP))
#define WMAXP ((GAS float*)(lw + WS_SSQP))
#define WABSV ((GAS float*)(lw + 7 * MiB))
#define XSC ((GAS float*)(lw + WS_RSMID))
#define ROPE ((GAS float*)(lw + WS_ROPE))
#define ASE ((GAS int*)(lw + WS_ASE))
#define ASP ((GAS int*)(lw + WS_ASP))
#define ASW ((GAS float*)(lw + WS_ASW))
#define MY ((GAS int*)(lw + WS_MY))
#define MW ((GAS float*)(lw + WS_MW))
#define MRS ((GAS float*)(lw + WS_MRS))
#define LOGITS ((GAS float*)(lw + WS_LOGITS))
#define PCQ ((GAS float*)(lw + WS_LOGITS))
#define PCKV ((GAS float*)(lw + WS_LOGITS + MiB))
#define PKPE ((GAS float*)(lw + WS_LOGITS + 2 * MiB))
#define XB ((GAS bf16_t*)(lw + WS_XB))
#define XB8 ((GAS unsigned char*)(lw + WS_XB8))
#define PROJ1 ((GAS bf16_t*)(lw + WS_PROJ1))
#define QB ((GAS bf16_t*)(lw + WS_QB))
#define KVB ((GAS bf16_t*)(lw + WS_KVB))
#define KB ((GAS bf16_t*)(lw + WS_KB))
#define OB ((GAS bf16_t*)(lw + WS_O))
#define GATES ((GAS bf16_t*)(lw + WS_GATES))
#define MB ((GAS bf16_t*)(lw + WS_M))
#define XM8 ((GAS unsigned char*)(lw + WS_XR))
#define TAB ((GAS int*)(lw + WS_XR + 64 * MiB))
#define ACT ((GAS bf16_t*)(lw + WS_ACT))
#define YBUF ((GAS bf16_t*)(lw + WS_YBUF))

    if (IN(0)) {
        PH_BEGIN
        {
          float mx_in0 = 0.f, mx_in1 = 0.f;
          { const int l = gw >> 10, k = gw & 1023;
            for (int rr = gw; rr < 2048; rr += NGW) { const int l2 = rr >> 10, k2 = rr & 1023; const GAS float* row = INP(2) + ((size_t)l2 * 1024 + k2) * IN_COLS; float mx = 0.f;
                for (int c = lane * 4; c < IN_COLS; c += 256) { const f32x4 q = *(const GAS f32x4*)(row + c); mx = __builtin_fmaxf(mx, __builtin_fmaxf(__builtin_fmaxf(__builtin_fabsf(q.x), __builtin_fabsf(q.y)), __builtin_fmaxf(__builtin_fabsf(q.z), __builtin_fabsf(q.w)))); }
                mx = wave_max(mx) * __builtin_fabsf(INP(1)[l2 * 1024 + k2]);
                if (l2 == 0) mx_in0 = __builtin_fmaxf(mx_in0, mx); else mx_in1 = __builtin_fmaxf(mx_in1, mx); }
            (void)l; (void)k; }
          for (int l2 = 0; l2 < 2; ++l2) { float mxw = 0.f;
            for (int r0 = gw * 4; r0 < 2 * NEXP * 1024; r0 += NGW * 4) { f32x4 q[4];
#pragma unroll
                for (int r = 0; r < 4; ++r) { const int rr = r0 + r, which = rr >> 15, ek = rr & 32767; q[r] = ((const GAS f32x4*)((which ? INP(23) : INP(22)) + ((size_t)l2 * NEXP * 1024 + ek) * 256) + lane)[0]; }
#pragma unroll
                for (int r = 0; r < 4; ++r) { const int k2 = (r0 + r) & 1023; const float g = __builtin_fabsf(INP(17)[l2 * 1024 + k2]);
                    mxw = __builtin_fmaxf(mxw, g * __builtin_fmaxf(__builtin_fmaxf(__builtin_fabsf(q[r].x), __builtin_fabsf(q[r].y)), __builtin_fmaxf(__builtin_fabsf(q[r].z), __builtin_fabsf(q[r].w)))); } }
            mxw = wave_max(mxw);
            if (lane == 0) WMAXP[(l2 * 2 + 1) * 2048 + gw] = mxw; }
          if (lane == 0) { WMAXP[0 * 2048 + gw] = mx_in0; WMAXP[2 * 2048 + gw] = mx_in1; } }
        { const GAS float* x_in = INP(0);
        for (int m0 = gw * 8; m0 < T; m0 += NGW * 8) {
            f32x4 v[8][4];
#pragma unroll
            for (int r = 0; r < 8; ++r)
#pragma unroll
                for (int j = 0; j < 4; ++j) v[r][j] = ((const GAS f32x4*)(x_in + (size_t)(m0 + r) * DM) + lane)[64 * j];
#pragma unroll
            for (int r = 0; r < 8; ++r) { float s = 0.f, mx = 0.f;
#pragma unroll
                for (int j = 0; j < 4; ++j) { const f32x4 q = v[r][j]; s += (q.x * q.x + q.y * q.y) + (q.z * q.z + q.w * q.w);
                    mx = __builtin_fmaxf(mx, __builtin_fmaxf(__builtin_fmaxf(__builtin_fabsf(q.x), __builtin_fabsf(q.y)), __builtin_fmaxf(__builtin_fabsf(q.z), __builtin_fabsf(q.w))));
                    }
                s = wave_sum(s); mx = wave_max(mx); mx = mx > 0.f ? mx : 1.f; const float qs = 127.0f / mx;
#pragma unroll
                for (int j = 0; j < 4; ++j) { const f32x4 q = v[r][j]; ((GAS unsigned*)(XB8 + (size_t)(m0 + r) * DM) + lane)[64 * j] = pk4_i8(q.x, q.y, q.z, q.w, qs); }
                if (lane == 0) { SSQX[m0 + r] = s; XSC[m0 + r] = mx * (1.0f / 127.0f); } }
        } }
        for (int e = bx * 512 + tid; e < SEQ * 16; e += G * 512) { const int pos = e >> 4, i = e & 15;
            const int i4 = i & 3; const double m4 = (i4 == 0) ? 1.0 : (i4 == 1) ? 0.5623413251903491 : (i4 == 2) ? 0.31622776601683794 : 0.1778279410038923;
            const int i16 = i >> 2; const double d4 = (i16 == 0) ? 1.0 : (i16 == 1) ? 0.1 : (i16 == 2) ? 0.01 : 0.001;
            const float ang = (float)pos * (float)(m4 * d4);
            double rev = (double)ang * 0.15915494309189535; rev -= __builtin_rint(rev); const float fr_ = (float)rev;
            ROPE[pos * 32 + i] = __builtin_amdgcn_cosf(fr_); ROPE[pos * 32 + 16 + i] = __builtin_amdgcn_sinf(fr_); }
            GRID_BAR();
        float wabs[4];
#pragma unroll
        for (int q = 0; q < 4; ++q) { float m = 0.f; for (int i = lane; i < NGW; i += 64) m = __builtin_fmaxf(m, WMAXP[q * 2048 + i]); m = wave_max(m); wabs[q] = m > 0.f ? m : 1.f; }
        if (bx == 0 && tid == 0) { WABSV[0] = wabs[0]; WABSV[1] = wabs[1]; WABSV[2] = wabs[2]; WABSV[3] = wabs[3]; }
#define WDQ(l_, t_) (WABSV[2 * (l_) + (t_)] * (1.0f / 127.0f))
#define WQS(l_, t_) (127.0f / wabs[2 * (l_) + (t_)])
        const float qs_in0 = WQS(0, 0), qs_in1 = WQS(1, 0), qs_gu0 = WQS(0, 1), qs_gu1 = WQS(1, 1);
        LAS float* scr = (LAS float*)(L + wave * 16384);
        constexpr int I_WIN1 = 16 * 40, I_WG = 16 * 64, I_WQB = 4 * 24, I_WKVB = 2 * 32, I_WOA = 8 * 32, I_WO = 16 * 32, I_WR = 16 * 8, I_WGU = 32 * 16 * 16, I_WD = 32 * 4 * 32;
        constexpr int NIT = I_WIN1 + I_WG + I_WQB + I_WKVB + 2 * I_WOA + I_WO + I_WR + I_WGU + I_WD;
        for (int it = gw; it < 2 * NIT; it += NGW) {
            const int l = it >= NIT ? 1 : 0; int r = it - l * NIT;
            if (r < I_WIN1) {
                const int kb = r / 40, nb = r % 40, n0 = 32 * nb, np = n0 + (lane & 31);
                int sc_ = np; if (np < 768) { const int pn = np >> 8, q = np & 255; sc_ = 64 * (4 * pn + ((q >> 5) & 3)) + 32 * (q >> 7) + (q & 31); }
                cvt_item<1>(np < C_GATE ? INP(2) + (size_t)l * 1024 * IN_COLS + sc_ : nullptr, IN_COLS, INP(1) + l * 1024, (GAS bf16_t*)(lw + WS_WIN1 + (size_t)l * 1280 * 1024), 1024, 64 * kb, n0, scr, lane, (l ? qs_in1 : qs_in0)); continue; } r -= I_WIN1;
            if (r < I_WG) {
                const int kb = r / 64, nb = r % 64, n0 = 32 * nb, np = n0 + (lane & 31);
                const int q = np >> 8, p = np & 255, cc = 128 * q + (p & 127) + ((p >> 7) ? 1024 : 0);
                cvt_item<1>(INP(2) + (size_t)l * 1024 * IN_COLS + C_GATE + cc, IN_COLS, INP(1) + l * 1024, (GAS bf16_t*)(lw + WS_WG + (size_t)l * 2048 * 1024), 1024, 64 * kb, n0, scr, lane, (l ? qs_in1 : qs_in0)); continue; } r -= I_WG;
            if (r < I_WQB) { cvt_nat(INP(10) + (size_t)l * 256 * 768, 768, 0, 768, INP(9) + l * 256, (GAS bf16_t*)(lw + WS_WQB) + (size_t)l * 768 * 256, 256, 768, r, scr, lane); continue; } r -= I_WQB;
            if (r < I_WKVB) {
                const int kb = r / 32, nb = r % 32, n0 = 32 * nb, np = n0 + (lane & 31);
                const int pn = np >> 8, q = np & 255, wc_ = (q >> 5) & 3; const int sc_ = 128 * (2 * pn + (wc_ & 1)) + 64 * (wc_ >> 1) + 32 * (q >> 7) + (q & 31);
                cvt_item(INP(12) + (size_t)l * 128 * 1024 + sc_, 1024, INP(11) + l * 128, (GAS bf16_t*)(lw + WS_WKVB) + (size_t)l * 1024 * 128, 128, 64 * kb, n0, scr, lane); continue; } r -= I_WKVB;
            if (r < 2 * I_WOA) {
                const int half = r >= I_WOA, r2 = r - half * I_WOA, kb = r2 / 32, nb = r2 % 32, n0 = 32 * nb;
                cvt_item<2>((half ? INP(15) : INP(8)) + (size_t)l * 512 * 1024 + pg8::col16_src(n0 + (lane & 31)), 1024, nullptr, (GAS bf16_t*)(lw + WS_WOA + (size_t)l * 1024 * 1024 + half * 512), 1024, 64 * kb, n0, scr, lane, W8S); continue; } r -= 2 * I_WOA;
            if (r < I_WO) { const int kb = r / 32, nb = r % 32, n0 = 32 * nb;
                cvt_item<2>(INP(16) + (size_t)l * 1024 * 1024 + pg8::col16_src(n0 + (lane & 31)), 1024, nullptr, (GAS bf16_t*)(lw + WS_WO + (size_t)l * 1024 * 1024), 1024, 64 * kb, n0, scr, lane, W8S); continue; } r -= I_WO;
            if (r < I_WR) {
                const int kb = r / 8, nb = r % 8, n0 = 32 * nb, np = n0 + (lane & 31);
                const GAS float* sp = nullptr; int ns = 32;
                if (np < 32) { sp = INP(20) + (size_t)l * 1024 * 32 + np; ns = 32; } else if (np < 36) { sp = INP(18) + (size_t)l * 1024 * 4 + (np - 32); ns = 4; }
                cvt_item(sp, ns, INP(17) + l * 1024, (GAS bf16_t*)(lw + WS_WR) + (size_t)l * 256 * 1024, 1024, 64 * kb, n0, scr, lane); continue; } r -= I_WR;
            if (r < I_WGU) {
                const int e = r / 256, r2 = r % 256, kb = r2 / 16, nb = r2 % 16, n0 = 32 * nb, np = n0 + (lane & 31);
                const int pn = np >> 8, q = np & 255, n = q >> 7;
                const int cc = 128 * pn + (q & 127);
                const GAS float* sp = (n ? INP(23) : INP(22)) + ((size_t)l * NEXP + e) * 1024 * 256 + cc;
                cvt_item<1>(sp, 256, INP(17) + l * 1024, (GAS bf16_t*)(lw + WS_WGU + ((size_t)l * NEXP + e) * 512 * 1024), 1024, 64 * kb, n0, scr, lane, (l ? qs_gu1 : qs_gu0)); continue; } r -= I_WGU;
            { const int e = r / 128, it2 = r % 128, kb = it2 / 32, nb = it2 % 32, n0 = 32 * nb;
              cvt_item(INP(24) + ((size_t)l * NEXP + e) * 256 * 1024 + pg8::col16_src(n0 + (lane & 31)), 1024, nullptr, (GAS bf16_t*)(lw + WS_WD) + ((size_t)l * NEXP + e) * 1024 * 256, 256, 64 * kb, n0, scr, lane); }
        }
    }
    SEAM(0);

    for (int l = 0; l < 2; ++l) {
        const int pb = 1 + NPH_LAYER * l;
        if (IN(pb + 0)) { PH_BEGIN
            pg8::Gemm g{(const GAS bf16_t*)XB8, (const GAS bf16_t*)(lw + WS_WIN1 + (size_t)l * 1280 * 1024), 512, 512, 512}; pg8::StaticOrder S; S.init(T, NPROJ1, G, bx);
            pg8::EpiProj1 E{PROJ1, SSQX, XSC, WDQ(l, 0), INP(4) + l * 64, INP(5) + l * 64, PCQ, PCKV, PKPE};
            pg8::gemm_phase<pg8::EpiProj1, pg8::StaticOrder, true>(L, g, S, E);
        }
        SEAM(pb + 0);
        if (IN(pb + 2)) { PH_BEGIN
            { pg8::Gemm g{PROJ1 + C_CQ, (const GAS bf16_t*)(lw + WS_WQB) + (size_t)l * 768 * 256, NPROJ1, 256, 256}; pg8::StaticOrder S; S.init(T, 768, G, bx);
              pg8::EpiRowNorm4 E{QB, 768, PCQ, 1.0f / 256.0f};
              pg8::gemm_phase<pg8::EpiRowNorm4, pg8::StaticOrder>(L, g, S, E); }
            { pg8::Gemm g{PROJ1 + C_CKV, (const GAS bf16_t*)(lw + WS_WKVB) + (size_t)l * 1024 * 128, NPROJ1, 128, 128}; pg8::StaticOrder S; S.init(T, 1024, G, bx);
              pg8::EpiKv E{KB, KVB, PCKV, PKPE, PROJ1, INP(14) + l * 96, ROPE};
              pg8::gemm_phase<pg8::EpiKv, pg8::StaticOrder>(L, g, S, E); }
        }
        SEAM(pb + 2);
        if (IN(pb + 4)) { PH_BEGIN
            char* shm = (char*)lds;
            float mfixB, sboundA;
            { const GAS float* gq = INP(13) + l * 96; const GAS float* gk = INP(14) + l * 96; float a = 0.f, c = 0.f;
              for (int i = lane; i < 96; i += 64) { a = __builtin_fmaxf(a, __builtin_fabsf(gq[i])); c = __builtin_fmaxf(c, __builtin_fabsf(gk[i])); }
              a = wave_max(a); c = wave_max(c); mfixB = __uint_as_float(__builtin_amdgcn_readfirstlane(__float_as_uint(__builtin_fminf(96.0f * C2B * a * c + 0.5f, 60.0f)))); }
            { const GAS float* gq = INP(4) + l * 64; const GAS float* gk = INP(5) + l * 64; const GAS float* rel = INP(7);
              float a = __builtin_fabsf(gq[lane]), c = __builtin_fabsf(gk[lane]), bm = 0.f;
              for (int i = lane; i < 256; i += 64) bm = __builtin_fmaxf(bm, __builtin_fabsf(rel[i]));
              a = wave_max(a); c = wave_max(c); bm = wave_max(bm); sboundA = __uint_as_float(__builtin_amdgcn_readfirstlane(__float_as_uint(__builtin_fminf(64.0f * C2A * a * c + bm * LOG2E + 0.5f, 60.0f)))); }
            for (int v = vcu; v < 256; v += G) {
                const int bh = v >> 1, s0 = 2 * (v & 1);
                for (int i = 0; i < 4; ++i) { const int s = s0 + (i >> 1), qb = (i & 1) ? 7 - s : s; att::mla_unit(bh >> 3, bh & 7, qb, QB, KB, KVB, OB, shm, mfixB, INP(13) + l * 96, ROPE); }
            }
            { LAS float* biasl = (LAS float*)(L + att::S_LBIAS); const GAS float* rel = INP(7);
              for (int e = tid; e < 8 * 128; e += 512) { const int hd = e >> 7, d = e & 127; int bk = d;
                  if (d >= 16) { bk = 16 + (int)(__logf((float)d * (1.0f / 16.0f)) / 2.0794415416798357f * 16.0f); bk = bk > 31 ? 31 : bk; }
                  biasl[e] = rel[bk * 8 + hd] * LOG2E; }
              __syncthreads(); }
            for (int u = vcu; u < NB * 32 * 2; u += G) { const int g2 = u & 1, n = (u >> 1) & 31, b = u >> 6; att::swa_unit(b, n, g2, PROJ1, OB, INP(6) + l * 8, shm, sboundA); }
        }
        SEAM(pb + 4);
        if (IN(pb + 5)) { PH_BEGIN
            pg8::Gemm g{(const GAS bf16_t*)XB8, (const GAS bf16_t*)(lw + WS_WG + (size_t)l * 2048 * 1024), 512, 512, 512}; pg8::StaticOrder S; S.init(T, 2048, G, bx);
            pg8::EpiGates2 E{GATES, GATES + (size_t)T * 1024, SSQX, INP(3) + l * 2048, XSC, WDQ(l, 0)};
            pg8::gemm_phase<pg8::EpiGates2, pg8::StaticOrder, true>(L, g, S, E);
        }
        SEAM(pb + 5);
        if (IN(pb + 6)) { PH_BEGIN
            pg8::Gemm g{OB, (const GAS bf16_t*)(lw + WS_WOA + (size_t)l * 1024 * 1024), 512, 512, 512}; pg8::StaticOrder S; S.init(T, 1024, G, bx);
            pg8::EpiMerge E{MB, GATES, GATES + (size_t)T * 1024};
            pg8::gemm_phase<pg8::EpiMerge, pg8::StaticOrder, false, true, true>(L, g, S, E);
        }
        SEAM(pb + 6);
        if (IN(pb + 7)) { PH_BEGIN
            pg8::Gemm g{MB, (const GAS bf16_t*)(lw + WS_WO + (size_t)l * 1024 * 1024), 512, 512, 512}; pg8::StaticOrder S; S.init(T, 1024, G, bx);
            pg8::EpiResid E{(l == 0) ? INP(0) : (const GAS float*)nullptr, XB, SSQP};
            pg8::gemm_phase<pg8::EpiResid, pg8::StaticOrder, false, false, true>(L, g, S, E);
        }
        SEAM(pb + 7);
        if (IN(pb + 9)) { PH_BEGIN
            pg8::Gemm g{XB, (const GAS bf16_t*)(lw + WS_WR) + (size_t)l * 256 * 1024, 1024, 1024, 1024}; pg8::StaticOrder S; S.init(T, 256, G, bx);
            pg8::EpiLogits E{LOGITS, SSQP};
            pg8::gemm_phase<pg8::EpiLogits, pg8::StaticOrder>(L, g, S, E);
            VM_WAIT(); __syncthreads();
            LAS int* cnt = (LAS int*)L; LAS int* basep = cnt + 32;
            const GAS float* brg = INP(19) + l * 4; const GAS float* bre = INP(21) + l * 32;
            GAS unsigned* gcnt = (GAS unsigned*)(lw + WS_CTL) + CW_CNT + 64 * l;
            pg8::Unit ru;
            LAS float* rsc = (LAS float*)(L + 4096);
            for (int iu = 0; S.next(iu, ru); ++iu) {
                if (tid < 32) cnt[tid] = 0;
                {
                    const int wv = tid >> 6;
                    for (int rr = 0; rr < 32; rr += 4) { u32x4 v0[4], v1[4]; float rsm[4];
#pragma unroll
                        for (int r = 0; r < 4; ++r) { const int t = ru.pm * 256 + wv * 32 + rr + r; const GAS u32x4* s = (const GAS u32x4*)(XB + (size_t)t * DM) + lane; v0[r] = s[0]; v1[r] = s[64];
                            const GAS f32x4* pp = (const GAS f32x4*)(SSQP + (size_t)t * 16); const f32x4 a = pp[0], b = pp[1], c = pp[2], d = pp[3];
                            rsm[r] = __builtin_amdgcn_rsqf((((a.x + a.y) + (a.z + a.w)) + ((b.x + b.y) + (b.z + b.w)) + ((c.x + c.y) + (c.z + c.w)) + ((d.x + d.y) + (d.z + d.w))) * (1.0f / 1024.0f) + EPS); }
#pragma unroll
                        for (int r = 0; r < 4; ++r) { const int t = ru.pm * 256 + wv * 32 + rr + r; const u32x4 a = v0[r], b = v1[r];
                            const float f[16] = {bflo(a.x), bfhi(a.x), bflo(a.y), bfhi(a.y), bflo(a.z), bfhi(a.z), bflo(a.w), bfhi(a.w), bflo(b.x), bfhi(b.x), bflo(b.y), bfhi(b.y), bflo(b.z), bfhi(b.z), bflo(b.w), bfhi(b.w)};
                            float mx = 0.f;
#pragma unroll
                            for (int i = 0; i < 16; ++i) mx = __builtin_fmaxf(mx, __builtin_fabsf(f[i]));
                            mx = wave_max(mx); mx = mx > 0.f ? mx : 1.f; const float qs = 127.0f / mx;
                            u32x2 q0, q1; q0.x = pk4_i8(f[0], f[1], f[2], f[3], qs); q0.y = pk4_i8(f[4], f[5], f[6], f[7], qs); q1.x = pk4_i8(f[8], f[9], f[10], f[11], qs); q1.y = pk4_i8(f[12], f[13], f[14], f[15], qs);
                            { GAS u32x2* d = (GAS u32x2*)(XM8 + (size_t)t * DM) + lane; d[0] = q0; d[64] = q1; }
                            if (lane == 0) rsc[wv * 32 + rr + r] = rsm[r] * mx * (1.0f / 127.0f); } }
                }
                __syncthreads();
                const bool act = tid < 256; const int t = ru.pm * 256 + (tid & 255); const GAS float* lg = LOGITS + (size_t)t * 64;
                float gl[4]; float gmx = -INFINITY; int gi = 0;
#pragma unroll
                for (int q = 0; q < 4; ++q) { gl[q] = lg[32 + q] + brg[q]; if (gl[q] > gmx) { gmx = gl[q]; gi = q; } }
                float gs = 0.f;
#pragma unroll
                for (int q = 0; q < 4; ++q) gs += __expf(gl[q] - gmx);
                const float gp = 1.0f / gs;
                float el[8]; float e0 = -INFINITY; int i0 = 0;
#pragma unroll
                for (int q = 0; q < 8; ++q) { el[q] = lg[8 * gi + q] + bre[8 * gi + q]; if (el[q] > e0) { e0 = el[q]; i0 = q; } }
                float e1 = -INFINITY; int i1 = 0;
#pragma unroll
                for (int q = 0; q < 8; ++q) if (q != i0 && el[q] > e1) { e1 = el[q]; i1 = q; }
                const float w1 = 1.0f / (1.0f + __expf(e0 - e1)), w0 = 1.0f - w1;
                const int ex0 = 8 * gi + i0, ex1 = 8 * gi + i1;
                int r0 = 0, r1 = 0;
                if (act) { r0 = __hip_atomic_fetch_add(&cnt[ex0], 1, __ATOMIC_RELAXED, __HIP_MEMORY_SCOPE_WORKGROUP); r1 = __hip_atomic_fetch_add(&cnt[ex1], 1, __ATOMIC_RELAXED, __HIP_MEMORY_SCOPE_WORKGROUP); }
                __syncthreads();
                if (tid < 32) basep[tid] = (int)__hip_atomic_fetch_add(gcnt + tid, (unsigned)cnt[tid], __ATOMIC_RELAXED, __HIP_MEMORY_SCOPE_AGENT);
                __syncthreads();
                if (act) { const unsigned sb = __float_as_uint(rsc[tid]);
                    *(GAS u32x4*)(TAB + (size_t)(ex0 * MOE_CAP + basep[ex0] + r0) * 4) = (u32x4){(unsigned)t, sb, (unsigned)(2 * t), __float_as_uint(gp * w0)};
                    *(GAS u32x4*)(TAB + (size_t)(ex1 * MOE_CAP + basep[ex1] + r1) * 4) = (u32x4){(unsigned)t, sb, (unsigned)(2 * t + 1), __float_as_uint(gp * w1)}; }
                __syncthreads();
            }
        }
        SEAM(pb + 10);
        if (IN(pb + 12) || IN(pb + 13)) {
            PH_BEGIN
            if (tid == 0) { const GAS unsigned* gcnt = (const GAS unsigned*)(lw + WS_CTL) + CW_CNT + 64 * l; int acc = 0;
                for (int e = 0; e < NEXP; ++e) { const int c = (int)__hip_atomic_load(gcnt + e, __ATOMIC_RELAXED, __HIP_MEMORY_SCOPE_AGENT); acc += (c + 255) >> 8; pend[e] = acc; pcnt[e] = c; } }
            __syncthreads();
        }
        if (IN(pb + 12)) { PH_BEGIN
            pg8::Gemm g{(const GAS bf16_t*)XM8, (const GAS bf16_t*)(lw + WS_WGU + (size_t)l * NEXP * 512 * 1024), 512, 512, 512};
            pg8::MoeGather S{pend[NEXP - 1] * 2, 2, G, bx, pend, (size_t)512 * 1024, TAB, pcnt};
            pg8::EpiGateUp E{ACT, (const GAS float*)TAB, pend, pcnt, WDQ(l, 1)};
            pg8::gemm_phase<pg8::EpiGateUp, pg8::MoeGather, true>(L, g, S, E);
        }
        SEAM(pb + 12);
        if (IN(pb + 13)) { PH_BEGIN
            pg8::Gemm g{ACT, (const GAS bf16_t*)(lw + WS_WD) + (size_t)l * NEXP * 1024 * 256, 256, 256, 256};
            pg8::MoeOrder S{pend[NEXP - 1] * 4, 4, G, bx, pend, (size_t)1024 * 256 * 2, TAB, pcnt};
            pg8::EpiDown E{YBUF, TAB, pend, pcnt};
            pg8::gemm_phase<pg8::EpiDown, pg8::MoeOrder>(L, g, S, E);
        }
        SEAM(pb + 13);
        if (IN(pb + 14)) { PH_BEGIN
            for (int m0 = gw * 4; m0 < T; m0 += NGW * 4) {
                u32x2 xm[4][4]; unsigned ya[4][4], yb[4][4]; f32x4 xv[4][4];
#pragma unroll
                for (int r = 0; r < 4; ++r) { const int m = m0 + r;
#pragma unroll
                    for (int j = 0; j < 4; ++j) { xm[r][j] = ((const GAS u32x2*)(XB + (size_t)m * DM) + lane)[64 * j];
                        ya[r][j] = ((const GAS unsigned*)((const GAS unsigned char*)YBUF + (size_t)(2 * m) * DM) + lane)[64 * j]; yb[r][j] = ((const GAS unsigned*)((const GAS unsigned char*)YBUF + (size_t)(2 * m + 1) * DM) + lane)[64 * j]; } }
#pragma unroll
                for (int r = 0; r < 4; ++r) { const int m = m0 + r; float s = 0.f, mx = 0.f;
#pragma unroll
                    for (int j = 0; j < 4; ++j) { const u32x2 x = xm[r][j]; const int a = (int)ya[r][j], b = (int)yb[r][j]; f32x4 v;
                        v.x = bflo(x.x) + (__builtin_amdgcn_cvt_f32_fp8(a, 0) + __builtin_amdgcn_cvt_f32_fp8(b, 0)) * Y8I; v.y = bfhi(x.x) + (__builtin_amdgcn_cvt_f32_fp8(a, 1) + __builtin_amdgcn_cvt_f32_fp8(b, 1)) * Y8I;
                        v.z = bflo(x.y) + (__builtin_amdgcn_cvt_f32_fp8(a, 2) + __builtin_amdgcn_cvt_f32_fp8(b, 2)) * Y8I; v.w = bfhi(x.y) + (__builtin_amdgcn_cvt_f32_fp8(a, 3) + __builtin_amdgcn_cvt_f32_fp8(b, 3)) * Y8I; xv[r][j] = v;
                        if (l == 1) ((GAS f32x4*)(out + (size_t)m * DM) + lane)[64 * j] = v;
                        else { u32x2 w; w.x = cvt_pk_bf16(v.x, v.y); w.y = cvt_pk_bf16(v.z, v.w); ((GAS u32x2*)(XB + (size_t)m * DM) + lane)[64 * j] = w; }
                        s += (v.x * v.x + v.y * v.y) + (v.z * v.z + v.w * v.w);
                        mx = __builtin_fmaxf(mx, __builtin_fmaxf(__builtin_fmaxf(__builtin_fabsf(v.x), __builtin_fabsf(v.y)), __builtin_fmaxf(__builtin_fabsf(v.z), __builtin_fabsf(v.w)))); }
                    if (l == 0) {
                    s = wave_sum(s); mx = wave_max(mx); mx = mx > 0.f ? mx : 1.f; const float qs = 127.0f / mx;
#pragma unroll
                    for (int j = 0; j < 4; ++j) { const f32x4 v = xv[r][j]; ((GAS unsigned*)(XB8 + (size_t)m * DM) + lane)[64 * j] = pk4_i8(v.x, v.y, v.z, v.w, qs); }
                    if (lane == 0) { SSQX[m] = s; XSC[m] = mx * (1.0f / 127.0f); } } }
            }
        }
        SEAM(pb + 14);
    }
}

extern "C" void kernel_launch(void* const* d_in, const GAS int* in_sizes, int n_in, void* d_out, int out_size, void* d_ws, size_t ws_size, hipStream_t stream) {
    static int grid = 0;
    if (grid == 0) {
        if (n_in != 25 || in_sizes[0] != T * DM || out_size != T * DM || ws_size < WS_END) { fprintf(stderr, "kernel_launch: unexpected shapes / workspace (%d inputs, ws %zu)\n", n_in, ws_size); grid = -1; return; }
        int dev = 0, cus = 0, per_cu = 0;
        if (hipGetDevice(&dev) != hipSuccess || hipDeviceGetAttribute(&cus, hipDeviceAttributeMultiprocessorCount, dev) != hipSuccess) { grid = -1; return; }
        if (hipFuncSetAttribute((const void*)fwd, hipFuncAttributeMaxDynamicSharedMemorySize, LDS_BYTES) != hipSuccess) { fprintf(stderr, "kernel_launch: hipFuncSetAttribute failed\n"); grid = -1; return; }
        if (hipOccupancyMaxActiveBlocksPerMultiprocessor(&per_cu, (const void*)fwd, 512, LDS_BYTES) != hipSuccess || per_cu < 1) fprintf(stderr, "kernel_launch: occupancy query reports %d\n", per_cu);
        (void)hipGetLastError();
        grid = cus;
    }
    if (grid < 0) return;
    if (hipMemsetAsync((char*)d_ws + WS_CTL, 0, CTL_ZERO_BYTES, stream) != hipSuccess) return;
    Args a{};
    for (int i = 0; i < 25; ++i) a.in[i] = (const GAS float*)d_in[i];
    a.out = (GAS float*)d_out; a.ws = (unsigned char*)d_ws;
#if ONE_LAUNCH
    a.ph_lo = 0; a.ph_hi = NPHASES;
    hipLaunchKernelGGL(fwd, dim3(grid), dim3(512), LDS_BYTES, stream, a);
#else
    for (int ph = 0; ph < NPHASES; ++ph) { a.ph_lo = ph; a.ph_hi = ph + 1; hipLaunchKernelGGL(fwd, dim3(grid), dim3(512), LDS_BYTES, stream, a); }
#endif
}
```

```cpp
#include <hip/hip_runtime.h>
#include <cstdio>
#include <cstdint>

#ifndef ONE_LAUNCH
#define ONE_LAUNCH 1
#endif

#define GAS __attribute__((address_space(1)))
#define LAS __attribute__((address_space(3)))
typedef unsigned short bf16_t;
typedef short bf16x8 __attribute__((ext_vector_type(8)));
typedef short s16x4 __attribute__((ext_vector_type(4)));
typedef float f32x4 __attribute__((ext_vector_type(4)));
typedef float f32x2 __attribute__((ext_vector_type(2)));
typedef float f32x16 __attribute__((ext_vector_type(16)));
typedef unsigned u32x4 __attribute__((ext_vector_type(4)));
typedef unsigned u32x2 __attribute__((ext_vector_type(2)));

constexpr int T = 65536, DM = 1024, SEQ = 4096, NB = 16;
constexpr int NPROJ1 = 1280;
constexpr int C_QA = 0, C_KA = 512, C_VA = 640, C_CQ = 768, C_CKV = 1024, C_KPE = 1152, C_GATE = 1184, IN_COLS = 3232;
constexpr int NEXP = 32, DEXP = 256;
constexpr int MOE_CAP = 65536;
constexpr float W8S = 32.0f, W8I = 1.0f / 32.0f;
constexpr int A_PAD = 2 * T + NEXP * 256;
constexpr float EPS = 1e-6f;
constexpr float LOG2E = 1.4426950408889634f;
constexpr float Y8S = 16.0f, Y8I = 1.0f / 16.0f;
constexpr float C2A = 0.125f * LOG2E;
constexpr float C2B = 0.10206207261596575f * LOG2E;

constexpr size_t MiB = 1u << 20;
constexpr size_t WS_CTL = 0, CTL_ZERO_BYTES = 2 * MiB;
constexpr size_t WS_SSQX = 2 * MiB;
constexpr size_t WS_RSMID = WS_SSQX + 256 * 1024;
constexpr size_t WS_ROPE = WS_RSMID + 256 * 1024;
constexpr size_t WS_ASE = 3 * MiB, WS_ASP = WS_ASE + 512 * 1024, WS_ASW = WS_ASP + 512 * 1024;
constexpr size_t WS_MY = WS_ASW + 512 * 1024, WS_MW = WS_MY + 768 * 1024, WS_MRS = WS_MW + 768 * 1024;
constexpr size_t WS_LOGITS = 8 * MiB;
constexpr size_t WS_WIN1 = 24 * MiB;
constexpr size_t WS_WG = 29 * MiB;
constexpr size_t WS_WQB = 37 * MiB;
constexpr size_t WS_WKVB = WS_WQB + 768 * 1024;
constexpr size_t WS_WOA = WS_WKVB + 768 * 1024;
constexpr size_t WS_WOB = WS_WOA + 2 * MiB;
constexpr size_t WS_WO = WS_WOB + 2 * MiB;
constexpr size_t WS_WR = WS_WO + 4 * MiB;
constexpr size_t WS_WGU = 48 * MiB;
constexpr size_t WS_WD = 112 * MiB;
constexpr size_t WS_XB = 144 * MiB;
constexpr size_t WS_PROJ1 = 272 * MiB;
constexpr size_t WS_QB = 432 * MiB;
constexpr size_t WS_KVB = 528 * MiB;
constexpr size_t WS_KB = 656 * MiB;
constexpr size_t WS_O = 752 * MiB;
constexpr size_t WS_GATES = 432 * MiB;
constexpr size_t WS_M = 272 * MiB;
constexpr size_t WS_XR = 272 * MiB;
constexpr size_t WS_ACT = 544 * MiB;
constexpr size_t WS_YBUF = 612 * MiB;
constexpr size_t WS_SSQP = 880 * MiB;
constexpr size_t WS_XB8 = 884 * MiB;
constexpr size_t WS_END = 948 * MiB;
static_assert(WS_MRS + 768 * 1024 <= WS_LOGITS && WS_LOGITS + (size_t)T * 64 * 4 <= WS_WIN1, "ws map");
static_assert(WS_WR + 1 * MiB <= WS_WGU && WS_WD + 32 * MiB <= WS_XB, "ws map");
static_assert(WS_XR + (size_t)A_PAD * 1024 * 2 <= WS_ACT && WS_ACT + (size_t)A_PAD * 256 * 2 <= WS_YBUF && WS_YBUF + (size_t)2 * T * 1024 * 2 <= WS_END, "ws map");

constexpr int CW_BAR = 4096;
constexpr int CW_WMAX = 20480;
constexpr int CW_CNT = 16384;

constexpr int RING_BYTES = 131072;
constexpr int MISC_OFF = RING_BYTES;
constexpr int LDS_BYTES = 147456;

#define LDS_WAIT() asm volatile("s_waitcnt lgkmcnt(0)" ::: "memory")
#define VM_WAIT() asm volatile("s_waitcnt vmcnt(0)" ::: "memory")

typedef float f32x2_cv __attribute__((ext_vector_type(2))); typedef __bf16 bf16x2_cv __attribute__((ext_vector_type(2)));
__device__ __forceinline__ unsigned cvt_pk_bf16(float lo, float hi) { const f32x2_cv v = {lo, hi}; const bf16x2_cv b = __builtin_convertvector(v, bf16x2_cv); return __builtin_bit_cast(unsigned, b); }
__device__ __forceinline__ unsigned pk4_i8(float a, float b, float c, float d, float s) {
    int q0 = (int)__builtin_rintf(a * s), q1 = (int)__builtin_rintf(b * s), q2 = (int)__builtin_rintf(c * s), q3 = (int)__builtin_rintf(d * s);
    q0 = q0 < -127 ? -127 : (q0 > 127 ? 127 : q0); q1 = q1 < -127 ? -127 : (q1 > 127 ? 127 : q1); q2 = q2 < -127 ? -127 : (q2 > 127 ? 127 : q2); q3 = q3 < -127 ? -127 : (q3 > 127 ? 127 : q3);
    return (unsigned)(q0 & 255) | ((unsigned)(q1 & 255) << 8) | ((unsigned)(q2 & 255) << 16) | ((unsigned)q3 << 24); }
__device__ __forceinline__ float wave_max(float v) {
#pragma unroll
    for (int o = 1; o < 64; o <<= 1) v = __builtin_fmaxf(v, __shfl_xor(v, o));
    return v;
}
__device__ __forceinline__ unsigned pk4_fp8(float a, float b, float c, float d) { int p = __builtin_amdgcn_cvt_pk_fp8_f32(a, b, 0, false); p = __builtin_amdgcn_cvt_pk_fp8_f32(c, d, p, true); return (unsigned)p; }
__device__ __forceinline__ float bflo(unsigned u) { return __uint_as_float(u << 16); }
__device__ __forceinline__ float bfhi(unsigned u) { return __uint_as_float(u & 0xffff0000u); }
__device__ __forceinline__ float bf1(bf16_t h) { return __uint_as_float((unsigned)h << 16); }
__device__ __forceinline__ float wave_sum(float v) {
#pragma unroll
    for (int o = 1; o < 64; o <<= 1) v += __shfl_xor(v, o);
    return v;
}
__device__ __forceinline__ float fsigmoid(float v) { return __builtin_amdgcn_rcpf(1.0f + __builtin_amdgcn_exp2f(-v * LOG2E)); }

namespace pg8 {
constexpr int BM = 256, BK = 64, HALF = 128, HTB = HALF * BK * 2, STAGE_BYTES = 8 * HTB, NXCD = 8, WGM = 8;
__host__ __device__ __forceinline__ int lds_byte(int r, int c) { const int st = (r >> 4) * 2 + (c >> 5), rr = r & 15, cc = c & 31, ob = rr * 64 + cc * 2; return st * 1024 + (ob ^ (((ob >> 9) & 1) << 5)); }
__host__ __device__ __forceinline__ void stage_rc(int b, int& R, int& C) { const int st = b / 1024, sb = b % 1024, swz = sb ^ (((sb >> 9) & 1) << 5); R = (st >> 1) * 16 + swz / 64; C = (st & 1) * 32 + (swz % 64) / 2; }
__host__ __device__ __forceinline__ int perm32(int rho) { const int n = rho >> 4, i = rho & 15; return 8 * (i >> 2) + 4 * n + (i & 3); }

struct Unit { int pm, pn; };
struct Gemm { const GAS bf16_t* A; const GAS bf16_t* Bt; int lda, ldb, K; };

struct StaticOrder {
    static constexpr bool GATHER = false;
    int nM, nN, nwg, G, c;
    __device__ void init(int M, int N, int G_, int c_) { nM = M / BM; nN = N / BM; nwg = nM * nN; G = G_; c = c_; }
    __device__ __forceinline__ bool next(int i, Unit& u) const {
        const long L = (long)i * G + c; if (L >= nwg) return false;
        int wgid = (int)L; { const int q = nwg / NXCD, r = nwg % NXCD, xcd = wgid % NXCD, off = wgid / NXCD; wgid = (xcd < r ? xcd * (q + 1) : r * (q + 1) + (xcd - r) * q) + off; }
        const int nig = WGM * nN, gid = wgid / nig, fm = gid * WGM, gsz = (nM - fm) < WGM ? (nM - fm) : WGM;
        u.pm = fm + ((wgid % nig) % gsz); u.pn = (wgid % nig) / gsz; return true;
    }
    __device__ __forceinline__ size_t aoff(const Gemm& g, const Unit& u) const { return (size_t)u.pm * BM * g.lda * 2; }
    __device__ __forceinline__ size_t boff(const Gemm& g, const Unit& u) const { return (size_t)u.pn * BM * g.ldb * 2; }
};
template <bool GA> struct MoeOrderT {
    static constexpr bool GATHER = GA;
    int nunits, npn, G, c; const LAS int* pend; size_t estride; const GAS int* tab; const LAS int* pcnt;
    __device__ bool next(int i, Unit& u) const { const long L = (long)i * G + c; if (L >= nunits) return false; u.pm = (int)(L / npn); u.pn = (int)(L % npn); return true; }
    __device__ __forceinline__ int expert(int pm) const { int e = 0; while (e < NEXP - 1 && pend[e] <= pm) ++e; return e; }
    __device__ __forceinline__ size_t aoff(const Gemm& g, const Unit& u) const { return (size_t)u.pm * BM * g.lda * 2; }
    __device__ __forceinline__ size_t boff(const Gemm& g, const Unit& u) const { return (size_t)expert(u.pm) * estride + (size_t)u.pn * BM * g.ldb * 2; }
    __device__ __forceinline__ void gather(const Gemm& g, const Unit& u, int tid, unsigned (&o)[2][2]) const {
        const int e = expert(u.pm), lp = u.pm - (e ? pend[e - 1] : 0), cnt = pcnt[e];
#pragma unroll
        for (int i = 0; i < 2; ++i) { int R, C; stage_rc(tid * 16 + i * 8192, R, C);
#pragma unroll
            for (int h = 0; h < 2; ++h) { const int pos = lp * 256 + h * HALF + R; int tok = 0; if (pos < cnt) tok = tab[(size_t)(e * MOE_CAP + pos) * 4];
                o[h][i] = (unsigned)tok * (unsigned)(g.lda * 2) + (unsigned)C * 2u; } }
    }
};
typedef MoeOrderT<false> MoeOrder; typedef MoeOrderT<true> MoeGather;

#define EPI_ROW(ai, m) (u.pm * 256 + (ai) * 128 + wr * 64 + (m) * 16 + fr)
#define EPI_COL(bj) (u.pn * 256 + (bj) * 128 + wc * 32 + 8 * fq)
#define EPI_COL16 (u.pn * 256 + wc * 64 + 16 * fq)
__device__ __forceinline__ int col16_src(int np) { const int j = np & 255; return (np & ~255) + 64 * ((j >> 5) & 3) + 16 * ((j >> 3) & 3) + 8 * (j >> 7) + (j & 7); }

template <bool SCALED> struct EpiScaleBf16T {
    static constexpr bool PERM = true;
    GAS bf16_t* O; int ldc; const GAS float* ssq; float invn; const GAS float* rowmul; float wsc;
    __device__ __forceinline__ void operator()(const f32x4 (&acc)[2][2][4][2], const Unit& u, int wr, int wc, int fr, int fq) const {
        float sc[2][4];
        if constexpr (SCALED) { float a[2][4], r[2][4];
#pragma unroll
            for (int ai = 0; ai < 2; ++ai)
#pragma unroll
                for (int m = 0; m < 4; ++m) { const int row = EPI_ROW(ai, m); a[ai][m] = ssq[row]; r[ai][m] = rowmul[row]; }
#pragma unroll
            for (int ai = 0; ai < 2; ++ai)
#pragma unroll
                for (int m = 0; m < 4; ++m) sc[ai][m] = __builtin_amdgcn_rsqf(a[ai][m] * invn + EPS) * r[ai][m] * wsc;
        }
#pragma unroll
        for (int ai = 0; ai < 2; ++ai)
#pragma unroll
            for (int m = 0; m < 4; ++m) { const int row = EPI_ROW(ai, m); const float s = SCALED ? sc[ai][m] : 1.0f;
#pragma unroll
                for (int bj = 0; bj < 2; ++bj) { const f32x4 v0 = acc[ai][bj][m][0] * s, v1 = acc[ai][bj][m][1] * s;
                    u32x4 w; w.x = cvt_pk_bf16(v0[0], v0[1]); w.y = cvt_pk_bf16(v0[2], v0[3]); w.z = cvt_pk_bf16(v1[0], v1[1]); w.w = cvt_pk_bf16(v1[2], v1[3]);
                    *(GAS u32x4*)(O + (size_t)row * ldc + EPI_COL(bj)) = w; } }
    }
};
typedef EpiScaleBf16T<true> EpiScaleBf16; typedef EpiScaleBf16T<false> EpiPlainBf16;
struct EpiProj1 {
    static constexpr bool PERM = true;
    GAS bf16_t* P; const GAS float* ssq; const GAS float* xsc; float wsc; const GAS float* gq; const GAS float* gk; GAS float* pcq; GAS float* pckv; GAS float* pkpe;
    __device__ __forceinline__ void operator()(const f32x4 (&acc)[2][2][4][2], const Unit& u, int wr, int wc, int fr, int fq) const {
        float sc[2][4];
        { float a[2][4], r[2][4];
#pragma unroll
          for (int ai = 0; ai < 2; ++ai)
#pragma unroll
              for (int m = 0; m < 4; ++m) { const int row = EPI_ROW(ai, m); a[ai][m] = ssq[row]; r[ai][m] = xsc[row]; }
#pragma unroll
          for (int ai = 0; ai < 2; ++ai)
#pragma unroll
              for (int m = 0; m < 4; ++m) sc[ai][m] = __builtin_amdgcn_rsqf(a[ai][m] * (1.0f / 1024.0f) + EPS) * r[ai][m] * wsc; }
        if (u.pn < 3) {
            const int head8 = 4 * u.pn + wc; const bool norm = head8 < 10;
            f32x4 g[2][2];
            if (norm) { const GAS float* gp = (head8 < 8 ? gq : gk) + 8 * fq; const float gs = head8 < 8 ? C2A : 1.0f;
#pragma unroll
                for (int bj = 0; bj < 2; ++bj)
#pragma unroll
                    for (int n = 0; n < 2; ++n) g[bj][n] = *(const GAS f32x4*)(gp + 32 * bj + 4 * n) * gs; }
#pragma unroll
            for (int ai = 0; ai < 2; ++ai)
#pragma unroll
                for (int m = 0; m < 4; ++m) { const int row = EPI_ROW(ai, m); f32x4 v[2][2];
#pragma unroll
                    for (int bj = 0; bj < 2; ++bj)
#pragma unroll
                        for (int n = 0; n < 2; ++n) v[bj][n] = acc[ai][bj][m][n] * sc[ai][m];
                    if (norm) { float s = 0.f;
#pragma unroll
                        for (int bj = 0; bj < 2; ++bj)
#pragma unroll
                            for (int n = 0; n < 2; ++n) s += (v[bj][n][0] * v[bj][n][0] + v[bj][n][1] * v[bj][n][1]) + (v[bj][n][2] * v[bj][n][2] + v[bj][n][3] * v[bj][n][3]);
                        s += __shfl_xor(s, 16); s += __shfl_xor(s, 32);
                        const float rs = __builtin_amdgcn_rsqf(s * (1.0f / 64.0f) + EPS);
#pragma unroll
                        for (int bj = 0; bj < 2; ++bj)
#pragma unroll
                            for (int n = 0; n < 2; ++n) v[bj][n] = v[bj][n] * rs * g[bj][n]; }
#pragma unroll
                    for (int bj = 0; bj < 2; ++bj) { u32x4 w; w.x = cvt_pk_bf16(v[bj][0][0], v[bj][0][1]); w.y = cvt_pk_bf16(v[bj][0][2], v[bj][0][3]); w.z = cvt_pk_bf16(v[bj][1][0], v[bj][1][1]); w.w = cvt_pk_bf16(v[bj][1][2], v[bj][1][3]);
                        *(GAS u32x4*)(P + (size_t)row * NPROJ1 + 64 * head8 + 32 * bj + 8 * fq) = w; } }
        } else {
#pragma unroll
            for (int ai = 0; ai < 2; ++ai)
#pragma unroll
                for (int m = 0; m < 4; ++m) { const int row = EPI_ROW(ai, m); float s0 = 0.f, s1 = 0.f;
#pragma unroll
                    for (int bj = 0; bj < 2; ++bj) { const f32x4 v0 = acc[ai][bj][m][0] * sc[ai][m], v1 = acc[ai][bj][m][1] * sc[ai][m];
                        const float q = (v0[0] * v0[0] + v0[1] * v0[1]) + (v0[2] * v0[2] + v0[3] * v0[3]) + (v1[0] * v1[0] + v1[1] * v1[1]) + (v1[2] * v1[2] + v1[3] * v1[3]);
                        if (bj == 0) s0 = q; else s1 = q;
                        u32x4 w; w.x = cvt_pk_bf16(v0[0], v0[1]); w.y = cvt_pk_bf16(v0[2], v0[3]); w.z = cvt_pk_bf16(v1[0], v1[1]); w.w = cvt_pk_bf16(v1[2], v1[3]);
                        *(GAS u32x4*)(P + (size_t)row * NPROJ1 + EPI_COL(bj)) = w; }
                    float s = (u.pn == 3) ? s0 + s1 : s0;
                    s += __shfl_xor(s, 16); s += __shfl_xor(s, 32);
                    if (fq == 0) ((u.pn == 3) ? pcq : pckv)[(size_t)row * 4 + wc] = s;
                    if (u.pn == 4 && wc == 0) { float t = s1; t += __shfl_xor(t, 16); t += __shfl_xor(t, 32); if (fq == 0) pkpe[row] = t; } }
        }
    }
};
struct EpiRowNorm4 {
    static constexpr bool PERM = true;
    GAS unsigned char* O; int ldc; const GAS float* part; float invn;
    __device__ __forceinline__ void operator()(const f32x4 (&acc)[2][2][4][2], const Unit& u, int wr, int wc, int fr, int fq) const {
        f32x4 p[2][4];
#pragma unroll
        for (int ai = 0; ai < 2; ++ai)
#pragma unroll
            for (int m = 0; m < 4; ++m) p[ai][m] = *(const GAS f32x4*)(part + (size_t)EPI_ROW(ai, m) * 4);
#pragma unroll
        for (int ai = 0; ai < 2; ++ai)
#pragma unroll
            for (int m = 0; m < 4; ++m) { const int row = EPI_ROW(ai, m); const float s = __builtin_amdgcn_rsqf(((p[ai][m].x + p[ai][m].y) + (p[ai][m].z + p[ai][m].w)) * invn + EPS);
                const f32x4 a0 = acc[ai][0][m][0] * s, a1 = acc[ai][0][m][1] * s, b0 = acc[ai][1][m][0] * s, b1 = acc[ai][1][m][1] * s;
                u32x4 w; w.x = pk4_fp8(a0[0], a0[1], a0[2], a0[3]); w.y = pk4_fp8(a1[0], a1[1], a1[2], a1[3]); w.z = pk4_fp8(b0[0], b0[1], b0[2], b0[3]); w.w = pk4_fp8(b1[0], b1[1], b1[2], b1[3]);
                *(GAS u32x4*)(O + (size_t)row * ldc + EPI_COL16) = w; }
    }
};
struct EpiGates {
    static constexpr bool PERM = true;
    GAS bf16_t* O; const GAS float* ssq; const GAS float* bias; const GAS float* rowmul; float wsc;
    __device__ __forceinline__ void operator()(const f32x4 (&acc)[2][2][4][2], const Unit& u, int wr, int wc, int fr, int fq) const {
        f32x4 bv[2][2]; float a[2][4], r[2][4], sc[2][4];
#pragma unroll
        for (int bj = 0; bj < 2; ++bj)
#pragma unroll
            for (int n = 0; n < 2; ++n) bv[bj][n] = *(const GAS f32x4*)(bias + EPI_COL(bj) + 4 * n);
#pragma unroll
        for (int ai = 0; ai < 2; ++ai)
#pragma unroll
            for (int m = 0; m < 4; ++m) { const int row = EPI_ROW(ai, m); a[ai][m] = ssq[row]; r[ai][m] = rowmul[row]; }
#pragma unroll
        for (int ai = 0; ai < 2; ++ai)
#pragma unroll
            for (int m = 0; m < 4; ++m) sc[ai][m] = __builtin_amdgcn_rsqf(a[ai][m] * (1.0f / 1024.0f) + EPS) * r[ai][m] * wsc;
#pragma unroll
        for (int ai = 0; ai < 2; ++ai)
#pragma unroll
            for (int m = 0; m < 4; ++m) { const int row = EPI_ROW(ai, m); const float s = sc[ai][m];
#pragma unroll
                for (int bj = 0; bj < 2; ++bj) { f32x4 v0 = acc[ai][bj][m][0] * s + bv[bj][0], v1 = acc[ai][bj][m][1] * s + bv[bj][1];
#pragma unroll
                    for (int i = 0; i < 4; ++i) { v0[i] = fsigmoid(v0[i]); v1[i] = fsigmoid(v1[i]); }
                    u32x4 w; w.x = cvt_pk_bf16(v0[0], v0[1]); w.y = cvt_pk_bf16(v0[2], v0[3]); w.z = cvt_pk_bf16(v1[0], v1[1]); w.w = cvt_pk_bf16(v1[2], v1[3]);
                    *(GAS u32x4*)(O + (size_t)row * 2048 + EPI_COL(bj)) = w; } }
    }
};
struct EpiKv {
    static constexpr bool PERM = true;
    GAS bf16_t* KBo; GAS bf16_t* Vo; const GAS float* pckv; const GAS float* pkpe; const GAS bf16_t* P; const GAS float* gbk; const GAS float* rope;
    __device__ __forceinline__ void operator()(const f32x4 (&acc)[2][2][4][2], const Unit& u, int wr, int wc, int fr, int fq) const {
        asm volatile("" : "+v"(fr), "+v"(fq));
        float rc[2][4];
        { f32x4 p[2][4];
#pragma unroll
          for (int ai = 0; ai < 2; ++ai)
#pragma unroll
              for (int m = 0; m < 4; ++m) p[ai][m] = *(const GAS f32x4*)(pckv + (unsigned)(EPI_ROW(ai, m) * 4));
#pragma unroll
          for (int ai = 0; ai < 2; ++ai)
#pragma unroll
              for (int m = 0; m < 4; ++m) rc[ai][m] = __builtin_amdgcn_rsqf(((p[ai][m].x + p[ai][m].y) + (p[ai][m].z + p[ai][m].w)) * (1.0f / 128.0f) + EPS); }
        const int head = 2 * u.pn + (wc & 1);
        if (wc >= 2) {
#pragma unroll
            for (int ai = 0; ai < 2; ++ai)
#pragma unroll
                for (int m = 0; m < 4; ++m) { const int row = EPI_ROW(ai, m);
#pragma unroll
                    for (int bj = 0; bj < 2; ++bj) { const f32x4 v0 = acc[ai][bj][m][0] * rc[ai][m], v1 = acc[ai][bj][m][1] * rc[ai][m];
                        u32x4 w; w.x = cvt_pk_bf16(v0[0], v0[1]); w.y = cvt_pk_bf16(v0[2], v0[3]); w.z = cvt_pk_bf16(v1[0], v1[1]); w.w = cvt_pk_bf16(v1[2], v1[3]);
                        *(GAS u32x4*)(Vo + (unsigned)(row * 1024 + 128 * head + 64 + 32 * bj + 8 * fq)) = w; } }
        } else {
            float rsh[2][4];
            {
                float sk[2][4];
#pragma unroll
                for (int ai = 0; ai < 2; ++ai)
#pragma unroll
                    for (int m = 0; m < 4; ++m) sk[ai][m] = pkpe[(unsigned)EPI_ROW(ai, m)];
                f32x4 g[2][2];
#pragma unroll
                for (int bj = 0; bj < 2; ++bj)
#pragma unroll
                    for (int n = 0; n < 2; ++n) g[bj][n] = *(const GAS f32x4*)(gbk + (unsigned)(32 * bj + 8 * fq + 4 * n));
#pragma unroll
                for (int ai = 0; ai < 2; ++ai)
#pragma unroll
                    for (int m = 0; m < 4; ++m) { const int row = EPI_ROW(ai, m); f32x4 v[2][2]; float s = 0.f;
#pragma unroll
                        for (int bj = 0; bj < 2; ++bj)
#pragma unroll
                            for (int n = 0; n < 2; ++n) { v[bj][n] = acc[ai][bj][m][n] * rc[ai][m]; s += (v[bj][n][0] * v[bj][n][0] + v[bj][n][1] * v[bj][n][1]) + (v[bj][n][2] * v[bj][n][2] + v[bj][n][3] * v[bj][n][3]); }
                        s += __shfl_xor(s, 16); s += __shfl_xor(s, 32);
                        const float rs = __builtin_amdgcn_rsqf((s + sk[ai][m]) * (1.0f / 96.0f) + EPS); rsh[ai][m] = rs;
                        const unsigned dof = (unsigned)((((row >> 12) * 8 + head) * 64 + ((row & (SEQ - 1)) >> 6)) * 12 * 512 + (row & 63) * 8);
#pragma unroll
                        for (int bj = 0; bj < 2; ++bj) { const f32x4 a0 = v[bj][0] * rs * g[bj][0], a1 = v[bj][1] * rs * g[bj][1];
                            u32x4 w; w.x = cvt_pk_bf16(a0[0], a0[1]); w.y = cvt_pk_bf16(a0[2], a0[3]); w.z = cvt_pk_bf16(a1[0], a1[1]); w.w = cvt_pk_bf16(a1[2], a1[3]);
                            *(GAS u32x4*)(KBo + (dof + (4 * bj + fq) * 512)) = w; }
                        }
            }
            asm volatile("" : "+v"(fq), "+v"(fr) :: "memory");
            {
                const f32x4 gr0 = *(const GAS f32x4*)(gbk + (unsigned)(64 + 4 * fq)), gr1 = *(const GAS f32x4*)(gbk + (unsigned)(80 + 4 * fq));
#pragma unroll
                for (int ai = 0; ai < 2; ++ai) { u32x2 kp0[4], kp1[4]; f32x4 cs[4], sn[4];
#pragma unroll
                    for (int m = 0; m < 4; ++m) { const int row = EPI_ROW(ai, m);
                        const unsigned pof = (unsigned)(row * NPROJ1 + C_KPE + 4 * fq); kp0[m] = *(const GAS u32x2*)(P + pof); kp1[m] = *(const GAS u32x2*)(P + (pof + 16));
                        const unsigned rof = (unsigned)((row & (SEQ - 1)) * 32 + 4 * fq); cs[m] = *(const GAS f32x4*)(rope + rof); sn[m] = *(const GAS f32x4*)(rope + (rof + 16)); }
#pragma unroll
                    for (int m = 0; m < 4; ++m) { const int row = EPI_ROW(ai, m); const float rs = rsh[ai][m]; const unsigned dof = (unsigned)((((row >> 12) * 8 + head) * 64 + ((row & (SEQ - 1)) >> 6)) * 12 * 512 + (row & 63) * 8);
                        const f32x4 x1 = (f32x4){bflo(kp0[m].x), bfhi(kp0[m].x), bflo(kp0[m].y), bfhi(kp0[m].y)} * rs * gr0, x2 = (f32x4){bflo(kp1[m].x), bfhi(kp1[m].x), bflo(kp1[m].y), bfhi(kp1[m].y)} * rs * gr1;
                        const f32x4 o1 = x1 * cs[m] - x2 * sn[m], o2 = x1 * sn[m] + x2 * cs[m];
                        u32x2 w1, w2; w1.x = cvt_pk_bf16(o1[0], o1[1]); w1.y = cvt_pk_bf16(o1[2], o1[3]); w2.x = cvt_pk_bf16(o2[0], o2[1]); w2.y = cvt_pk_bf16(o2[2], o2[3]);
                        *(GAS u32x2*)(KBo + (dof + (8 + (fq >> 1)) * 512 + 4 * (fq & 1))) = w1; *(GAS u32x2*)(KBo + (dof + (10 + (fq >> 1)) * 512 + 4 * (fq & 1))) = w2; }
                    asm volatile("" ::: "memory"); }
            }
        }
    }
};
struct EpiGates2 {
    static constexpr bool PERM = true;
    GAS bf16_t* GR; GAS bf16_t* GBo; const GAS float* ssq; const GAS float* bias; const GAS float* rowmul; float wsc;
    __device__ __forceinline__ void operator()(const f32x4 (&acc)[2][2][4][2], const Unit& u, int wr, int wc, int fr, int fq) const {
        f32x4 ba[2], bb[2]; float a[2][4], r[2][4], sc[2][4];
        const int c0 = u.pn * 128 + wc * 32 + 8 * fq;
#pragma unroll
        for (int n = 0; n < 2; ++n) { ba[n] = *(const GAS f32x4*)(bias + c0 + 4 * n) * (-LOG2E); bb[n] = *(const GAS f32x4*)(bias + 1024 + c0 + 4 * n) * (-LOG2E); }
#pragma unroll
        for (int ai = 0; ai < 2; ++ai)
#pragma unroll
            for (int m = 0; m < 4; ++m) { const int row = EPI_ROW(ai, m); a[ai][m] = ssq[row]; r[ai][m] = rowmul[row]; }
#pragma unroll
        for (int ai = 0; ai < 2; ++ai)
#pragma unroll
            for (int m = 0; m < 4; ++m) sc[ai][m] = __builtin_amdgcn_rsqf(a[ai][m] * (1.0f / 1024.0f) + EPS) * r[ai][m] * (wsc * -LOG2E);
#pragma unroll
        for (int ai = 0; ai < 2; ++ai)
#pragma unroll
            for (int m = 0; m < 4; ++m) { const int row = EPI_ROW(ai, m); const float s = sc[ai][m]; f32x4 rr[2], gb[2];
#pragma unroll
                for (int n = 0; n < 2; ++n) { const f32x4 la = acc[ai][0][m][n] * s + ba[n], lb = acc[ai][1][m][n] * s + bb[n];
#pragma unroll
                    for (int i = 0; i < 4; ++i) { const float ea = __builtin_amdgcn_exp2f(la[i]), eb = __builtin_amdgcn_exp2f(lb[i]);
                        gb[n][i] = __builtin_amdgcn_rcpf(1.0f + eb); rr[n][i] = (1.0f + eb) * __builtin_amdgcn_rcpf(1.0f + ea); } }
                const size_t off = (size_t)row * 1024 + c0;
                u32x4 w; w.x = cvt_pk_bf16(rr[0][0], rr[0][1]); w.y = cvt_pk_bf16(rr[0][2], rr[0][3]); w.z = cvt_pk_bf16(rr[1][0], rr[1][1]); w.w = cvt_pk_bf16(rr[1][2], rr[1][3]); *(GAS u32x4*)(GR + off) = w;
                w.x = cvt_pk_bf16(gb[0][0], gb[0][1]); w.y = cvt_pk_bf16(gb[0][2], gb[0][3]); w.z = cvt_pk_bf16(gb[1][0], gb[1][1]); w.w = cvt_pk_bf16(gb[1][2], gb[1][3]); *(GAS u32x4*)(GBo + off) = w; }
    }
};
struct EpiMerge {
    static constexpr bool PERM = true; static constexpr bool HAS_MID = true;
    GAS bf16_t* Mo; const GAS bf16_t* GR; const GAS bf16_t* GBi;
    template <bool FIN> __device__ __forceinline__ void apply(f32x4 (&acc)[2][2][4][2], const Unit& u, int wr, int wc, int fr, int fq) const {
        const GAS bf16_t* G_ = FIN ? GBi : GR;
        u32x4 gv[2][4][2];
#pragma unroll
        for (int ai = 0; ai < 2; ++ai)
#pragma unroll
            for (int m = 0; m < 4; ++m)
#pragma unroll
                for (int bj = 0; bj < 2; ++bj) gv[ai][m][bj] = *(const GAS u32x4*)(G_ + (size_t)EPI_ROW(ai, m) * 1024 + EPI_COL16 + 8 * bj);
#pragma unroll
        for (int ai = 0; ai < 2; ++ai) {
#pragma unroll
            for (int m = 0; m < 4; ++m) { u32x4 w;
#pragma unroll
                for (int bj = 0; bj < 2; ++bj) { const u32x4 g = gv[ai][m][bj]; f32x4 v0 = acc[ai][bj][m][0], v1 = acc[ai][bj][m][1];
                    v0[0] *= bflo(g.x); v0[1] *= bfhi(g.x); v0[2] *= bflo(g.y); v0[3] *= bfhi(g.y); v1[0] *= bflo(g.z); v1[1] *= bfhi(g.z); v1[2] *= bflo(g.w); v1[3] *= bfhi(g.w);
                    if constexpr (FIN) { v0 = v0 * W8I; v1 = v1 * W8I; const unsigned lo_ = pk4_fp8(v0[0], v0[1], v0[2], v0[3]), hi_ = pk4_fp8(v1[0], v1[1], v1[2], v1[3]);
                        if (bj == 0) { w.x = lo_; w.y = hi_; } else { w.z = lo_; w.w = hi_; } }
                    else { acc[ai][bj][m][0] = v0; acc[ai][bj][m][1] = v1; } }
                if constexpr (FIN) *(GAS u32x4*)((GAS unsigned char*)Mo + (size_t)EPI_ROW(ai, m) * 1024 + EPI_COL16) = w; }
            asm volatile("" ::: "memory"); }
    }
    __device__ __forceinline__ void mid(f32x4 (&acc)[2][2][4][2], const Unit& u, int wr, int wc, int fr, int fq) const { apply<false>(acc, u, wr, wc, fr, fq); }
    __device__ __forceinline__ void operator()(f32x4 (&acc)[2][2][4][2], const Unit& u, int wr, int wc, int fr, int fq) const { apply<true>(acc, u, wr, wc, fr, fq); }
};
template <bool ACCUM> struct EpiGateMul {
    static constexpr bool PERM = true;
    GAS bf16_t* Mo; const GAS bf16_t* gates; int goff;
    __device__ __forceinline__ void operator()(const f32x4 (&acc)[2][2][4][2], const Unit& u, int wr, int wc, int fr, int fq) const {
#pragma unroll
        for (int ai = 0; ai < 2; ++ai) { u32x4 gv[4][2], pv[4][2];
#pragma unroll
            for (int m = 0; m < 4; ++m) { const int row = EPI_ROW(ai, m);
#pragma unroll
                for (int bj = 0; bj < 2; ++bj) { const int col = EPI_COL(bj); gv[m][bj] = *(const GAS u32x4*)(gates + (size_t)row * 2048 + goff + col);
                    if (ACCUM) pv[m][bj] = *(const GAS u32x4*)(Mo + (size_t)row * 1024 + col); } }
#pragma unroll
            for (int m = 0; m < 4; ++m) { const int row = EPI_ROW(ai, m);
#pragma unroll
                for (int bj = 0; bj < 2; ++bj) { const int col = EPI_COL(bj); const u32x4 g = gv[m][bj];
                    f32x4 v0 = acc[ai][bj][m][0], v1 = acc[ai][bj][m][1];
                    v0[0] *= bflo(g.x); v0[1] *= bfhi(g.x); v0[2] *= bflo(g.y); v0[3] *= bfhi(g.y);
                    v1[0] *= bflo(g.z); v1[1] *= bfhi(g.z); v1[2] *= bflo(g.w); v1[3] *= bfhi(g.w);
                    if (ACCUM) { const u32x4 p = pv[m][bj];
                        v0[0] += bflo(p.x); v0[1] += bfhi(p.x); v0[2] += bflo(p.y); v0[3] += bfhi(p.y);
                        v1[0] += bflo(p.z); v1[1] += bfhi(p.z); v1[2] += bflo(p.w); v1[3] += bfhi(p.w); }
                    u32x4 w; w.x = cvt_pk_bf16(v0[0], v0[1]); w.y = cvt_pk_bf16(v0[2], v0[3]); w.z = cvt_pk_bf16(v1[0], v1[1]); w.w = cvt_pk_bf16(v1[2], v1[3]);
                    *(GAS u32x4*)(Mo + (size_t)row * 1024 + col) = w; } }
            asm volatile("" ::: "memory"); }
    }
};
struct EpiResid {
    static constexpr bool PERM = true;
    const GAS float* xres; GAS bf16_t* xb; GAS float* ssq;
    __device__ __forceinline__ void operator()(const f32x4 (&acc)[2][2][4][2], const Unit& u, int wr, int wc, int fr, int fq) const {
#pragma unroll
        for (int ai = 0; ai < 2; ++ai) { f32x4 pre[4][2][2];
            if (xres) {
#pragma unroll
                for (int m = 0; m < 4; ++m) { const int row = EPI_ROW(ai, m);
#pragma unroll
                    for (int bj = 0; bj < 2; ++bj) { const size_t off = (size_t)row * 1024 + EPI_COL16 + 8 * bj; pre[m][bj][0] = *(const GAS f32x4*)(xres + off); pre[m][bj][1] = *(const GAS f32x4*)(xres + off + 4); } }
            } else {
                u32x4 pb[4][2];
#pragma unroll
                for (int m = 0; m < 4; ++m) { const int row = EPI_ROW(ai, m);
#pragma unroll
                    for (int bj = 0; bj < 2; ++bj) pb[m][bj] = *(const GAS u32x4*)(xb + (size_t)row * 1024 + EPI_COL16 + 8 * bj); }
#pragma unroll
                for (int m = 0; m < 4; ++m)
#pragma unroll
                    for (int bj = 0; bj < 2; ++bj) { const u32x4 p = pb[m][bj]; pre[m][bj][0] = (f32x4){bflo(p.x), bfhi(p.x), bflo(p.y), bfhi(p.y)}; pre[m][bj][1] = (f32x4){bflo(p.z), bfhi(p.z), bflo(p.w), bfhi(p.w)}; }
            }
#pragma unroll
            for (int m = 0; m < 4; ++m) { const int row = EPI_ROW(ai, m); float s = 0.f;
#pragma unroll
                for (int bj = 0; bj < 2; ++bj) { const size_t off = (size_t)row * 1024 + EPI_COL16 + 8 * bj;
                    const f32x4 v0 = acc[ai][bj][m][0] * W8I + pre[m][bj][0], v1 = acc[ai][bj][m][1] * W8I + pre[m][bj][1];
                    s += (v0[0] * v0[0] + v0[1] * v0[1]) + (v0[2] * v0[2] + v0[3] * v0[3]) + (v1[0] * v1[0] + v1[1] * v1[1]) + (v1[2] * v1[2] + v1[3] * v1[3]);
                    u32x4 w; w.x = cvt_pk_bf16(v0[0], v0[1]); w.y = cvt_pk_bf16(v0[2], v0[3]); w.z = cvt_pk_bf16(v1[0], v1[1]); w.w = cvt_pk_bf16(v1[2], v1[3]);
                    *(GAS u32x4*)(xb + off) = w; }
                s += __shfl_xor(s, 16); s += __shfl_xor(s, 32);
                if (fq == 0) ssq[(size_t)row * 16 + u.pn * 4 + wc] = s; }
            asm volatile("" ::: "memory"); }
    }
};
struct EpiLogits {
    static constexpr bool PERM = true;
    GAS float* L; const GAS float* ssqp;
    __device__ __forceinline__ void operator()(const f32x4 (&acc)[2][2][4][2], const Unit& u, int wr, int wc, int fr, int fq) const {
        if (u.pn != 0 || wc > 1) return;
#pragma unroll
        for (int ai = 0; ai < 2; ++ai) { f32x4 pp[4][4];
#pragma unroll
            for (int m = 0; m < 4; ++m) { const GAS f32x4* p = (const GAS f32x4*)(ssqp + (size_t)EPI_ROW(ai, m) * 16); pp[m][0] = p[0]; pp[m][1] = p[1]; pp[m][2] = p[2]; pp[m][3] = p[3]; }
#pragma unroll
            for (int m = 0; m < 4; ++m) { const int row = EPI_ROW(ai, m); const f32x4 a = pp[m][0], b = pp[m][1], c = pp[m][2], d = pp[m][3];
                const float sc = __builtin_amdgcn_rsqf((((a.x + a.y) + (a.z + a.w)) + ((b.x + b.y) + (b.z + b.w)) + ((c.x + c.y) + (c.z + c.w)) + ((d.x + d.y) + (d.z + d.w))) * (1.0f / 1024.0f) + EPS);
#pragma unroll
                for (int n = 0; n < 2; ++n) { const int col = wc * 32 + 8 * fq + 4 * n; if (col < 36) *(GAS f32x4*)(L + (size_t)row * 64 + col) = acc[ai][0][m][n] * sc; } } }
    }
};
struct EpiGateUp {
    static constexpr bool PERM = true;
    GAS bf16_t* act; const GAS float* tabf; const LAS int* pend; const LAS int* pcnt; float wsc;
    __device__ __forceinline__ void operator()(const f32x4 (&acc)[2][2][4][2], const Unit& u, int wr, int wc, int fr, int fq) const {
        int e = 0; while (e < NEXP - 1 && pend[e] <= u.pm) ++e;
        const int lp = u.pm - (e ? pend[e - 1] : 0), cnt = pcnt[e] - lp * 256; const unsigned base = (unsigned)(e * MOE_CAP + lp * 256);
        float sc[2][4];
#pragma unroll
        for (int ai = 0; ai < 2; ++ai)
#pragma unroll
            for (int m = 0; m < 4; ++m) { const int r = ai * 128 + wr * 64 + m * 16 + fr; const float v = tabf[(size_t)(base + r) * 4 + 1]; sc[ai][m] = (r < cnt) ? v : 0.f; }
#pragma unroll
        for (int ai = 0; ai < 2; ++ai)
#pragma unroll
            for (int m = 0; m < 4; ++m) { const int row = EPI_ROW(ai, m); const float s = sc[ai][m] * wsc; f32x4 a[2];
#pragma unroll
                for (int n = 0; n < 2; ++n) { const f32x4 gg = acc[ai][0][m][n] * s, uu = acc[ai][1][m][n] * s;
#pragma unroll
                    for (int i = 0; i < 4; ++i) a[n][i] = gg[i] * fsigmoid(gg[i]) * uu[i]; }
                u32x4 w; w.x = cvt_pk_bf16(a[0][0], a[0][1]); w.y = cvt_pk_bf16(a[0][2], a[0][3]); w.z = cvt_pk_bf16(a[1][0], a[1][1]); w.w = cvt_pk_bf16(a[1][2], a[1][3]);
                *(GAS u32x4*)(act + (size_t)row * 256 + u.pn * 128 + wc * 32 + 8 * fq) = w; }
    }
};
struct EpiDown {
    static constexpr bool PERM = true;
    GAS bf16_t* ybuf; const GAS int* tabi; const LAS int* pend; const LAS int* pcnt;
    __device__ __forceinline__ void operator()(const f32x4 (&acc)[2][2][4][2], const Unit& u, int wr, int wc, int fr, int fq) const {
        int e = 0; while (e < NEXP - 1 && pend[e] <= u.pm) ++e;
        const int lp = u.pm - (e ? pend[e - 1] : 0), cnt = pcnt[e] - lp * 256; const unsigned base = (unsigned)(e * MOE_CAP + lp * 256);
        int yd[2][4]; float sw[2][4];
#pragma unroll
        for (int ai = 0; ai < 2; ++ai)
#pragma unroll
            for (int m = 0; m < 4; ++m) { const int r = ai * 128 + wr * 64 + m * 16 + fr; const GAS int* en = tabi + (size_t)(base + r) * 4; const int y_ = en[2]; const float w_ = __int_as_float(en[3]);
                yd[ai][m] = (r < cnt) ? y_ : -1; sw[ai][m] = w_; }
#pragma unroll
        for (int ai = 0; ai < 2; ++ai)
#pragma unroll
            for (int m = 0; m < 4; ++m) { const float sc = sw[ai][m];
                if (yd[ai][m] >= 0) { const float s8 = sc * Y8S;
                    const f32x4 a0 = acc[ai][0][m][0] * s8, a1 = acc[ai][0][m][1] * s8, b0 = acc[ai][1][m][0] * s8, b1 = acc[ai][1][m][1] * s8;
                    u32x4 w; w.x = pk4_fp8(a0[0], a0[1], a0[2], a0[3]); w.y = pk4_fp8(a1[0], a1[1], a1[2], a1[3]); w.z = pk4_fp8(b0[0], b0[1], b0[2], b0[3]); w.w = pk4_fp8(b1[0], b1[1], b1[2], b1[3]);
                    *(GAS u32x4*)((GAS unsigned char*)ybuf + (size_t)yd[ai][m] * 1024 + EPI_COL16) = w; } }
    }
};

typedef int v4i32_t __attribute__((ext_vector_type(4)));
typedef long i64x2_t __attribute__((ext_vector_type(2)));
template <class Epi, class Sched, bool I8 = false, bool MID = false, bool F8 = false, bool ALIGN_EPI = true, bool SP2 = true>
__device__ __forceinline__ void gemm_phase(LAS unsigned char* lds, const Gemm g, const Sched& S, const Epi& E) {
    int tid_ = threadIdx.x; asm volatile("" : "+v"(tid_));
    const int tid = tid_, wid = __builtin_amdgcn_readfirstlane(tid >> 6), lane = tid & 63, wr = wid >> 2, wc = wid & 3, fr = lane & 15, fq = lane >> 4;
    int K_ = g.K; asm volatile("" : "+s"(K_));
    const int K = K_, nt = K / BK;
    unsigned voffA[2], voffB[2];
#pragma unroll
    for (int i = 0; i < 2; ++i) { int R, C; stage_rc(tid * 16 + i * 8192, R, C); const int Rb = Epi::PERM ? ((R & ~31) + perm32(R & 31)) : R;
        voffA[i] = (unsigned)(R * g.lda + C) * 2u; voffB[i] = (unsigned)(Rb * g.ldb + C) * 2u; }
    const size_t kstep = (size_t)(BK * 2);
    const size_t hstepA = (size_t)HALF * g.lda * 2, hstepB = (size_t)HALF * g.ldb * 2;
    const unsigned ldsw = (unsigned)wid * 1024u;
    const int aoff = lds_byte(wr * 64 + fr, fq * 8), boff = lds_byte(wc * 32 + fr, fq * 8);
#define PG8_SA(b, h) (((b) * 2 + (h)) * HTB)
#define PG8_SB(b, h) ((4 + (b) * 2 + (h)) * HTB)
#define PG8_STAGE(bufoff, gbase, voff) do { _Pragma("unroll") for (int _i = 0; _i < 2; ++_i) \
        __builtin_amdgcn_global_load_lds((const GAS unsigned*)((const char*)(gbase) + (voff)[_i]), (LAS unsigned*)(lds + (bufoff) + ldsw + _i * 8192), 16, 0, 0); } while (0)
#define PG8_LDA(dst, b, h) do { _Pragma("unroll") for (int m = 0; m < 4; ++m) _Pragma("unroll") for (int k = 0; k < 2; ++k) dst[m][k] = *(const LAS bf16x8*)(lds + PG8_SA(b, h) + aoff + m * 2048 + k * 1024); } while (0)
#define PG8_LDB(dst, b, h) do { _Pragma("unroll") for (int n = 0; n < 2; ++n) _Pragma("unroll") for (int k = 0; k < 2; ++k) dst[n][k] = *(const LAS bf16x8*)(lds + PG8_SB(b, h) + boff + n * 2048 + k * 1024); } while (0)
#define PG8_MMA(ai, bj, At, Bt) do { __builtin_amdgcn_s_setprio(1); _Pragma("unroll") for (int m = 0; m < 4; ++m) _Pragma("unroll") for (int n = 0; n < 2; ++n) _Pragma("unroll") for (int k = 0; k < 2; ++k) { \
        if constexpr (I8) acc[ai][bj][m][n] = __builtin_bit_cast(f32x4, __builtin_amdgcn_mfma_i32_16x16x64_i8(__builtin_bit_cast(v4i32_t, Bt[n][k]), __builtin_bit_cast(v4i32_t, At[m][k]), __builtin_bit_cast(v4i32_t, acc[ai][bj][m][n]), 0, 0, 0)); \
        else if constexpr (F8) { const i64x2_t b_ = __builtin_bit_cast(i64x2_t, Bt[n][k]), a_ = __builtin_bit_cast(i64x2_t, At[m][k]); \
            acc[ai][bj][m][n] = __builtin_amdgcn_mfma_f32_16x16x32_fp8_fp8(b_[0], a_[0], acc[ai][bj][m][n], 0, 0, 0); acc[ai][bj][m][n] = __builtin_amdgcn_mfma_f32_16x16x32_fp8_fp8(b_[1], a_[1], acc[ai][bj][m][n], 0, 0, 0); } \
        else acc[ai][bj][m][n] = __builtin_amdgcn_mfma_f32_16x16x32_bf16(Bt[n][k], At[m][k], acc[ai][bj][m][n], 0, 0, 0); } \
        __builtin_amdgcn_s_setprio(0); } while (0)
#define PG8_WAIT_V(n) asm volatile("s_waitcnt vmcnt(" #n ")" ::: "memory")
#define PG8_WAIT_L(n) asm volatile("s_waitcnt lgkmcnt(" #n ")" ::: "memory")
#define PG8_BAR __builtin_amdgcn_s_barrier()
#define PG8_SCHED __builtin_amdgcn_sched_barrier(0)
    Unit cur, nxt; int ui = 0;
    if (!S.next(0, cur)) return;
    unsigned gvc[2][2], gvn[2][2];
    if constexpr (Sched::GATHER) { S.gather(g, cur, tid, gvc); gvn[0][0] = gvc[0][0]; gvn[0][1] = gvc[0][1]; gvn[1][0] = gvc[1][0]; gvn[1][1] = gvc[1][1]; }
#define PG8_STAGE_A(b, h, aptr, ko, nx) do { if constexpr (Sched::GATHER) { unsigned sv_[2] = {(nx) ? gvn[h][0] : gvc[h][0], (nx) ? gvn[h][1] : gvc[h][1]}; PG8_STAGE(PG8_SA(b, h), (const char*)g.A + (ko), sv_); } \
        else PG8_STAGE(PG8_SA(b, h), (aptr), voffA); } while (0)
    f32x4 acc[2][2][4][2];
#pragma unroll
    for (int a = 0; a < 2; ++a)
#pragma unroll
        for (int b = 0; b < 2; ++b)
#pragma unroll
            for (int m = 0; m < 4; ++m)
#pragma unroll
                for (int n = 0; n < 2; ++n) acc[a][b][m][n] = (f32x4){0.f, 0.f, 0.f, 0.f};
    bf16x8 At[4][2], B0[2][2], B1[2][2];
    const char* cA = (const char*)g.A + S.aoff(g, cur); const char* cB = (const char*)g.Bt + S.boff(g, cur);
    const int ntm = nt - 1;
#define PG8_ROT(u_) ((MID || nt < 4) ? 0 : (((u_).pn & 3) * (nt >> 2)))
#define PG8_KO(rot_, t_) ((size_t)(((t_) + (rot_)) & ntm) * kstep)
    int rotc = PG8_ROT(cur);
    if constexpr (SP2) {
        PG8_STAGE(PG8_SB(0, 0), cB + PG8_KO(rotc, 0), voffB); PG8_STAGE(PG8_SB(0, 1), cB + hstepB + PG8_KO(rotc, 0), voffB); PG8_STAGE_A(0, 0, cA + PG8_KO(rotc, 0), PG8_KO(rotc, 0), false); PG8_STAGE_A(0, 1, cA + hstepA + PG8_KO(rotc, 0), PG8_KO(rotc, 0), false);
        if (wr == 1) PG8_BAR;
        PG8_WAIT_V(2); PG8_BAR;
        PG8_STAGE(PG8_SB(1, 0), cB + PG8_KO(rotc, 1), voffB); PG8_STAGE_A(1, 0, cA + PG8_KO(rotc, 1), PG8_KO(rotc, 1), false); PG8_STAGE(PG8_SB(1, 1), cB + hstepB + PG8_KO(rotc, 1), voffB);
        PG8_WAIT_V(6); PG8_BAR;
    }
    for (;;) {
        const bool has_next = S.next(ui + 1, nxt);
        const char* nA = has_next ? (const char*)g.A + S.aoff(g, nxt) : cA; const char* nB = has_next ? (const char*)g.Bt + S.boff(g, nxt) : cB;
        const int rotn = has_next ? PG8_ROT(nxt) : rotc;
        if constexpr (Sched::GATHER) { if (has_next) S.gather(g, nxt, tid, gvn); }
        for (int t = 0; t < nt; t += 2) {
            if constexpr (MID) { if (t == (nt >> 1)) E.mid(acc, cur, wr, wc, fr, fq); }
            const bool last = (t == nt - 2);
            const char* a1 = cA + PG8_KO(rotc, t + 1);
            const char* a2 = last ? nA + PG8_KO(rotn, 0) : cA + PG8_KO(rotc, t + 2); const char* b2 = last ? nB + PG8_KO(rotn, 0) : cB + PG8_KO(rotc, t + 2);
            const char* a3 = last ? nA + PG8_KO(rotn, 1) : cA + PG8_KO(rotc, t + 3); const char* b3 = last ? nB + PG8_KO(rotn, 1) : cB + PG8_KO(rotc, t + 3);
            const size_t ko1 = PG8_KO(rotc, t + 1), ko2 = last ? PG8_KO(rotn, 0) : PG8_KO(rotc, t + 2), ko3 = last ? PG8_KO(rotn, 1) : PG8_KO(rotc, t + 3); (void)ko1; (void)ko2; (void)ko3;
            PG8_LDB(B0, 0, 0); PG8_LDB(B1, 0, 1); PG8_SCHED; PG8_LDA(At, 0, 0); PG8_STAGE_A(1, 1, a1 + hstepA, ko1, false);
            PG8_WAIT_V(8); PG8_WAIT_L(0); PG8_BAR; PG8_MMA(0, 0, At, B0); PG8_MMA(0, 1, At, B1); PG8_BAR; PG8_SCHED;
            PG8_LDA(At, 0, 1); PG8_STAGE(PG8_SB(0, 0), b2, voffB); PG8_STAGE(PG8_SB(0, 1), b2 + hstepB, voffB); PG8_STAGE_A(0, 0, a2, ko2, last);
            PG8_WAIT_V(8); PG8_WAIT_L(0); PG8_BAR; PG8_MMA(1, 0, At, B0); PG8_MMA(1, 1, At, B1); PG8_BAR; PG8_SCHED;
            PG8_LDB(B0, 1, 0); PG8_LDB(B1, 1, 1); PG8_SCHED; PG8_LDA(At, 1, 0); PG8_STAGE_A(0, 1, a2 + hstepA, ko2, last);
            PG8_WAIT_V(8); PG8_WAIT_L(0); PG8_BAR; PG8_MMA(0, 0, At, B0); PG8_MMA(0, 1, At, B1); PG8_BAR; PG8_SCHED;
            PG8_LDA(At, 1, 1); PG8_STAGE(PG8_SB(1, 0), b3, voffB); PG8_STAGE(PG8_SB(1, 1), b3 + hstepB, voffB); PG8_STAGE_A(1, 0, a3, ko3, last);
            PG8_WAIT_V(8); PG8_WAIT_L(0); PG8_BAR; PG8_MMA(1, 0, At, B0); PG8_MMA(1, 1, At, B1); PG8_BAR; PG8_SCHED;
        }
        if constexpr (ALIGN_EPI) { if (wr == 0) PG8_BAR; }
        if constexpr (I8) {
#pragma unroll
            for (int a = 0; a < 2; ++a)
#pragma unroll
                for (int b = 0; b < 2; ++b)
#pragma unroll
                    for (int m = 0; m < 4; ++m)
#pragma unroll
                        for (int n = 0; n < 2; ++n) { const v4i32_t q = __builtin_bit_cast(v4i32_t, acc[a][b][m][n]); acc[a][b][m][n] = (f32x4){(float)q[0], (float)q[1], (float)q[2], (float)q[3]}; }
        }
        E(acc, cur, wr, wc, fr, fq);
        if (!has_next) break;
#pragma unroll
        for (int a = 0; a < 2; ++a)
#pragma unroll
            for (int b = 0; b < 2; ++b)
#pragma unroll
                for (int m = 0; m < 4; ++m)
#pragma unroll
                    for (int n = 0; n < 2; ++n) acc[a][b][m][n] = (f32x4){0.f, 0.f, 0.f, 0.f};
        cur = nxt; cA = nA; cB = nB; rotc = rotn; ++ui;
        if constexpr (Sched::GATHER) { gvc[0][0] = gvn[0][0]; gvc[0][1] = gvn[0][1]; gvc[1][0] = gvn[1][0]; gvc[1][1] = gvn[1][1]; }
        if constexpr (ALIGN_EPI) { if (wr == 1) PG8_BAR; }
    }
    PG8_WAIT_V(0);
    if constexpr (!ALIGN_EPI) { if (wr == 0) PG8_BAR; }
    PG8_BAR;
#undef PG8_SA
#undef PG8_SB
#undef PG8_STAGE
#undef PG8_STAGE_A
#undef PG8_LDA
#undef PG8_LDB
#undef PG8_MMA
#undef PG8_ROT
#undef PG8_KO
#undef PG8_WAIT_V
#undef PG8_WAIT_L
#undef PG8_BAR
#undef PG8_SCHED
}
}

namespace att {
typedef LAS const char* lds_cptr;
typedef short v4i16_t __attribute__((ext_vector_type(4)));
typedef float f32x2_t __attribute__((ext_vector_type(2))); typedef __bf16 bf16x2_t __attribute__((ext_vector_type(2)));
__device__ __forceinline__ int crow(int r, int hi) { return (r & 3) + 8 * (r >> 2) + 4 * hi; }
__device__ __forceinline__ void glds16(const GAS void* gsrc, unsigned lds_dst) { unsigned keep;
    asm volatile("s_mov_b32 %0, m0\n\ts_mov_b32 m0, %2\n\ts_nop 0\n\tglobal_load_lds_dwordx4 %1, off\n\ts_mov_b32 m0, %0" : "=&s"(keep) : "v"(gsrc), "s"(lds_dst) : "memory"); }
__device__ __forceinline__ void glds16s(const GAS void* sbase, unsigned voff, unsigned lds_dst) { unsigned keep;
    asm volatile("s_mov_b32 %0, m0\n\ts_mov_b32 m0, %3\n\ts_nop 0\n\tglobal_load_lds_dwordx4 %1, %2\n\ts_mov_b32 m0, %0" : "=&s"(keep) : "v"(voff), "s"(sbase), "s"(lds_dst) : "memory"); }
__device__ __forceinline__ unsigned cvtpk_s(float lo, float hi) { f32x2_t v = {lo, hi}; bf16x2_t b = __builtin_convertvector(v, bf16x2_t); return __builtin_bit_cast(unsigned, b); }
#define ATT_WAIT_BAR() asm volatile("s_waitcnt vmcnt(0) lgkmcnt(0)\n\ts_barrier" ::: "memory")
constexpr float THR = 8.0f;

template <int NQ> __device__ __forceinline__ void qk_tile(f32x16& p0, f32x16& p1, lds_cptr kslot, const bf16x8* qr, const f32x16& negm, int r32, int hi) {
    lds_cptr kb = kslot + hi * 1024 + r32 * 16;
    p0 = negm; p1 = negm;
#pragma unroll
    for (int d0 = 0; d0 < NQ; ++d0) {
        const bf16x8 b0 = *(const LAS bf16x8*)(kb + d0 * 2048);
        const bf16x8 b1 = *(const LAS bf16x8*)(kb + d0 * 2048 + 512);
        p0 = __builtin_amdgcn_mfma_f32_32x32x16_bf16(b0, qr[d0], p0, 0, 0, 0);
        p1 = __builtin_amdgcn_mfma_f32_32x32x16_bf16(b1, qr[d0], p1, 0, 0, 0);
    }
}
__device__ __forceinline__ void pv(f32x16* o, int vb, bf16x8 pa0, bf16x8 pa1, bf16x8 pa2, bf16x8 pa3) {
#pragma unroll
    for (int d0 = 0; d0 < 2; ++d0) { s16x4 lo[4], hi[4];
#pragma unroll
        for (int ks = 0; ks < 4; ++ks) {
            asm volatile("ds_read_b64_tr_b16 %0,%1 offset:%c2" : "=&v"(lo[ks]) : "v"(vb), "i"(d0 * 4096 + ks * 1024) : "memory");
            asm volatile("ds_read_b64_tr_b16 %0,%1 offset:%c2" : "=&v"(hi[ks]) : "v"(vb), "i"(d0 * 4096 + ks * 1024 + 512) : "memory"); }
        asm volatile("s_waitcnt lgkmcnt(0)" ::: "memory"); __builtin_amdgcn_sched_barrier(0);
#define PK(k) (bf16x8){lo[k][0], lo[k][1], lo[k][2], lo[k][3], hi[k][0], hi[k][1], hi[k][2], hi[k][3]}
        o[d0] = __builtin_amdgcn_mfma_f32_32x32x16_bf16(pa0, PK(0), o[d0], 0, 0, 0);
        o[d0] = __builtin_amdgcn_mfma_f32_32x32x16_bf16(pa1, PK(1), o[d0], 0, 0, 0);
        o[d0] = __builtin_amdgcn_mfma_f32_32x32x16_bf16(pa2, PK(2), o[d0], 0, 0, 0);
        o[d0] = __builtin_amdgcn_mfma_f32_32x32x16_bf16(pa3, PK(3), o[d0], 0, 0, 0);
#undef PK
    }
}
__device__ __forceinline__ void softmax_pv(f32x16& p0, f32x16& p1, float& mhat, float& l_reg, f32x16& negm, f32x16* o, bool first, LAS float* wsf, int vb, int r32, int hi) {
    float a = __builtin_fmaxf(p0[0], p1[0]);
#pragma unroll
    for (int r = 1; r < 16; ++r) a = __builtin_fmaxf(a, __builtin_fmaxf(p0[r], p1[r]));
    float rm = a;
    { auto rr = __builtin_amdgcn_permlane32_swap(__float_as_uint(rm), __float_as_uint(rm), false, false); rm = __builtin_fmaxf(__uint_as_float(rr[0]), __uint_as_float(rr[1])); }
    if (first) {
        const float dl = rm; mhat += dl;
#pragma unroll
        for (int r = 0; r < 16; ++r) { p0[r] -= dl; p1[r] -= dl; }
#pragma unroll
        for (int r = 0; r < 16; ++r) negm[r] = -mhat;
    } else if (__any(rm > THR)) {
        const float dl = __builtin_fmaxf(rm, 0.f); mhat += dl;
#pragma unroll
        for (int r = 0; r < 16; ++r) { p0[r] -= dl; p1[r] -= dl; }
#pragma unroll
        for (int r = 0; r < 16; ++r) negm[r] = -mhat;
        const float f = __builtin_amdgcn_exp2f(-dl); l_reg *= f;
        if (hi == 0) wsf[r32] = f;
        LDS_WAIT();
#pragma unroll
        for (int r = 0; r < 16; ++r) { const float fr_ = wsf[crow(r, hi)]; o[0][r] *= fr_; o[1][r] *= fr_; }
        LDS_WAIT();
    }
    float sacc = 0.f;
#pragma unroll
    for (int r = 0; r < 16; ++r) { p0[r] = __builtin_amdgcn_exp2f(p0[r]); p1[r] = __builtin_amdgcn_exp2f(p1[r]); sacc += p0[r] + p1[r]; }
    l_reg += sacc;
    u32x4 pw0, pw1, pw2, pw3;
    pw0 = (u32x4){cvtpk_s(p0[0], p0[1]), cvtpk_s(p0[2], p0[3]), cvtpk_s(p0[4], p0[5]), cvtpk_s(p0[6], p0[7])};
    pw1 = (u32x4){cvtpk_s(p0[8], p0[9]), cvtpk_s(p0[10], p0[11]), cvtpk_s(p0[12], p0[13]), cvtpk_s(p0[14], p0[15])};
    pw2 = (u32x4){cvtpk_s(p1[0], p1[1]), cvtpk_s(p1[2], p1[3]), cvtpk_s(p1[4], p1[5]), cvtpk_s(p1[6], p1[7])};
    pw3 = (u32x4){cvtpk_s(p1[8], p1[9]), cvtpk_s(p1[10], p1[11]), cvtpk_s(p1[12], p1[13]), cvtpk_s(p1[14], p1[15])};
    pv(o, vb, __builtin_bit_cast(bf16x8, pw0), __builtin_bit_cast(bf16x8, pw1), __builtin_bit_cast(bf16x8, pw2), __builtin_bit_cast(bf16x8, pw3));
}
__device__ __forceinline__ void softmax_pv_fixed(f32x16& p0, f32x16& p1, float& l_reg, f32x16* o, int vb) {
    float sacc = 0.f;
#pragma unroll
    for (int r = 0; r < 16; ++r) { p0[r] = __builtin_amdgcn_exp2f(p0[r]); p1[r] = __builtin_amdgcn_exp2f(p1[r]); sacc += p0[r] + p1[r]; }
    l_reg += sacc;
    u32x4 pw0, pw1, pw2, pw3;
    pw0 = (u32x4){cvtpk_s(p0[0], p0[1]), cvtpk_s(p0[2], p0[3]), cvtpk_s(p0[4], p0[5]), cvtpk_s(p0[6], p0[7])};
    pw1 = (u32x4){cvtpk_s(p0[8], p0[9]), cvtpk_s(p0[10], p0[11]), cvtpk_s(p0[12], p0[13]), cvtpk_s(p0[14], p0[15])};
    pw2 = (u32x4){cvtpk_s(p1[0], p1[1]), cvtpk_s(p1[2], p1[3]), cvtpk_s(p1[4], p1[5]), cvtpk_s(p1[6], p1[7])};
    pw3 = (u32x4){cvtpk_s(p1[8], p1[9]), cvtpk_s(p1[10], p1[11]), cvtpk_s(p1[12], p1[13]), cvtpk_s(p1[14], p1[15])};
    pv(o, vb, __builtin_bit_cast(bf16x8, pw0), __builtin_bit_cast(bf16x8, pw1), __builtin_bit_cast(bf16x8, pw2), __builtin_bit_cast(bf16x8, pw3));
}
__device__ __forceinline__ void store_o(const f32x16* o, float l_reg, LAS float* wsf, LAS bf16_t* stg, GAS bf16_t* Ow, int pitch, int lane, int r32, int hi) {
    { auto rr = __builtin_amdgcn_permlane32_swap(__float_as_uint(l_reg), __float_as_uint(l_reg), false, false); l_reg = __uint_as_float(rr[0]) + __uint_as_float(rr[1]); }
    if (hi == 0) wsf[32 + r32] = l_reg;
    LDS_WAIT();
    float rli[16];
#pragma unroll
    for (int r = 0; r < 16; ++r) rli[r] = __builtin_amdgcn_rcpf(wsf[32 + crow(r, hi)]);
#pragma unroll
    for (int r = 0; r < 16; ++r) { const int orow = crow(r, hi);
#pragma unroll
        for (int d0 = 0; d0 < 2; ++d0) stg[orow * 64 + d0 * 32 + r32] = (bf16_t)(cvt_pk_bf16(o[d0][r] * rli[r], 0.f) & 0xffffu); }
    LDS_WAIT();
#pragma unroll
    for (int i = 0; i < 4; ++i) { const int row = i * 8 + (lane >> 3), ch = lane & 7; const u32x4 v = *(const LAS u32x4*)(stg + row * 64 + ch * 8); *(GAS u32x4*)(Ow + (size_t)row * pitch + ch * 8) = v; }
    LDS_WAIT();
}

constexpr int M_NS = 4, M_KSLOT = 12288, M_VSLOT = 8192, M_LK = 0, M_LV = M_NS * M_KSLOT, M_LWS = M_LV + M_NS * M_VSLOT, M_LOST = M_LWS + 2048, M_LDS = M_LOST + 32768;
#define ATT_WAITN_BAR(N) asm volatile("s_waitcnt vmcnt(" #N ") lgkmcnt(0)\n\ts_barrier" ::: "memory")
__device__ __forceinline__ void mla_load_q(bf16x8 (&qr)[6], const GAS unsigned char* Qrow, const GAS float* gbq, const GAS float* rope, int pos, int hi) {
    u32x2 q8[6];
#pragma unroll
    for (int d0 = 0; d0 < 6; ++d0) q8[d0] = *(const GAS u32x2*)(Qrow + d0 * 16 + hi * 8);
    float f[6][8]; float ss = 0.f;
#pragma unroll
    for (int d0 = 0; d0 < 6; ++d0) { const int wx = (int)q8[d0].x, wy = (int)q8[d0].y;
        f[d0][0] = __builtin_amdgcn_cvt_f32_fp8(wx, 0); f[d0][1] = __builtin_amdgcn_cvt_f32_fp8(wx, 1); f[d0][2] = __builtin_amdgcn_cvt_f32_fp8(wx, 2); f[d0][3] = __builtin_amdgcn_cvt_f32_fp8(wx, 3);
        f[d0][4] = __builtin_amdgcn_cvt_f32_fp8(wy, 0); f[d0][5] = __builtin_amdgcn_cvt_f32_fp8(wy, 1); f[d0][6] = __builtin_amdgcn_cvt_f32_fp8(wy, 2); f[d0][7] = __builtin_amdgcn_cvt_f32_fp8(wy, 3);
#pragma unroll
        for (int j = 0; j < 8; ++j) ss += f[d0][j] * f[d0][j]; }
    ss += __shfl_xor(ss, 32);
    const float rs = __builtin_amdgcn_rsqf(ss * (1.0f / 96.0f) + EPS) * C2B;
#pragma unroll
    for (int d0 = 0; d0 < 6; ++d0) { const f32x4 g0 = *(const GAS f32x4*)(gbq + 16 * d0 + 8 * hi), g1 = *(const GAS f32x4*)(gbq + 16 * d0 + 8 * hi + 4);
        f[d0][0] *= rs * g0.x; f[d0][1] *= rs * g0.y; f[d0][2] *= rs * g0.z; f[d0][3] *= rs * g0.w; f[d0][4] *= rs * g1.x; f[d0][5] *= rs * g1.y; f[d0][6] *= rs * g1.z; f[d0][7] *= rs * g1.w; }
    { const GAS float* rp = rope + (size_t)pos * 32 + 8 * hi; const f32x4 c0 = *(const GAS f32x4*)rp, c1 = *(const GAS f32x4*)(rp + 4), s0 = *(const GAS f32x4*)(rp + 16), s1 = *(const GAS f32x4*)(rp + 20);
      const float cs[8] = {c0.x, c0.y, c0.z, c0.w, c1.x, c1.y, c1.z, c1.w}, sn[8] = {s0.x, s0.y, s0.z, s0.w, s1.x, s1.y, s1.z, s1.w};
#pragma unroll
      for (int j = 0; j < 8; ++j) { const float a = f[4][j], c = f[5][j]; f[4][j] = a * cs[j] - c * sn[j]; f[5][j] = a * sn[j] + c * cs[j]; } }
#pragma unroll
    for (int d0 = 0; d0 < 6; ++d0) { u32x4 w; w.x = cvt_pk_bf16(f[d0][0], f[d0][1]); w.y = cvt_pk_bf16(f[d0][2], f[d0][3]); w.z = cvt_pk_bf16(f[d0][4], f[d0][5]); w.w = cvt_pk_bf16(f[d0][6], f[d0][7]); qr[d0] = __builtin_bit_cast(bf16x8, w); }
}
__device__ __forceinline__ void qk_tile2(f32x16& a0, f32x16& a1, f32x16& b0, f32x16& b1, lds_cptr kslot, const bf16x8* qa, const bf16x8* qb, int r32, int hi) {
    lds_cptr kb = kslot + hi * 1024 + r32 * 16;
    a0 = f32x16{}; a1 = f32x16{}; b0 = f32x16{}; b1 = f32x16{};
    bf16x8 k0 = *(const LAS bf16x8*)(kb), k1 = *(const LAS bf16x8*)(kb + 512);
#pragma unroll
    for (int d0 = 0; d0 < 6; ++d0) {
        bf16x8 n0 = k0, n1 = k1;
        if (d0 < 5) { n0 = *(const LAS bf16x8*)(kb + (d0 + 1) * 2048); n1 = *(const LAS bf16x8*)(kb + (d0 + 1) * 2048 + 512); }
        __builtin_amdgcn_sched_barrier(0);
        a0 = __builtin_amdgcn_mfma_f32_32x32x16_bf16(k0, qa[d0], a0, 0, 0, 0);
        a1 = __builtin_amdgcn_mfma_f32_32x32x16_bf16(k1, qa[d0], a1, 0, 0, 0);
        b0 = __builtin_amdgcn_mfma_f32_32x32x16_bf16(k0, qb[d0], b0, 0, 0, 0);
        b1 = __builtin_amdgcn_mfma_f32_32x32x16_bf16(k1, qb[d0], b1, 0, 0, 0);
        __builtin_amdgcn_sched_barrier(0);
        k0 = n0; k1 = n1;
    }
}
__device__ __forceinline__ void exp_pack(f32x16& p0, f32x16& p1, float& l_reg, bf16x8 (&pa)[4], float sub) {
    float sacc = 0.f;
    if (sub != 0.f) {
#pragma unroll
        for (int r = 0; r < 16; ++r) { p0[r] -= sub; p1[r] -= sub; } }
#pragma unroll
    for (int r = 0; r < 16; ++r) { p0[r] = __builtin_amdgcn_exp2f(p0[r]); p1[r] = __builtin_amdgcn_exp2f(p1[r]); sacc += p0[r] + p1[r]; }
    l_reg += sacc;
    pa[0] = __builtin_bit_cast(bf16x8, (u32x4){cvtpk_s(p0[0], p0[1]), cvtpk_s(p0[2], p0[3]), cvtpk_s(p0[4], p0[5]), cvtpk_s(p0[6], p0[7])});
    pa[1] = __builtin_bit_cast(bf16x8, (u32x4){cvtpk_s(p0[8], p0[9]), cvtpk_s(p0[10], p0[11]), cvtpk_s(p0[12], p0[13]), cvtpk_s(p0[14], p0[15])});
    pa[2] = __builtin_bit_cast(bf16x8, (u32x4){cvtpk_s(p1[0], p1[1]), cvtpk_s(p1[2], p1[3]), cvtpk_s(p1[4], p1[5]), cvtpk_s(p1[6], p1[7])});
    pa[3] = __builtin_bit_cast(bf16x8, (u32x4){cvtpk_s(p1[8], p1[9]), cvtpk_s(p1[10], p1[11]), cvtpk_s(p1[12], p1[13]), cvtpk_s(p1[14], p1[15])});
}
__device__ __forceinline__ void pv2(f32x16* oa, f32x16* ob, int vb, const bf16x8 (&pa)[4], const bf16x8 (&pb)[4], bool doA, bool doB) {
    s16x4 lo[2][4], hi[2][4];
#pragma unroll
    for (int d0 = 0; d0 < 2; ++d0)
#pragma unroll
        for (int ks = 0; ks < 4; ++ks) {
            asm volatile("ds_read_b64_tr_b16 %0,%1 offset:%c2" : "=&v"(lo[d0][ks]) : "v"(vb), "i"(d0 * 4096 + ks * 1024) : "memory");
            asm volatile("ds_read_b64_tr_b16 %0,%1 offset:%c2" : "=&v"(hi[d0][ks]) : "v"(vb), "i"(d0 * 4096 + ks * 1024 + 512) : "memory"); }
#define PK(d, k) (bf16x8){lo[d][k][0], lo[d][k][1], lo[d][k][2], lo[d][k][3], hi[d][k][0], hi[d][k][1], hi[d][k][2], hi[d][k][3]}
#pragma unroll
    for (int d0 = 0; d0 < 2; ++d0) {
        if (d0 == 0) asm volatile("s_waitcnt lgkmcnt(8)" ::: "memory"); else asm volatile("s_waitcnt lgkmcnt(0)" ::: "memory");
        __builtin_amdgcn_sched_barrier(0);
        if (doA) {
#pragma unroll
            for (int k = 0; k < 4; ++k) oa[d0] = __builtin_amdgcn_mfma_f32_32x32x16_bf16(pa[k], PK(d0, k), oa[d0], 0, 0, 0); }
        if (doB) {
#pragma unroll
            for (int k = 0; k < 4; ++k) ob[d0] = __builtin_amdgcn_mfma_f32_32x32x16_bf16(pb[k], PK(d0, k), ob[d0], 0, 0, 0); }
    }
#undef PK
}
__device__ __forceinline__ void qk_one(f32x16& a0, f32x16& a1, lds_cptr kslot, const bf16x8* qa, int r32, int hi) {
    lds_cptr kb = kslot + hi * 1024 + r32 * 16;
    a0 = f32x16{}; a1 = f32x16{};
    bf16x8 k0 = *(const LAS bf16x8*)(kb), k1 = *(const LAS bf16x8*)(kb + 512);
#pragma unroll
    for (int d0 = 0; d0 < 6; ++d0) {
        bf16x8 n0 = k0, n1 = k1;
        if (d0 < 5) { n0 = *(const LAS bf16x8*)(kb + (d0 + 1) * 2048); n1 = *(const LAS bf16x8*)(kb + (d0 + 1) * 2048 + 512); }
        __builtin_amdgcn_sched_barrier(0);
        a0 = __builtin_amdgcn_mfma_f32_32x32x16_bf16(k0, qa[d0], a0, 0, 0, 0);
        a1 = __builtin_amdgcn_mfma_f32_32x32x16_bf16(k1, qa[d0], a1, 0, 0, 0);
        __builtin_amdgcn_sched_barrier(0);
        k0 = n0; k1 = n1;
    }
}
__device__ __forceinline__ void qkB_expA(f32x16& b0, f32x16& b1, f32x16& pA0, f32x16& pA1, float& la, bf16x8 (&pa)[4], lds_cptr kslot, const bf16x8* qb, int r32, int hi) {
    lds_cptr kb = kslot + hi * 1024 + r32 * 16;
    b0 = f32x16{}; b1 = f32x16{};
    bf16x8 k0 = *(const LAS bf16x8*)(kb), k1 = *(const LAS bf16x8*)(kb + 512);
    float sacc = 0.f;
#define EXPG(g) do { f32x16& P_ = ((g) < 4) ? pA0 : pA1; constexpr int r0_ = 4 * ((g) & 3); \
        float e0_ = __builtin_amdgcn_exp2f(P_[r0_]), e1_ = __builtin_amdgcn_exp2f(P_[r0_ + 1]), e2_ = __builtin_amdgcn_exp2f(P_[r0_ + 2]), e3_ = __builtin_amdgcn_exp2f(P_[r0_ + 3]); \
        sacc += (e0_ + e1_) + (e2_ + e3_); asm volatile("" : "+v"(e0_), "+v"(e1_), "+v"(e2_), "+v"(e3_), "+v"(sacc)); P_[r0_] = e0_; P_[r0_ + 1] = e1_; P_[r0_ + 2] = e2_; P_[r0_ + 3] = e3_; } while (0)
#define PACK(j) do { const f32x16& P_ = ((j) < 2) ? pA0 : pA1; constexpr int r0_ = 8 * ((j) & 1); u32x4 w_ = {cvtpk_s(P_[r0_], P_[r0_ + 1]), cvtpk_s(P_[r0_ + 2], P_[r0_ + 3]), cvtpk_s(P_[r0_ + 4], P_[r0_ + 5]), cvtpk_s(P_[r0_ + 6], P_[r0_ + 7])}; \
        asm volatile("" : "+v"(w_)); pa[j] = __builtin_bit_cast(bf16x8, w_); } while (0)
#pragma unroll
    for (int d0 = 0; d0 < 6; ++d0) {
        bf16x8 n0 = k0, n1 = k1;
        if (d0 < 5) { n0 = *(const LAS bf16x8*)(kb + (d0 + 1) * 2048); n1 = *(const LAS bf16x8*)(kb + (d0 + 1) * 2048 + 512); }
        __builtin_amdgcn_sched_barrier(0);
        b0 = __builtin_amdgcn_mfma_f32_32x32x16_bf16(k0, qb[d0], b0, 0, 0, 0);
        if (d0 == 0) EXPG(0); else if (d0 == 1) EXPG(2); else if (d0 == 2) EXPG(4); else if (d0 == 3) EXPG(6); else if (d0 == 4) PACK(0); else PACK(2);
        __builtin_amdgcn_sched_barrier(0);
        b1 = __builtin_amdgcn_mfma_f32_32x32x16_bf16(k1, qb[d0], b1, 0, 0, 0);
        if (d0 == 0) EXPG(1); else if (d0 == 1) EXPG(3); else if (d0 == 2) EXPG(5); else if (d0 == 3) EXPG(7); else if (d0 == 4) PACK(1); else PACK(3);
        __builtin_amdgcn_sched_barrier(0);
        k0 = n0; k1 = n1;
    }
#undef EXPG
#undef PACK
    la += sacc;
}
__device__ __forceinline__ void tail_pvA_expB_pvB(f32x16& pB0, f32x16& pB1, float& lb, const bf16x8 (&pa)[4], f32x16* oa, f32x16* ob, int vb) {
    s16x4 lo[2][4], hi[2][4];
#pragma unroll
    for (int d0 = 0; d0 < 2; ++d0)
#pragma unroll
        for (int ks = 0; ks < 4; ++ks) {
            asm volatile("ds_read_b64_tr_b16 %0,%1 offset:%c2" : "=&v"(lo[d0][ks]) : "v"(vb), "i"(d0 * 4096 + ks * 1024) : "memory");
            asm volatile("ds_read_b64_tr_b16 %0,%1 offset:%c2" : "=&v"(hi[d0][ks]) : "v"(vb), "i"(d0 * 4096 + ks * 1024 + 512) : "memory"); }
#define PK(d, k) (bf16x8){lo[d][k][0], lo[d][k][1], lo[d][k][2], lo[d][k][3], hi[d][k][0], hi[d][k][1], hi[d][k][2], hi[d][k][3]}
#define EXPG(g) do { f32x16& P_ = ((g) < 4) ? pB0 : pB1; constexpr int r0_ = 4 * ((g) & 3); \
        float e0_ = __builtin_amdgcn_exp2f(P_[r0_]), e1_ = __builtin_amdgcn_exp2f(P_[r0_ + 1]), e2_ = __builtin_amdgcn_exp2f(P_[r0_ + 2]), e3_ = __builtin_amdgcn_exp2f(P_[r0_ + 3]); \
        sacc += (e0_ + e1_) + (e2_ + e3_); asm volatile("" : "+v"(e0_), "+v"(e1_), "+v"(e2_), "+v"(e3_), "+v"(sacc)); P_[r0_] = e0_; P_[r0_ + 1] = e1_; P_[r0_ + 2] = e2_; P_[r0_ + 3] = e3_; } while (0)
    float sacc = 0.f;
    EXPG(0);
    asm volatile("s_waitcnt lgkmcnt(8)" ::: "memory"); __builtin_amdgcn_sched_barrier(0);
#define STEP(g) do { oa[(g) >> 2] = __builtin_amdgcn_mfma_f32_32x32x16_bf16(pa[(g) & 3], PK((g) >> 2, (g) & 3), oa[(g) >> 2], 0, 0, 0); \
        if ((g) + 1 < 8) EXPG((g) + 1); if ((g) == 3) asm volatile("s_waitcnt lgkmcnt(0)" ::: "memory"); __builtin_amdgcn_sched_barrier(0); } while (0)
    STEP(0); STEP(1); STEP(2); STEP(3); STEP(4); STEP(5); STEP(6); STEP(7);
#undef STEP
#undef EXPG
    lb += sacc;
    bf16x8 pb[4];
    pb[0] = __builtin_bit_cast(bf16x8, (u32x4){cvtpk_s(pB0[0], pB0[1]), cvtpk_s(pB0[2], pB0[3]), cvtpk_s(pB0[4], pB0[5]), cvtpk_s(pB0[6], pB0[7])});
    pb[1] = __builtin_bit_cast(bf16x8, (u32x4){cvtpk_s(pB0[8], pB0[9]), cvtpk_s(pB0[10], pB0[11]), cvtpk_s(pB0[12], pB0[13]), cvtpk_s(pB0[14], pB0[15])});
    pb[2] = __builtin_bit_cast(bf16x8, (u32x4){cvtpk_s(pB1[0], pB1[1]), cvtpk_s(pB1[2], pB1[3]), cvtpk_s(pB1[4], pB1[5]), cvtpk_s(pB1[6], pB1[7])});
    pb[3] = __builtin_bit_cast(bf16x8, (u32x4){cvtpk_s(pB1[8], pB1[9]), cvtpk_s(pB1[10], pB1[11]), cvtpk_s(pB1[12], pB1[13]), cvtpk_s(pB1[14], pB1[15])});
#pragma unroll
    for (int d0 = 0; d0 < 2; ++d0)
#pragma unroll
        for (int k = 0; k < 4; ++k) ob[d0] = __builtin_amdgcn_mfma_f32_32x32x16_bf16(pb[k], PK(d0, k), ob[d0], 0, 0, 0);
#undef PK
}
__device__ __forceinline__ void store_o8(const f32x16* o, float l_reg, LAS float* wsf, LAS unsigned char* stg, GAS unsigned char* Ow8, int pitch, int lane, int r32, int hi) {
    { auto rr = __builtin_amdgcn_permlane32_swap(__float_as_uint(l_reg), __float_as_uint(l_reg), false, false); l_reg = __uint_as_float(rr[0]) + __uint_as_float(rr[1]); }
    if (hi == 0) wsf[32 + r32] = l_reg;
    LDS_WAIT();
    float rli[16];
#pragma unroll
    for (int r = 0; r < 16; ++r) rli[r] = __builtin_amdgcn_rcpf(wsf[32 + crow(r, hi)]);
#pragma unroll
    for (int r = 0; r < 16; ++r) { const int orow = crow(r, hi);
        const int p = __builtin_amdgcn_cvt_pk_fp8_f32(o[0][r] * rli[r], o[1][r] * rli[r], 0, false);
        stg[orow * 64 + r32] = (unsigned char)(p & 0xff); stg[orow * 64 + 32 + r32] = (unsigned char)((p >> 8) & 0xff); }
    LDS_WAIT();
    { const int row = lane >> 1, hf = lane & 1; const u32x4 v0 = *(const LAS u32x4*)(stg + row * 64 + hf * 32), v1 = *(const LAS u32x4*)(stg + row * 64 + hf * 32 + 16);
      GAS unsigned char* d = Ow8 + (size_t)row * pitch + hf * 32; *(GAS u32x4*)d = v0; *(GAS u32x4*)(d + 16) = v1; }
    LDS_WAIT();
}
__device__ __forceinline__ void mla_unit(int b, int h, int qb, const GAS bf16_t* Q, const GAS bf16_t* K, const GAS bf16_t* V, GAS bf16_t* O, char* shm, float mfix, const GAS float* gbq, const GAS float* rope) {
    int tid_ = threadIdx.x; asm volatile("" : "+v"(tid_));
    const int tid = tid_, lane = tid & 63, r32 = lane & 31, hi = lane >> 5; const int wid = __builtin_amdgcn_readfirstlane(tid >> 6);
    const long rowbase = (long)b * SEQ; const int q0 = qb * 512;
    const unsigned lds0 = (unsigned)(uintptr_t)shm;
    const lds_cptr shm3 = (lds_cptr)shm;
    LAS float* wsf = (LAS float*)(shm3 + M_LWS) + wid * 64;
    const GAS bf16_t* Kb = K + (size_t)((b * 8 + h) * 64) * 12 * 512; const GAS bf16_t* Vb = V + rowbase * 1024 + h * 128 + 64;
    const unsigned kof0 = (unsigned)(lane * 8) * 2u;
    const unsigned vof = (unsigned)((16 * (wid & 3) + (lane >> 2)) * 1024 + (wid >> 2) * 32 + (lane & 3) * 8) * 2u;
    const int vb0 = (int)(lds0 + M_LV) + ((lane >> 4) & 1) * 32 + (lane & 3) * 8 + (4 * hi + ((lane & 15) >> 2)) * 64;
#define MLA_DMA(t, s) do { const GAS bf16_t* kt_ = Kb + (size_t)(t) * 12 * 512; const GAS bf16_t* vt_ = Vb + (size_t)(t) * 64 * 1024; \
        glds16s(kt_ + wid * 512, kof0, (unsigned)__builtin_amdgcn_readfirstlane(lds0 + M_LK + (s) * M_KSLOT + wid * 1024)); \
        glds16s(kt_ + (8 + (wid & 3)) * 512, kof0, (unsigned)__builtin_amdgcn_readfirstlane(lds0 + M_LK + (s) * M_KSLOT + (8 + (wid & 3)) * 1024)); \
        glds16s(vt_, vof, (unsigned)__builtin_amdgcn_readfirstlane(lds0 + M_LV + (s) * M_VSLOT + wid * 1024)); } while (0)
    const int NT = 8 * (qb + 1);
    MLA_DMA(0, 0); MLA_DMA(1, 1); MLA_DMA(2, 2);
    bf16x8 qa[6], qbb[6];
    mla_load_q(qa, (const GAS unsigned char*)Q + (rowbase + q0 + wid * 64 + r32) * 768 + h * 96, gbq, rope, q0 + wid * 64 + r32, hi);
    mla_load_q(qbb, (const GAS unsigned char*)Q + (rowbase + q0 + wid * 64 + 32 + r32) * 768 + h * 96, gbq, rope, q0 + wid * 64 + 32 + r32, hi);
    float la = 0.f, lb = 0.f; f32x16 oa[2], ob[2]; oa[0] = f32x16{}; oa[1] = f32x16{}; ob[0] = f32x16{}; ob[1] = f32x16{};
    const float sub = __builtin_fmaxf(mfix - 40.0f, 0.0f);
    const int qrelA = wid * 64 + r32, qrelB = qrelA + 32;
    const int NTw = NT - 7 + wid;
    for (int t = 0; t < NT; ++t) {
        const int rem = NT - 1 - t;
        if (rem >= 2) ATT_WAITN_BAR(6); else if (rem == 1) ATT_WAITN_BAR(3); else ATT_WAITN_BAR(0);
        if (t + 3 < NT) MLA_DMA(t + 3, (t + 3) & 3);
        if (t >= NTw) continue;
        const int s = t & 3, jb = t - (NT - 8);
        f32x16 pA0, pA1, pB0, pB1; bf16x8 pa[4];
        const int kb = 64 * jb + 4 * hi;
        qk_one(pA0, pA1, shm3 + M_LK + s * M_KSLOT, qa, r32, hi);
        if (jb >= 0) {
#pragma unroll
            for (int r = 0; r < 16; ++r) { const int kv = kb + (r & 3) + 8 * (r >> 2); if (kv > qrelA) pA0[r] = -INFINITY; if (kv + 32 > qrelA) pA1[r] = -INFINITY; } }
        if (sub != 0.f) {
#pragma unroll
            for (int r = 0; r < 16; ++r) { pA0[r] -= sub; pA1[r] -= sub; } }
        qkB_expA(pB0, pB1, pA0, pA1, la, pa, shm3 + M_LK + s * M_KSLOT, qbb, r32, hi);
        if (jb >= 0) {
#pragma unroll
            for (int r = 0; r < 16; ++r) { const int kv = kb + (r & 3) + 8 * (r >> 2); if (kv > qrelB) pB0[r] = -INFINITY; if (kv + 32 > qrelB) pB1[r] = -INFINITY; } }
        if (sub != 0.f) {
#pragma unroll
            for (int r = 0; r < 16; ++r) { pB0[r] -= sub; pB1[r] -= sub; } }
        tail_pvA_expB_pvB(pB0, pB1, lb, pa, oa, ob, vb0 + s * M_VSLOT);
    }
    store_o8(oa, la, wsf, (LAS unsigned char*)(shm3 + M_LOST) + wid * 4096, (GAS unsigned char*)O + (rowbase + q0 + wid * 64) * 1024 + 512 + h * 64, 1024, lane, r32, hi);
    store_o8(ob, lb, wsf, (LAS unsigned char*)(shm3 + M_LOST) + wid * 4096, (GAS unsigned char*)O + (rowbase + q0 + wid * 64 + 32) * 1024 + 512 + h * 64, 1024, lane, r32, hi);
    ATT_WAIT_BAR();
#undef MLA_DMA
}

constexpr int S_LK = 0, S_LV = 32768, S_LBIAS = 65536, S_LWS = S_LBIAS + 4096, S_LOST = S_LWS + 2048, S_LDS = S_LOST + 32768;
__device__ __forceinline__ void swa_unit(int b, int n, int g, const GAS bf16_t* P, GAS bf16_t* O, const GAS float* sinks, char* shm, float sbound) {
    int tid_ = threadIdx.x; asm volatile("" : "+v"(tid_));
    const int tid = tid_, lane = tid & 63, r32 = lane & 31, hi = lane >> 5; const int wid = __builtin_amdgcn_readfirstlane(tid >> 6);
    const unsigned lds0 = (unsigned)(uintptr_t)shm;
    const lds_cptr shm3 = (lds_cptr)shm;
    LAS float* wsf = (LAS float*)(shm3 + S_LWS) + wid * 64;
    const LAS float* biasl = (const LAS float*)(shm3 + S_LBIAS);
    const long kb0 = (long)b * SEQ + 128 * (n - 1);
    const int tt0 = (n == 0) ? 2 : 0;
    for (int tt = tt0; tt < 4; ++tt) {
        glds16(P + (kb0 + 64 * tt + lane) * NPROJ1 + C_KA + 64 * g + wid * 8, (unsigned)__builtin_amdgcn_readfirstlane(lds0 + S_LK + tt * 8192 + wid * 1024));
        glds16(P + (kb0 + 64 * tt + 16 * (wid & 3) + (lane >> 2)) * NPROJ1 + C_VA + 64 * g + (wid >> 2) * 32 + (lane & 3) * 8, (unsigned)__builtin_amdgcn_readfirstlane(lds0 + S_LV + tt * 8192 + wid * 1024));
    }
    const int vb0 = (int)(lds0 + S_LV) + ((lane >> 4) & 1) * 32 + (lane & 3) * 8 + (4 * hi + ((lane & 15) >> 2)) * 64;
    ATT_WAIT_BAR();
    for (int pass = 0; pass < 2; ++pass) {
        const int bq = wid + 8 * pass, hg = bq >> 2, j = bq & 3, head = 4 * g + hg;
        const long qrow0 = (long)b * SEQ + 128 * n + 32 * j;
        bf16x8 qr[4];
        { const GAS bf16_t* Qw = P + (qrow0 + r32) * NPROJ1 + C_QA + 64 * head + hi * 8;
#pragma unroll
          for (int d0 = 0; d0 < 4; ++d0) qr[d0] = *(const GAS bf16x8*)(Qw + d0 * 16); }
        const float sink2 = sinks[head] * LOG2E, mfix = __builtin_fmaxf(sbound, sink2);
        float l_reg = (hi == 0) ? __builtin_amdgcn_exp2f(sink2 - mfix) : 0.0f; f32x16 o[2]; o[0] = f32x16{}; o[1] = f32x16{}; f32x16 negm;
#pragma unroll
        for (int r = 0; r < 16; ++r) negm[r] = -mfix;
        const int ts = (j < 2) ? 0 : 1;
        for (int tt = ts; tt < ts + 3; ++tt) {
            if (tt < tt0) continue;
            f32x16 p0, p1;
            qk_tile<4>(p0, p1, shm3 + S_LK + tt * 8192, qr, negm, r32, hi);
            const int dbase = 32 * j + r32 + 128 - 64 * tt - 4 * hi;
#pragma unroll
            for (int r = 0; r < 16; ++r) { const int d0_ = dbase - ((r & 3) + 8 * (r >> 2)), d1_ = d0_ - 32;
                const float b0 = biasl[head * 128 + (d0_ & 127)], b1 = biasl[head * 128 + (d1_ & 127)];
                p0[r] = (d0_ >= 0 && d0_ < 128) ? p0[r] + b0 : -INFINITY;
                p1[r] = (d1_ >= 0 && d1_ < 128) ? p1[r] + b1 : -INFINITY; }
            softmax_pv_fixed(p0, p1, l_reg, o, vb0 + tt * 8192);
        }
        store_o8(o, l_reg, wsf, (LAS unsigned char*)(shm3 + S_LOST) + wid * 4096, (GAS unsigned char*)O + qrow0 * 1024 + 64 * head, 1024, lane, r32, hi);
    }
    ATT_WAIT_BAR();
}
}

#define XB_TMO      128
#define XB_XCNT(j)  (256  + 64 * (j))
#define XB_XSUB(j)  (1280 + 64 * (j))
#define XB_XGEN(j)  (2304 + 64 * (j))
#define XB_TOP      3328
#define XB_TOPGEN   3392
#define XCD_BAR_WORDS 3456
#define XB_SPIN_CAP (1u << 22)
__device__ __forceinline__ unsigned xb_ld(unsigned* p)              { return __hip_atomic_load(p, __ATOMIC_RELAXED, __HIP_MEMORY_SCOPE_AGENT); }
__device__ __forceinline__ unsigned xb_add(unsigned* p, unsigned v) { return __hip_atomic_fetch_add(p, v, __ATOMIC_RELAXED, __HIP_MEMORY_SCOPE_AGENT); }
__device__ __forceinline__ unsigned xb_xcc_id() { return (unsigned)__builtin_amdgcn_s_getreg((3 << 11) | 20) & 0xFu; }
#define XB_SPIN(cond, bar) do { unsigned _sp = 0; while (cond) { __builtin_amdgcn_s_sleep(1); \
    if ((++_sp & 255u) == 0u) { if (xb_ld(&(bar)[XB_TMO])) break; if (_sp > XB_SPIN_CAP) { atomicAdd(&(bar)[XB_TMO], 1u); break; } } } } while (0)
struct XcdBarrier { unsigned* bar; unsigned x; volatile LAS unsigned* st; };
__device__ __forceinline__ XcdBarrier xcd_barrier_post(unsigned* bar, volatile LAS unsigned* st) {
    XcdBarrier b; b.bar = bar; b.x = xb_xcc_id(); b.st = st;
    if (threadIdx.x == 0) (void)xb_add(&bar[XB_XCNT(b.x)], 1u);
    return b;
}
__device__ __forceinline__ void xcd_barrier_complete(unsigned* bar, unsigned x, unsigned& nloc, unsigned& nx) {
    const unsigned G = gridDim.x * gridDim.y * gridDim.z;
    unsigned sum, cnt, mine, sp = 0u;
    for (;;) {
        sum = 0u; cnt = 0u; mine = 0u;
#pragma unroll
        for (unsigned j = 0; j < 16; ++j) { const unsigned c = xb_ld(&bar[XB_XCNT(j)]); sum += c; cnt += (c > 0u) ? 1u : 0u; mine = (j == x) ? c : mine; }
        if (sum == G) break;
        __builtin_amdgcn_s_sleep(1);
        if ((++sp & 255u) == 0u) { if (xb_ld(&bar[XB_TMO])) break; if (sp > XB_SPIN_CAP) { atomicAdd(&bar[XB_TMO], 1u); break; } }
    }
    nloc = mine > 0u ? mine : 1u; nx = cnt > 0u ? cnt : 1u;
}
__device__ __forceinline__ void xcd_barrier(const XcdBarrier& b) {
    asm volatile("s_waitcnt vmcnt(0)" ::: "memory");
    __syncthreads();
    if (threadIdx.x == 0) {
        unsigned* bar = b.bar;
        __builtin_amdgcn_s_waitcnt(0);
        unsigned nloc = b.st[0], nx = b.st[1];
        if (nloc == 0u) { xcd_barrier_complete(bar, b.x, nloc, nx); b.st[0] = nloc; b.st[1] = nx; }
        const unsigned old = xb_add(&bar[XB_XSUB(b.x)], 1u);
        const unsigned gen = old / nloc;
        if (old + 1u == (gen + 1u) * nloc) {
            __builtin_amdgcn_fence(__ATOMIC_RELEASE, "agent");
            asm volatile("s_waitcnt vmcnt(0)" ::: "memory");
            const unsigned og = xb_add(&bar[XB_TOP], 1u);
            const unsigned tg = og / nx;
            if (og + 1u == (tg + 1u) * nx) xb_add(&bar[XB_TOPGEN], 1u);
            else XB_SPIN(xb_ld(&bar[XB_TOPGEN]) == tg, bar);
            __builtin_amdgcn_fence(__ATOMIC_ACQUIRE, "agent");
            xb_add(&bar[XB_XGEN(b.x)], 1u);
            asm volatile("s_waitcnt vmcnt(0)" ::: "memory");
        } else {
            XB_SPIN(xb_ld(&bar[XB_XGEN(b.x)]) == gen, bar);
            __builtin_amdgcn_fence(__ATOMIC_ACQUIRE, "agent");
            asm volatile("s_waitcnt vmcnt(0)" ::: "memory");
        }
    }
    __syncthreads();
}

enum { MAP_NAT = 0, MAP_GU = 1, MAP_ROUTER = 2 };
template <int Q8 = 0> __device__ __forceinline__ void cvt_item(const GAS float* sp, int ns, const GAS float* gain, GAS bf16_t* dst, int ldd, int k0, int n0, LAS float* scr, int lane, float qs = 1.f) {
    { float vv[32], gg[32];
#pragma unroll
      for (int i = 0; i < 32; ++i) { const int kk = 2 * i + (lane >> 5); vv[i] = sp ? sp[(size_t)(k0 + kk) * ns] : 0.f; gg[i] = gain ? gain[k0 + kk] : 1.f; }
#pragma unroll
      for (int i = 0; i < 32; ++i) { const int kk = 2 * i + (lane >> 5); scr[kk * 33 + (lane & 31)] = vv[i] * gg[i]; } }
    LDS_WAIT(); asm volatile("" ::: "memory");
    const int ch = lane & 7;
#pragma unroll
    for (int j = 0; j < 4; ++j) { const int n = (lane >> 3) + 8 * j; const LAS float* s = scr + (8 * ch) * 33 + n;
        if constexpr (Q8 == 2) { u32x2 o; o.x = pk4_fp8(s[0 * 33] * qs, s[1 * 33] * qs, s[2 * 33] * qs, s[3 * 33] * qs); o.y = pk4_fp8(s[4 * 33] * qs, s[5 * 33] * qs, s[6 * 33] * qs, s[7 * 33] * qs);
            *(GAS u32x2*)((GAS unsigned char*)dst + (size_t)(n0 + n) * ldd + k0 + 8 * ch) = o; }
        else if constexpr (Q8 == 1) { u32x2 o; o.x = pk4_i8(s[0 * 33], s[1 * 33], s[2 * 33], s[3 * 33], qs); o.y = pk4_i8(s[4 * 33], s[5 * 33], s[6 * 33], s[7 * 33], qs);
            *(GAS u32x2*)((GAS unsigned char*)dst + (size_t)(n0 + n) * ldd + k0 + 8 * ch) = o; }
        else { u32x4 o; o.x = cvt_pk_bf16(s[0 * 33], s[1 * 33]); o.y = cvt_pk_bf16(s[2 * 33], s[3 * 33]); o.z = cvt_pk_bf16(s[4 * 33], s[5 * 33]); o.w = cvt_pk_bf16(s[6 * 33], s[7 * 33]);
            *(GAS u32x4*)(dst + (size_t)(n0 + n) * ldd + k0 + 8 * ch) = o; } }
    LDS_WAIT(); asm volatile("" ::: "memory");
}
template <int Q8 = 0> __device__ __forceinline__ void cvt_nat(const GAS float* src, int Nsrc, int coff, int nvalid, const GAS float* gain, GAS bf16_t* dst, int K, int Ndst, int item, LAS float* scr, int lane, float qs = 1.f) {
    const int nblk = Ndst / 32, kb = item / nblk, nb = item % nblk, n0 = 32 * nb, np = n0 + (lane & 31);
    cvt_item<Q8>(np < nvalid ? src + coff + np : nullptr, Nsrc, gain, dst, K, 64 * kb, n0, scr, lane, qs);
}

struct Args { const GAS float* in[25]; GAS float* out; unsigned char* ws; int ph_lo, ph_hi; };
constexpr int NPH_LAYER = 15, NPHASES = 1 + 2 * NPH_LAYER;

__global__ void __launch_bounds__(512, 2) fwd(Args args) {
    extern __shared__ __attribute__((aligned(16))) unsigned char lds[];
    LAS unsigned char* L = (LAS unsigned char*)lds;
    volatile LAS unsigned* MISC = (volatile LAS unsigned*)(L + MISC_OFF);
    LAS int* pend = (LAS int*)(L + MISC_OFF + 64);
    LAS int* pcnt = (LAS int*)(L + MISC_OFF + 256);
    const int tid = threadIdx.x, lane = tid & 63, wave = __builtin_amdgcn_readfirstlane(tid >> 6);
    const int G = gridDim.x, bx = blockIdx.x;
    const int vcu = (G % 8 == 0) ? (bx % 8) * (G / 8) + bx / 8 : bx;
    const int gw = vcu * 8 + wave, NGW = G * 8;
    typedef __attribute__((address_space(4))) const unsigned long long* karg_t;
    const karg_t ka0 = (karg_t)__builtin_amdgcn_kernarg_segment_ptr();
    unsigned char* ws = (unsigned char*)ka0[26];
    unsigned* ctl = (unsigned*)(ws + WS_CTL);
    for (int u = tid; u < 256; u += 512) ((LAS unsigned*)(L + MISC_OFF))[u] = 0u;
    __syncthreads();
#if ONE_LAUNCH
    XcdBarrier bar = xcd_barrier_post(ctl + CW_BAR, MISC);
#define GRID_BAR() xcd_barrier(bar)
#else
#define GRID_BAR() do {} while (0)
#endif
    const int lo = args.ph_lo, hi = args.ph_hi;
#ifndef PHONLY
#define PHONLY -1
#endif
#define PHSEL(k) (PHONLY < 0 || (((k) == 0 ? 0 : (((k) - 1) % 15) + 1)) == PHONLY)
#define IN(k) (PHSEL(k) && lo <= (k) && (k) < hi)
#define SEAM(k) do { if (IN(k) && IN((k) + 1)) GRID_BAR(); } while (0)
#define PH_BEGIN int tid = threadIdx.x; asm volatile("" : "+v"(tid)); const int lane = tid & 63; (void)lane; karg_t ka = ka0; asm volatile("" : "+s"(ka)); unsigned char* lw = (unsigned char*)ka[26]; GAS float* out = (GAS float*)ka[25]; (void)lw; (void)out;
#define INP(k) ((const GAS float*)ka[k])
#define SSQX ((GAS float*)(lw + WS_SSQX))
#define SSQP ((GAS float*)(lw + WS_SSQP))
#define WMAXP ((GAS float*)(lw + WS_SSQP))
#define WABSV ((GAS float*)(lw + 7 * MiB))
#define XSC ((GAS float*)(lw + WS_RSMID))
#define ROPE ((GAS float*)(lw + WS_ROPE))
#define ASE ((GAS int*)(lw + WS_ASE))
#define ASP ((GAS int*)(lw + WS_ASP))
#define ASW ((GAS float*)(lw + WS_ASW))
#define MY ((GAS int*)(lw + WS_MY))
#define MW ((GAS float*)(lw + WS_MW))
#define MRS ((GAS float*)(lw + WS_MRS))
#define LOGITS ((GAS float*)(lw + WS_LOGITS))
#define PCQ ((GAS float*)(lw + WS_LOGITS))
#define PCKV ((GAS float*)(lw + WS_LOGITS + MiB))
#define PKPE ((GAS float*)(lw + WS_LOGITS + 2 * MiB))
#define XB ((GAS bf16_t*)(lw + WS_XB))
#define XB8 ((GAS unsigned char*)(lw + WS_XB8))
#define PROJ1 ((GAS bf16_t*)(lw + WS_PROJ1))
#define QB ((GAS bf16_t*)(lw + WS_QB))
#define KVB ((GAS bf16_t*)(lw + WS_KVB))
#define KB ((GAS bf16_t*)(lw + WS_KB))
#define OB ((GAS bf16_t*)(lw + WS_O))
#define GATES ((GAS bf16_t*)(lw + WS_GATES))
#define MB ((GAS bf16_t*)(lw + WS_M))
#define XM8 ((GAS unsigned char*)(lw + WS_XR))
#define TAB ((GAS int*)(lw + WS_XR + 64 * MiB))
#define ACT ((GAS bf16_t*)(lw + WS_ACT))
#define YBUF ((GAS bf16_t*)(lw + WS_YBUF))

    if (IN(0)) {
        PH_BEGIN
        {
          float mx_in0 = 0.f, mx_in1 = 0.f;
          { const int l = gw >> 10, k = gw & 1023;
            for (int rr = gw; rr < 2048; rr += NGW) { const int l2 = rr >> 10, k2 = rr & 1023; const GAS float* row = INP(2) + ((size_t)l2 * 1024 + k2) * IN_COLS; float mx = 0.f;
                for (int c = lane * 4; c < IN_COLS; c += 256) { const f32x4 q = *(const GAS f32x4*)(row + c); mx = __builtin_fmaxf(mx, __builtin_fmaxf(__builtin_fmaxf(__builtin_fabsf(q.x), __builtin_fabsf(q.y)), __builtin_fmaxf(__builtin_fabsf(q.z), __builtin_fabsf(q.w)))); }
                mx = wave_max(mx) * __builtin_fabsf(INP(1)[l2 * 1024 + k2]);
                if (l2 == 0) mx_in0 = __builtin_fmaxf(mx_in0, mx); else mx_in1 = __builtin_fmaxf(mx_in1, mx); }
            (void)l; (void)k; }
          for (int l2 = 0; l2 < 2; ++l2) { float mxw = 0.f;
            for (int r0 = gw * 4; r0 < 2 * NEXP * 1024; r0 += NGW * 4) { f32x4 q[4];
#pragma unroll
                for (int r = 0; r < 4; ++r) { const int rr = r0 + r, which = rr >> 15, ek = rr & 32767; q[r] = ((const GAS f32x4*)((which ? INP(23) : INP(22)) + ((size_t)l2 * NEXP * 1024 + ek) * 256) + lane)[0]; }
#pragma unroll
                for (int r = 0; r < 4; ++r) { const int k2 = (r0 + r) & 1023; const float g = __builtin_fabsf(INP(17)[l2 * 1024 + k2]);
                    mxw = __builtin_fmaxf(mxw, g * __builtin_fmaxf(__builtin_fmaxf(__builtin_fabsf(q[r].x), __builtin_fabsf(q[r].y)), __builtin_fmaxf(__builtin_fabsf(q[r].z), __builtin_fabsf(q[r].w)))); } }
            mxw = wave_max(mxw);
            if (lane == 0) WMAXP[(l2 * 2 + 1) * 2048 + gw] = mxw; }
          if (lane == 0) { WMAXP[0 * 2048 + gw] = mx_in0; WMAXP[2 * 2048 + gw] = mx_in1; } }
        { const GAS float* x_in = INP(0);
        for (int m0 = gw * 8; m0 < T; m0 += NGW * 8) {
            f32x4 v[8][4];
#pragma unroll
            for (int r = 0; r < 8; ++r)
#pragma unroll
                for (int j = 0; j < 4; ++j) v[r][j] = ((const GAS f32x4*)(x_in + (size_t)(m0 + r) * DM) + lane)[64 * j];
#pragma unroll
            for (int r = 0; r < 8; ++r) { float s = 0.f, mx = 0.f;
#pragma unroll
                for (int j = 0; j < 4; ++j) { const f32x4 q = v[r][j]; s += (q.x * q.x + q.y * q.y) + (q.z * q.z + q.w * q.w);
                    mx = __builtin_fmaxf(mx, __builtin_fmaxf(__builtin_fmaxf(__builtin_fabsf(q.x), __builtin_fabsf(q.y)), __builtin_fmaxf(__builtin_fabsf(q.z), __builtin_fabsf(q.w))));
                    }
                s = wave_sum(s); mx = wave_max(mx); mx = mx > 0.f ? mx : 1.f; const float qs = 127.0f / mx;
#pragma unroll
                for (int j = 0; j < 4; ++j) { const f32x4 q = v[r][j]; ((GAS unsigned*)(XB8 + (size_t)(m0 + r) * DM) + lane)[64 * j] = pk4_i8(q.x, q.y, q.z, q.w, qs); }
                if (lane == 0) { SSQX[m0 + r] = s; XSC[m0 + r] = mx * (1.0f / 127.0f); } }
        } }
        for (int e = bx * 512 + tid; e < SEQ * 16; e += G * 512) { const int pos = e >> 4, i = e & 15;
            const int i4 = i & 3; const double m4 = (i4 == 0) ? 1.0 : (i4 == 1) ? 0.5623413251903491 : (i4 == 2) ? 0.31622776601683794 : 0.1778279410038923;
            const int i16 = i >> 2; const double d4 = (i16 == 0) ? 1.0 : (i16 == 1) ? 0.1 : (i16 == 2) ? 0.01 : 0.001;
            const float ang = (float)pos * (float)(m4 * d4);
            double rev = (double)ang * 0.15915494309189535; rev -= __builtin_rint(rev); const float fr_ = (float)rev;
            ROPE[pos * 32 + i] = __builtin_amdgcn_cosf(fr_); ROPE[pos * 32 + 16 + i] = __builtin_amdgcn_sinf(fr_); }
            GRID_BAR();
        float wabs[4];
#pragma unroll
        for (int q = 0; q < 4; ++q) { float m = 0.f; for (int i = lane; i < NGW; i += 64) m = __builtin_fmaxf(m, WMAXP[q * 2048 + i]); m = wave_max(m); wabs[q] = m > 0.f ? m : 1.f; }
        if (bx == 0 && tid == 0) { WABSV[0] = wabs[0]; WABSV[1] = wabs[1]; WABSV[2] = wabs[2]; WABSV[3] = wabs[3]; }
#define WDQ(l_, t_) (WABSV[2 * (l_) + (t_)] * (1.0f / 127.0f))
#define WQS(l_, t_) (127.0f / wabs[2 * (l_) + (t_)])
        const float qs_in0 = WQS(0, 0), qs_in1 = WQS(1, 0), qs_gu0 = WQS(0, 1), qs_gu1 = WQS(1, 1);
        LAS float* scr = (LAS float*)(L + wave * 16384);
        constexpr int I_WIN1 = 16 * 40, I_WG = 16 * 64, I_WQB = 4 * 24, I_WKVB = 2 * 32, I_WOA = 8 * 32, I_WO = 16 * 32, I_WR = 16 * 8, I_WGU = 32 * 16 * 16, I_WD = 32 * 4 * 32;
        constexpr int NIT = I_WIN1 + I_WG + I_WQB + I_WKVB + 2 * I_WOA + I_WO + I_WR + I_WGU + I_WD;
        for (int it = gw; it < 2 * NIT; it += NGW) {
            const int l = it >= NIT ? 1 : 0; int r = it - l * NIT;
            if (r < I_WIN1) {
                const int kb = r / 40, nb = r % 40, n0 = 32 * nb, np = n0 + (lane & 31);
                int sc_ = np; if (np < 768) { const int pn = np >> 8, q = np & 255; sc_ = 64 * (4 * pn + ((q >> 5) & 3)) + 32 * (q >> 7) + (q & 31); }
                cvt_item<1>(np < C_GATE ? INP(2) + (size_t)l * 1024 * IN_COLS + sc_ : nullptr, IN_COLS, INP(1) + l * 1024, (GAS bf16_t*)(lw + WS_WIN1 + (size_t)l * 1280 * 1024), 1024, 64 * kb, n0, scr, lane, (l ? qs_in1 : qs_in0)); continue; } r -= I_WIN1;
            if (r < I_WG) {
                const int kb = r / 64, nb = r % 64, n0 = 32 * nb, np = n0 + (lane & 31);
                const int q = np >> 8, p = np & 255, cc = 128 * q + (p & 127) + ((p >> 7) ? 1024 : 0);
                cvt_item<1>(INP(2) + (size_t)l * 1024 * IN_COLS + C_GATE + cc, IN_COLS, INP(1) + l * 1024, (GAS bf16_t*)(lw + WS_WG + (size_t)l * 2048 * 1024), 1024, 64 * kb, n0, scr, lane, (l ? qs_in1 : qs_in0)); continue; } r -= I_WG;
            if (r < I_WQB) { const int kb = r / 24, nb = r % 24, n0 = 32 * nb;
                cvt_item(INP(10) + (size_t)l * 256 * 768 + pg8::col16_src(n0 + (lane & 31)), 768, INP(9) + l * 256, (GAS bf16_t*)(lw + WS_WQB) + (size_t)l * 768 * 256, 256, 64 * kb, n0, scr, lane); continue; } r -= I_WQB;
            if (r < I_WKVB) {
                const int kb = r / 32, nb = r % 32, n0 = 32 * nb, np = n0 + (lane & 31);
                const int pn = np >> 8, q = np & 255, wc_ = (q >> 5) & 3; const int sc_ = 128 * (2 * pn + (wc_ & 1)) + 64 * (wc_ >> 1) + 32 * (q >> 7) + (q & 31);
                cvt_item(INP(12) + (size_t)l * 128 * 1024 + sc_, 1024, INP(11) + l * 128, (GAS bf16_t*)(lw + WS_WKVB) + (size_t)l * 1024 * 128, 128, 64 * kb, n0, scr, lane); continue; } r -= I_WKVB;
            if (r < 2 * I_WOA) {
                const int half = r >= I_WOA, r2 = r - half * I_WOA, kb = r2 / 32, nb = r2 % 32, n0 = 32 * nb;
                cvt_item<2>((half ? INP(15) : INP(8)) + (size_t)l * 512 * 1024 + pg8::col16_src(n0 + (lane & 31)), 1024, nullptr, (GAS bf16_t*)(lw + WS_WOA + (size_t)l * 1024 * 1024 + half * 512), 1024, 64 * kb, n0, scr, lane, W8S); continue; } r -= 2 * I_WOA;
            if (r < I_WO) { const int kb = r / 32, nb = r % 32, n0 = 32 * nb;
                cvt_item<2>(INP(16) + (size_t)l * 1024 * 1024 + pg8::col16_src(n0 + (lane & 31)), 1024, nullptr, (GAS bf16_t*)(lw + WS_WO + (size_t)l * 1024 * 1024), 1024, 64 * kb, n0, scr, lane, W8S); continue; } r -= I_WO;
            if (r < I_WR) {
                const int kb = r / 8, nb = r % 8, n0 = 32 * nb, np = n0 + (lane & 31);
                const GAS float* sp = nullptr; int ns = 32;
                if (np < 32) { sp = INP(20) + (size_t)l * 1024 * 32 + np; ns = 32; } else if (np < 36) { sp = INP(18) + (size_t)l * 1024 * 4 + (np - 32); ns = 4; }
                cvt_item(sp, ns, INP(17) + l * 1024, (GAS bf16_t*)(lw + WS_WR) + (size_t)l * 256 * 1024, 1024, 64 * kb, n0, scr, lane); continue; } r -= I_WR;
            if (r < I_WGU) {
                const int e = r / 256, r2 = r % 256, kb = r2 / 16, nb = r2 % 16, n0 = 32 * nb, np = n0 + (lane & 31);
                const int pn = np >> 8, q = np & 255, n = q >> 7;
                const int cc = 128 * pn + (q & 127);
                const GAS float* sp = (n ? INP(23) : INP(22)) + ((size_t)l * NEXP + e) * 1024 * 256 + cc;
                cvt_item<1>(sp, 256, INP(17) + l * 1024, (GAS bf16_t*)(lw + WS_WGU + ((size_t)l * NEXP + e) * 512 * 1024), 1024, 64 * kb, n0, scr, lane, (l ? qs_gu1 : qs_gu0)); continue; } r -= I_WGU;
            { const int e = r / 128, it2 = r % 128, kb = it2 / 32, nb = it2 % 32, n0 = 32 * nb;
              cvt_item(INP(24) + ((size_t)l * NEXP + e) * 256 * 1024 + pg8::col16_src(n0 + (lane & 31)), 1024, nullptr, (GAS bf16_t*)(lw + WS_WD) + ((size_t)l * NEXP + e) * 1024 * 256, 256, 64 * kb, n0, scr, lane); }
        }
    }
    SEAM(0);

    for (int l = 0; l < 2; ++l) {
        const int pb = 1 + NPH_LAYER * l;
        if (IN(pb + 0)) { PH_BEGIN
            pg8::Gemm g{(const GAS bf16_t*)XB8, (const GAS bf16_t*)(lw + WS_WIN1 + (size_t)l * 1280 * 1024), 512, 512, 512}; pg8::StaticOrder S; S.init(T, NPROJ1, G, bx);
            pg8::EpiProj1 E{PROJ1, SSQX, XSC, WDQ(l, 0), INP(4) + l * 64, INP(5) + l * 64, PCQ, PCKV, PKPE};
            pg8::gemm_phase<pg8::EpiProj1, pg8::StaticOrder, true>(L, g, S, E);
        }
        SEAM(pb + 0);
        if (IN(pb + 2)) { PH_BEGIN
            { pg8::Gemm g{PROJ1 + C_CQ, (const GAS bf16_t*)(lw + WS_WQB) + (size_t)l * 768 * 256, NPROJ1, 256, 256}; pg8::StaticOrder S; S.init(T, 768, G, bx);
              pg8::EpiRowNorm4 E{(GAS unsigned char*)QB, 768, PCQ, 1.0f / 256.0f};
              pg8::gemm_phase<pg8::EpiRowNorm4, pg8::StaticOrder>(L, g, S, E); }
            { pg8::Gemm g{PROJ1 + C_CKV, (const GAS bf16_t*)(lw + WS_WKVB) + (size_t)l * 1024 * 128, NPROJ1, 128, 128}; pg8::StaticOrder S; S.init(T, 1024, G, bx);
              pg8::EpiKv E{KB, KVB, PCKV, PKPE, PROJ1, INP(14) + l * 96, ROPE};
              pg8::gemm_phase<pg8::EpiKv, pg8::StaticOrder>(L, g, S, E); }
        }
        SEAM(pb + 2);
        if (IN(pb + 4)) { PH_BEGIN
            char* shm = (char*)lds;
            float mfixB, sboundA;
            { const GAS float* gq = INP(13) + l * 96; const GAS float* gk = INP(14) + l * 96; float a = 0.f, c = 0.f;
              for (int i = lane; i < 96; i += 64) { a = __builtin_fmaxf(a, __builtin_fabsf(gq[i])); c = __builtin_fmaxf(c, __builtin_fabsf(gk[i])); }
              a = wave_max(a); c = wave_max(c); mfixB = __uint_as_float(__builtin_amdgcn_readfirstlane(__float_as_uint(__builtin_fminf(96.0f * C2B * a * c + 0.5f, 60.0f)))); }
            { const GAS float* gq = INP(4) + l * 64; const GAS float* gk = INP(5) + l * 64; const GAS float* rel = INP(7);
              float a = __builtin_fabsf(gq[lane]), c = __builtin_fabsf(gk[lane]), bm = 0.f;
              for (int i = lane; i < 256; i += 64) bm = __builtin_fmaxf(bm, __builtin_fabsf(rel[i]));
              a = wave_max(a); c = wave_max(c); bm = wave_max(bm); sboundA = __uint_as_float(__builtin_amdgcn_readfirstlane(__float_as_uint(__builtin_fminf(64.0f * C2A * a * c + bm * LOG2E + 0.5f, 60.0f)))); }
            for (int v = vcu; v < 256; v += G) {
                const int bh = v >> 1, s0 = 2 * (v & 1);
                for (int i = 0; i < 4; ++i) { const int s = s0 + (i >> 1), qb = (i & 1) ? 7 - s : s; att::mla_unit(bh >> 3, bh & 7, qb, QB, KB, KVB, OB, shm, mfixB, INP(13) + l * 96, ROPE); }
            }
            { LAS float* biasl = (LAS float*)(L + att::S_LBIAS); const GAS float* rel = INP(7);
              for (int e = tid; e < 8 * 128; e += 512) { const int hd = e >> 7, d = e & 127; int bk = d;
                  if (d >= 16) { bk = 16 + (int)(__logf((float)d * (1.0f / 16.0f)) / 2.0794415416798357f * 16.0f); bk = bk > 31 ? 31 : bk; }
                  biasl[e] = rel[bk * 8 + hd] * LOG2E; }
              __syncthreads(); }
            for (int u = vcu; u < NB * 32 * 2; u += G) { const int g2 = u & 1, n = (u >> 1) & 31, b = u >> 6; att::swa_unit(b, n, g2, PROJ1, OB, INP(6) + l * 8, shm, sboundA); }
        }
        SEAM(pb + 4);
        if (IN(pb + 5)) { PH_BEGIN
            pg8::Gemm g{(const GAS bf16_t*)XB8, (const GAS bf16_t*)(lw + WS_WG + (size_t)l * 2048 * 1024), 512, 512, 512}; pg8::StaticOrder S; S.init(T, 2048, G, bx);
            pg8::EpiGates2 E{GATES, GATES + (size_t)T * 1024, SSQX, INP(3) + l * 2048, XSC, WDQ(l, 0)};
            pg8::gemm_phase<pg8::EpiGates2, pg8::StaticOrder, true>(L, g, S, E);
        }
        SEAM(pb + 5);
        if (IN(pb + 6)) { PH_BEGIN
            pg8::Gemm g{OB, (const GAS bf16_t*)(lw + WS_WOA + (size_t)l * 1024 * 1024), 512, 512, 512}; pg8::StaticOrder S; S.init(T, 1024, G, bx);
            pg8::EpiMerge E{MB, GATES, GATES + (size_t)T * 1024};
            pg8::gemm_phase<pg8::EpiMerge, pg8::StaticOrder, false, true, true>(L, g, S, E);
        }
        SEAM(pb + 6);
        if (IN(pb + 7)) { PH_BEGIN
            pg8::Gemm g{MB, (const GAS bf16_t*)(lw + WS_WO + (size_t)l * 1024 * 1024), 512, 512, 512}; pg8::StaticOrder S; S.init(T, 1024, G, bx);
            pg8::EpiResid E{(l == 0) ? INP(0) : (const GAS float*)nullptr, XB, SSQP};
            pg8::gemm_phase<pg8::EpiResid, pg8::StaticOrder, false, false, true>(L, g, S, E);
        }
        SEAM(pb + 7);
        if (IN(pb + 9)) { PH_BEGIN
            pg8::Gemm g{XB, (const GAS bf16_t*)(lw + WS_WR) + (size_t)l * 256 * 1024, 1024, 1024, 1024}; pg8::StaticOrder S; S.init(T, 256, G, bx);
            pg8::EpiLogits E{LOGITS, SSQP};
            pg8::gemm_phase<pg8::EpiLogits, pg8::StaticOrder>(L, g, S, E);
            VM_WAIT(); __syncthreads();
            LAS int* cnt = (LAS int*)L; LAS int* basep = cnt + 32;
            const GAS float* brg = INP(19) + l * 4; const GAS float* bre = INP(21) + l * 32;
            GAS unsigned* gcnt = (GAS unsigned*)(lw + WS_CTL) + CW_CNT + 64 * l;
            pg8::Unit ru;
            LAS float* rsc = (LAS float*)(L + 4096);
            for (int iu = 0; S.next(iu, ru); ++iu) {
                if (tid < 32) cnt[tid] = 0;
                {
                    const int wv = tid >> 6;
                    for (int rr = 0; rr < 32; rr += 4) { u32x4 v0[4], v1[4]; float rsm[4];
#pragma unroll
                        for (int r = 0; r < 4; ++r) { const int t = ru.pm * 256 + wv * 32 + rr + r; const GAS u32x4* s = (const GAS u32x4*)(XB + (size_t)t * DM) + lane; v0[r] = s[0]; v1[r] = s[64];
                            const GAS f32x4* pp = (const GAS f32x4*)(SSQP + (size_t)t * 16); const f32x4 a = pp[0], b = pp[1], c = pp[2], d = pp[3];
                            rsm[r] = __builtin_amdgcn_rsqf((((a.x + a.y) + (a.z + a.w)) + ((b.x + b.y) + (b.z + b.w)) + ((c.x + c.y) + (c.z + c.w)) + ((d.x + d.y) + (d.z + d.w))) * (1.0f / 1024.0f) + EPS); }
#pragma unroll
                        for (int r = 0; r < 4; ++r) { const int t = ru.pm * 256 + wv * 32 + rr + r; const u32x4 a = v0[r], b = v1[r];
                            const float f[16] = {bflo(a.x), bfhi(a.x), bflo(a.y), bfhi(a.y), bflo(a.z), bfhi(a.z), bflo(a.w), bfhi(a.w), bflo(b.x), bfhi(b.x), bflo(b.y), bfhi(b.y), bflo(b.z), bfhi(b.z), bflo(b.w), bfhi(b.w)};
                            float mx = 0.f;
#pragma unroll
                            for (int i = 0; i < 16; ++i) mx = __builtin_fmaxf(mx, __builtin_fabsf(f[i]));
                            mx = wave_max(mx); mx = mx > 0.f ? mx : 1.f; const float qs = 127.0f / mx;
                            u32x2 q0, q1; q0.x = pk4_i8(f[0], f[1], f[2], f[3], qs); q0.y = pk4_i8(f[4], f[5], f[6], f[7], qs); q1.x = pk4_i8(f[8], f[9], f[10], f[11], qs); q1.y = pk4_i8(f[12], f[13], f[14], f[15], qs);
                            { GAS u32x2* d = (GAS u32x2*)(XM8 + (size_t)t * DM) + lane; d[0] = q0; d[64] = q1; }
                            if (lane == 0) rsc[wv * 32 + rr + r] = rsm[r] * mx * (1.0f / 127.0f); } }
                }
                __syncthreads();
                const bool act = tid < 256; const int t = ru.pm * 256 + (tid & 255); const GAS float* lg = LOGITS + (size_t)t * 64;
                float gl[4]; float gmx = -INFINITY; int gi = 0;
#pragma unroll
                for (int q = 0; q < 4; ++q) { gl[q] = lg[32 + q] + brg[q]; if (gl[q] > gmx) { gmx = gl[q]; gi = q; } }
                float gs = 0.f;
#pragma unroll
                for (int q = 0; q < 4; ++q) gs += __expf(gl[q] - gmx);
                const float gp = 1.0f / gs;
                float el[8]; float e0 = -INFINITY; int i0 = 0;
#pragma unroll
                for (int q = 0; q < 8; ++q) { el[q] = lg[8 * gi + q] + bre[8 * gi + q]; if (el[q] > e0) { e0 = el[q]; i0 = q; } }
                float e1 = -INFINITY; int i1 = 0;
#pragma unroll
                for (int q = 0; q < 8; ++q) if (q != i0 && el[q] > e1) { e1 = el[q]; i1 = q; }
                const float w1 = 1.0f / (1.0f + __expf(e0 - e1)), w0 = 1.0f - w1;
                const int ex0 = 8 * gi + i0, ex1 = 8 * gi + i1;
                int r0 = 0, r1 = 0;
                if (act) { r0 = __hip_atomic_fetch_add(&cnt[ex0], 1, __ATOMIC_RELAXED, __HIP_MEMORY_SCOPE_WORKGROUP); r1 = __hip_atomic_fetch_add(&cnt[ex1], 1, __ATOMIC_RELAXED, __HIP_MEMORY_SCOPE_WORKGROUP); }
                __syncthreads();
                if (tid < 32) basep[tid] = (int)__hip_atomic_fetch_add(gcnt + tid, (unsigned)cnt[tid], __ATOMIC_RELAXED, __HIP_MEMORY_SCOPE_AGENT);
                __syncthreads();
                if (act) { const unsigned sb = __float_as_uint(rsc[tid]);
                    *(GAS u32x4*)(TAB + (size_t)(ex0 * MOE_CAP + basep[ex0] + r0) * 4) = (u32x4){(unsigned)t, sb, (unsigned)(2 * t), __float_as_uint(gp * w0)};
                    *(GAS u32x4*)(TAB + (size_t)(ex1 * MOE_CAP + basep[ex1] + r1) * 4) = (u32x4){(unsigned)t, sb, (unsigned)(2 * t + 1), __float_as_uint(gp * w1)}; }
                __syncthreads();
            }
        }
        SEAM(pb + 10);
        if (IN(pb + 12) || IN(pb + 13)) {
            PH_BEGIN
            if (tid == 0) { const GAS unsigned* gcnt = (const GAS unsigned*)(lw + WS_CTL) + CW_CNT + 64 * l; int acc = 0;
                for (int e = 0; e < NEXP; ++e) { const int c = (int)__hip_atomic_load(gcnt + e, __ATOMIC_RELAXED, __HIP_MEMORY_SCOPE_AGENT); acc += (c + 255) >> 8; pend[e] = acc; pcnt[e] = c; } }
            __syncthreads();
        }
        if (IN(pb + 12)) { PH_BEGIN
            pg8::Gemm g{(const GAS bf16_t*)XM8, (const GAS bf16_t*)(lw + WS_WGU + (size_t)l * NEXP * 512 * 1024), 512, 512, 512};
            pg8::MoeGather S{pend[NEXP - 1] * 2, 2, G, bx, pend, (size_t)512 * 1024, TAB, pcnt};
            pg8::EpiGateUp E{ACT, (const GAS float*)TAB, pend, pcnt, WDQ(l, 1)};
            pg8::gemm_phase<pg8::EpiGateUp, pg8::MoeGather, true>(L, g, S, E);
        }
        SEAM(pb + 12);
        if (IN(pb + 13)) { PH_BEGIN
            pg8::Gemm g{ACT, (const GAS bf16_t*)(lw + WS_WD) + (size_t)l * NEXP * 1024 * 256, 256, 256, 256};
            pg8::MoeOrder S{pend[NEXP - 1] * 4, 4, G, bx, pend, (size_t)1024 * 256 * 2, TAB, pcnt};
            pg8::EpiDown E{YBUF, TAB, pend, pcnt};
            pg8::gemm_phase<pg8::EpiDown, pg8::MoeOrder>(L, g, S, E);
        }
        SEAM(pb + 13);
        if (IN(pb + 14)) { PH_BEGIN
            for (int m0 = gw * 4; m0 < T; m0 += NGW * 4) {
                u32x2 xm[4][4]; unsigned ya[4][4], yb[4][4]; f32x4 xv[4][4];
#pragma unroll
                for (int r = 0; r < 4; ++r) { const int m = m0 + r;
#pragma unroll
                    for (int j = 0; j < 4; ++j) { xm[r][j] = ((const GAS u32x2*)(XB + (size_t)m * DM) + lane)[64 * j];
                        ya[r][j] = ((const GAS unsigned*)((const GAS unsigned char*)YBUF + (size_t)(2 * m) * DM) + lane)[64 * j]; yb[r][j] = ((const GAS unsigned*)((const GAS unsigned char*)YBUF + (size_t)(2 * m + 1) * DM) + lane)[64 * j]; } }
#pragma unroll
                for (int r = 0; r < 4; ++r) { const int m = m0 + r; float s = 0.f, mx = 0.f;
#pragma unroll
                    for (int j = 0; j < 4; ++j) { const u32x2 x = xm[r][j]; const int a = (int)ya[r][j], b = (int)yb[r][j]; f32x4 v;
                        v.x = bflo(x.x) + (__builtin_amdgcn_cvt_f32_fp8(a, 0) + __builtin_amdgcn_cvt_f32_fp8(b, 0)) * Y8I; v.y = bfhi(x.x) + (__builtin_amdgcn_cvt_f32_fp8(a, 1) + __builtin_amdgcn_cvt_f32_fp8(b, 1)) * Y8I;
                        v.z = bflo(x.y) + (__builtin_amdgcn_cvt_f32_fp8(a, 2) + __builtin_amdgcn_cvt_f32_fp8(b, 2)) * Y8I; v.w = bfhi(x.y) + (__builtin_amdgcn_cvt_f32_fp8(a, 3) + __builtin_amdgcn_cvt_f32_fp8(b, 3)) * Y8I; xv[r][j] = v;
                        if (l == 1) ((GAS f32x4*)(out + (size_t)m * DM) + lane)[64 * j] = v;
                        else { u32x2 w; w.x = cvt_pk_bf16(v.x, v.y); w.y = cvt_pk_bf16(v.z, v.w); ((GAS u32x2*)(XB + (size_t)m * DM) + lane)[64 * j] = w; }
                        s += (v.x * v.x + v.y * v.y) + (v.z * v.z + v.w * v.w);
                        mx = __builtin_fmaxf(mx, __builtin_fmaxf(__builtin_fmaxf(__builtin_fabsf(v.x), __builtin_fabsf(v.y)), __builtin_fmaxf(__builtin_fabsf(v.z), __builtin_fabsf(v.w)))); }
                    if (l == 0) {
                    s = wave_sum(s); mx = wave_max(mx); mx = mx > 0.f ? mx : 1.f; const float qs = 127.0f / mx;
#pragma unroll
                    for (int j = 0; j < 4; ++j) { const f32x4 v = xv[r][j]; ((GAS unsigned*)(XB8 + (size_t)m * DM) + lane)[64 * j] = pk4_i8(v.x, v.y, v.z, v.w, qs); }
                    if (lane == 0) { SSQX[m] = s; XSC[m] = mx * (1.0f / 127.0f); } } }
            }
        }
        SEAM(pb + 14);
    }
}

extern "C" void kernel_launch(void* const* d_in, const GAS int* in_sizes, int n_in, void* d_out, int out_size, void* d_ws, size_t ws_size, hipStream_t stream) {
    static int grid = 0;
    if (grid == 0) {
        if (n_in != 25 || in_sizes[0] != T * DM || out_size != T * DM || ws_size < WS_END) { fprintf(stderr, "kernel_launch: unexpected shapes / workspace (%d inputs, ws %zu)\n", n_in, ws_size); grid = -1; return; }
        int dev = 0, cus = 0, per_cu = 0;
        if (hipGetDevice(&dev) != hipSuccess || hipDeviceGetAttribute(&cus, hipDeviceAttributeMultiprocessorCount, dev) != hipSuccess) { grid = -1; return; }
        if (hipFuncSetAttribute((const void*)fwd, hipFuncAttributeMaxDynamicSharedMemorySize, LDS_BYTES) != hipSuccess) { fprintf(stderr, "kernel_launch: hipFuncSetAttribute failed\n"); grid = -1; return; }
        if (hipOccupancyMaxActiveBlocksPerMultiprocessor(&per_cu, (const void*)fwd, 512, LDS_BYTES) != hipSuccess || per_cu < 1) fprintf(stderr, "kernel_launch: occupancy query reports %d\n", per_cu);
        (void)hipGetLastError();
        grid = cus;
    }
    if (grid < 0) return;
    if (hipMemsetAsync((char*)d_ws + WS_CTL, 0, CTL_ZERO_BYTES, stream) != hipSuccess) return;
    Args a{};
    for (int i = 0; i < 25; ++i) a.in[i] = (const GAS float*)d_in[i];
    a.out = (GAS float*)d_out; a.ws = (unsigned char*)d_ws;
#if ONE_LAUNCH
    a.ph_lo = 0; a.ph_hi = NPHASES;
    hipLaunchKernelGGL(fwd, dim3(grid), dim3(512), LDS_BYTES, stream, a);
#else
    for (int ph = 0; ph < NPHASES; ++ph) { a.ph_lo = ph; a.ph_hi = ph + 1; hipLaunchKernelGGL(fwd, dim3(grid), dim3(512), LDS_BYTES, stream, a); }
#endif
}
```

```cpp
#include <hip/hip_runtime.h>
#include <cstdio>
#include <cstdint>

#ifndef ONE_LAUNCH
#define ONE_LAUNCH 1
#endif

#define GAS __attribute__((address_space(1)))
#define LAS __attribute__((address_space(3)))
typedef unsigned short bf16_t;
typedef short bf16x8 __attribute__((ext_vector_type(8)));
typedef short s16x4 __attribute__((ext_vector_type(4)));
typedef float f32x4 __attribute__((ext_vector_type(4)));
typedef float f32x2 __attribute__((ext_vector_type(2)));
typedef float f32x16 __attribute__((ext_vector_type(16)));
typedef unsigned u32x4 __attribute__((ext_vector_type(4)));
typedef unsigned u32x2 __attribute__((ext_vector_type(2)));

constexpr int T = 65536, DM = 1024, SEQ = 4096, NB = 16;
constexpr int NPROJ1 = 1280;
constexpr int C_QA = 0, C_KA = 512, C_VA = 640, C_CQ = 768, C_CKV = 1024, C_KPE = 1152, C_GATE = 1184, IN_COLS = 3232;
constexpr int NEXP = 32, DEXP = 256;
constexpr int MOE_CAP = 65536;
constexpr float W8S = 32.0f, W8I = 1.0f / 32.0f;
constexpr int A_PAD = 2 * T + NEXP * 256;
constexpr float EPS = 1e-6f;
constexpr float LOG2E = 1.4426950408889634f;
constexpr float Y8S = 16.0f, Y8I = 1.0f / 16.0f;
constexpr float C2A = 0.125f * LOG2E;
constexpr float C2B = 0.10206207261596575f * LOG2E;

constexpr size_t MiB = 1u << 20;
constexpr size_t WS_CTL = 0, CTL_ZERO_BYTES = 2 * MiB;
constexpr size_t WS_SSQX = 2 * MiB;
constexpr size_t WS_RSMID = WS_SSQX + 256 * 1024;
constexpr size_t WS_ROPE = WS_RSMID + 256 * 1024;
constexpr size_t WS_ASE = 3 * MiB, WS_ASP = WS_ASE + 512 * 1024, WS_ASW = WS_ASP + 512 * 1024;
constexpr size_t WS_MY = WS_ASW + 512 * 1024, WS_MW = WS_MY + 768 * 1024, WS_MRS = WS_MW + 768 * 1024;
constexpr size_t WS_LOGITS = 8 * MiB;
constexpr size_t WS_WIN1 = 24 * MiB;
constexpr size_t WS_WG = 29 * MiB;
constexpr size_t WS_WQB = 37 * MiB;
constexpr size_t WS_WKVB = WS_WQB + 768 * 1024;
constexpr size_t WS_WOA = WS_WKVB + 768 * 1024;
constexpr size_t WS_WOB = WS_WOA + 2 * MiB;
constexpr size_t WS_WO = WS_WOB + 2 * MiB;
constexpr size_t WS_WR = WS_WO + 4 * MiB;
constexpr size_t WS_WGU = 48 * MiB;
constexpr size_t WS_WD = 112 * MiB;
constexpr size_t WS_XB = 144 * MiB;
constexpr size_t WS_PROJ1 = 272 * MiB;
constexpr size_t WS_QB = 432 * MiB;
constexpr size_t WS_KVB = 528 * MiB;
constexpr size_t WS_KB = 656 * MiB;
constexpr size_t WS_O = 752 * MiB;
constexpr size_t WS_GATES = 432 * MiB;
constexpr size_t WS_M = 272 * MiB;
constexpr size_t WS_XR = 272 * MiB;
constexpr size_t WS_ACT = 544 * MiB;
constexpr size_t WS_YBUF = 612 * MiB;
constexpr size_t WS_SSQP = 880 * MiB;
constexpr size_t WS_XB8 = 884 * MiB;
constexpr size_t WS_END = 948 * MiB;
static_assert(WS_MRS + 768 * 1024 <= WS_LOGITS && WS_LOGITS + (size_t)T * 64 * 4 <= WS_WIN1, "ws map");
static_assert(WS_WR + 1 * MiB <= WS_WGU && WS_WD + 32 * MiB <= WS_XB, "ws map");
static_assert(WS_XR + (size_t)A_PAD * 1024 * 2 <= WS_ACT && WS_ACT + (size_t)A_PAD * 256 * 2 <= WS_YBUF && WS_YBUF + (size_t)2 * T * 1024 * 2 <= WS_END, "ws map");

constexpr int CW_BAR = 4096;
constexpr int CW_WMAX = 20480;
constexpr int CW_CNT = 16384;

constexpr int RING_BYTES = 131072;
constexpr int MISC_OFF = RING_BYTES;
constexpr int LDS_BYTES = 147456;

#define LDS_WAIT() asm volatile("s_waitcnt lgkmcnt(0)" ::: "memory")
#define VM_WAIT() asm volatile("s_waitcnt vmcnt(0)" ::: "memory")

typedef float f32x2_cv __attribute__((ext_vector_type(2))); typedef __bf16 bf16x2_cv __attribute__((ext_vector_type(2)));
__device__ __forceinline__ unsigned cvt_pk_bf16(float lo, float hi) { const f32x2_cv v = {lo, hi}; const bf16x2_cv b = __builtin_convertvector(v, bf16x2_cv); return __builtin_bit_cast(unsigned, b); }
__device__ __forceinline__ unsigned pk4_i8(float a, float b, float c, float d, float s) {
    int q0 = (int)__builtin_rintf(a * s), q1 = (int)__builtin_rintf(b * s), q2 = (int)__builtin_rintf(c * s), q3 = (int)__builtin_rintf(d * s);
    q0 = q0 < -127 ? -127 : (q0 > 127 ? 127 : q0); q1 = q1 < -127 ? -127 : (q1 > 127 ? 127 : q1); q2 = q2 < -127 ? -127 : (q2 > 127 ? 127 : q2); q3 = q3 < -127 ? -127 : (q3 > 127 ? 127 : q3);
    return (unsigned)(q0 & 255) | ((unsigned)(q1 & 255) << 8) | ((unsigned)(q2 & 255) << 16) | ((unsigned)q3 << 24); }
__device__ __forceinline__ float wave_max(float v) {
#pragma unroll
    for (int o = 1; o < 64; o <<= 1) v = __builtin_fmaxf(v, __shfl_xor(v, o));
    return v;
}
__device__ __forceinline__ unsigned pk4_fp8(float a, float b, float c, float d) { int p = __builtin_amdgcn_cvt_pk_fp8_f32(a, b, 0, false); p = __builtin_amdgcn_cvt_pk_fp8_f32(c, d, p, true); return (unsigned)p; }
__device__ __forceinline__ float bflo(unsigned u) { return __uint_as_float(u << 16); }
__device__ __forceinline__ float bfhi(unsigned u) { return __uint_as_float(u & 0xffff0000u); }
__device__ __forceinline__ float bf1(bf16_t h) { return __uint_as_float((unsigned)h << 16); }
__device__ __forceinline__ float wave_sum(float v) {
#pragma unroll
    for (int o = 1; o < 64; o <<= 1) v += __shfl_xor(v, o);
    return v;
}
__device__ __forceinline__ float fsigmoid(float v) { return __builtin_amdgcn_rcpf(1.0f + __builtin_amdgcn_exp2f(-v * LOG2E)); }

namespace pg8 {
constexpr int BM = 256, BK = 64, HALF = 128, HTB = HALF * BK * 2, STAGE_BYTES = 8 * HTB, NXCD = 8, WGM = 8;
__host__ __device__ __forceinline__ int lds_byte(int r, int c) { const int st = (r >> 4) * 2 + (c >> 5), rr = r & 15, cc = c & 31, ob = rr * 64 + cc * 2; return st * 1024 + (ob ^ (((ob >> 9) & 1) << 5)); }
__host__ __device__ __forceinline__ void stage_rc(int b, int& R, int& C) { const int st = b / 1024, sb = b % 1024, swz = sb ^ (((sb >> 9) & 1) << 5); R = (st >> 1) * 16 + swz / 64; C = (st & 1) * 32 + (swz % 64) / 2; }
__host__ __device__ __forceinline__ int perm32(int rho) { const int n = rho >> 4, i = rho & 15; return 8 * (i >> 2) + 4 * n + (i & 3); }

struct Unit { int pm, pn; };
struct Gemm { const GAS bf16_t* A; const GAS bf16_t* Bt; int lda, ldb, K; };

struct StaticOrder {
    static constexpr bool GATHER = false;
    int nM, nN, nwg, G, c;
    __device__ void init(int M, int N, int G_, int c_) { nM = M / BM; nN = N / BM; nwg = nM * nN; G = G_; c = c_; }
    __device__ __forceinline__ bool next(int i, Unit& u) const {
        const long L = (long)i * G + c; if (L >= nwg) return false;
        int wgid = (int)L; { const int q = nwg / NXCD, r = nwg % NXCD, xcd = wgid % NXCD, off = wgid / NXCD; wgid = (xcd < r ? xcd * (q + 1) : r * (q + 1) + (xcd - r) * q) + off; }
        const int nig = WGM * nN, gid = wgid / nig, fm = gid * WGM, gsz = (nM - fm) < WGM ? (nM - fm) : WGM;
        u.pm = fm + ((wgid % nig) % gsz); u.pn = (wgid % nig) / gsz; return true;
    }
    __device__ __forceinline__ size_t aoff(const Gemm& g, const Unit& u) const { return (size_t)u.pm * BM * g.lda * 2; }
    __device__ __forceinline__ size_t boff(const Gemm& g, const Unit& u) const { return (size_t)u.pn * BM * g.ldb * 2; }
};
template <bool GA> struct MoeOrderT {
    static constexpr bool GATHER = GA;
    int nunits, npn, G, c; const LAS int* pend; size_t estride; const GAS int* tab; const LAS int* pcnt;
    __device__ bool next(int i, Unit& u) const { const long L = (long)i * G + c; if (L >= nunits) return false; u.pm = (int)(L / npn); u.pn = (int)(L % npn); return true; }
    __device__ __forceinline__ int expert(int pm) const { int e = 0; while (e < NEXP - 1 && pend[e] <= pm) ++e; return e; }
    __device__ __forceinline__ size_t aoff(const Gemm& g, const Unit& u) const { return (size_t)u.pm * BM * g.lda * 2; }
    __device__ __forceinline__ size_t boff(const Gemm& g, const Unit& u) const { return (size_t)expert(u.pm) * estride + (size_t)u.pn * BM * g.ldb * 2; }
    __device__ __forceinline__ void gather(const Gemm& g, const Unit& u, int tid, unsigned (&o)[2][2]) const {
        const int e = expert(u.pm), lp = u.pm - (e ? pend[e - 1] : 0), cnt = pcnt[e];
#pragma unroll
        for (int i = 0; i < 2; ++i) { int R, C; stage_rc(tid * 16 + i * 8192, R, C);
#pragma unroll
            for (int h = 0; h < 2; ++h) { const int pos = lp * 256 + h * HALF + R; int tok = 0; if (pos < cnt) tok = tab[(size_t)(e * MOE_CAP + pos) * 4];
                o[h][i] = (unsigned)tok * (unsigned)(g.lda * 2) + (unsigned)C * 2u; } }
    }
};
typedef MoeOrderT<false> MoeOrder; typedef MoeOrderT<true> MoeGather;

#define EPI_ROW(ai, m) (u.pm * 256 + (ai) * 128 + wr * 64 + (m) * 16 + fr)
#define EPI_COL(bj) (u.pn * 256 + (bj) * 128 + wc * 32 + 8 * fq)
#define EPI_COL16 (u.pn * 256 + wc * 64 + 16 * fq)
__device__ __forceinline__ int col16_src(int np) { const int j = np & 255; return (np & ~255) + 64 * ((j >> 5) & 3) + 16 * ((j >> 3) & 3) + 8 * (j >> 7) + (j & 7); }

template <bool SCALED> struct EpiScaleBf16T {
    static constexpr bool PERM = true;
    GAS bf16_t* O; int ldc; const GAS float* ssq; float invn; const GAS float* rowmul; float wsc;
    __device__ __forceinline__ void operator()(const f32x4 (&acc)[2][2][4][2], const Unit& u, int wr, int wc, int fr, int fq) const {
        float sc[2][4];
        if constexpr (SCALED) { float a[2][4], r[2][4];
#pragma unroll
            for (int ai = 0; ai < 2; ++ai)
#pragma unroll
                for (int m = 0; m < 4; ++m) { const int row = EPI_ROW(ai, m); a[ai][m] = ssq[row]; r[ai][m] = rowmul[row]; }
#pragma unroll
            for (int ai = 0; ai < 2; ++ai)
#pragma unroll
                for (int m = 0; m < 4; ++m) sc[ai][m] = __builtin_amdgcn_rsqf(a[ai][m] * invn + EPS) * r[ai][m] * wsc;
        }
#pragma unroll
        for (int ai = 0; ai < 2; ++ai)
#pragma unroll
            for (int m = 0; m < 4; ++m) { const int row = EPI_ROW(ai, m); const float s = SCALED ? sc[ai][m] : 1.0f;
#pragma unroll
                for (int bj = 0; bj < 2; ++bj) { const f32x4 v0 = acc[ai][bj][m][0] * s, v1 = acc[ai][bj][m][1] * s;
                    u32x4 w; w.x = cvt_pk_bf16(v0[0], v0[1]); w.y = cvt_pk_bf16(v0[2], v0[3]); w.z = cvt_pk_bf16(v1[0], v1[1]); w.w = cvt_pk_bf16(v1[2], v1[3]);
                    *(GAS u32x4*)(O + (size_t)row * ldc + EPI_COL(bj)) = w; } }
    }
};
typedef EpiScaleBf16T<true> EpiScaleBf16; typedef EpiScaleBf16T<false> EpiPlainBf16;
struct EpiProj1 {
    static constexpr bool PERM = true;
    GAS bf16_t* P; const GAS float* ssq; const GAS float* xsc; float wsc; const GAS float* gq; const GAS float* gk; GAS float* pcq; GAS float* pckv; GAS float* pkpe;
    __device__ __forceinline__ void operator()(const f32x4 (&acc)[2][2][4][2], const Unit& u, int wr, int wc, int fr, int fq) const {
        float sc[2][4];
        { float a[2][4], r[2][4];
#pragma unroll
          for (int ai = 0; ai < 2; ++ai)
#pragma unroll
              for (int m = 0; m < 4; ++m) { const int row = EPI_ROW(ai, m); a[ai][m] = ssq[row]; r[ai][m] = xsc[row]; }
#pragma unroll
          for (int ai = 0; ai < 2; ++ai)
#pragma unroll
              for (int m = 0; m < 4; ++m) sc[ai][m] = __builtin_amdgcn_rsqf(a[ai][m] * (1.0f / 1024.0f) + EPS) * r[ai][m] * wsc; }
        if (u.pn < 3) {
            const int head8 = 4 * u.pn + wc; const bool norm = head8 < 10;
            f32x4 g[2][2];
            if (norm) { const GAS float* gp = (head8 < 8 ? gq : gk) + 8 * fq; const float gs = head8 < 8 ? C2A : 1.0f;
#pragma unroll
                for (int bj = 0; bj < 2; ++bj)
#pragma unroll
                    for (int n = 0; n < 2; ++n) g[bj][n] = *(const GAS f32x4*)(gp + 32 * bj + 4 * n) * gs; }
#pragma unroll
            for (int ai = 0; ai < 2; ++ai)
#pragma unroll
                for (int m = 0; m < 4; ++m) { const int row = EPI_ROW(ai, m); f32x4 v[2][2];
#pragma unroll
                    for (int bj = 0; bj < 2; ++bj)
#pragma unroll
                        for (int n = 0; n < 2; ++n) v[bj][n] = acc[ai][bj][m][n] * sc[ai][m];
                    if (norm) { float s = 0.f;
#pragma unroll
                        for (int bj = 0; bj < 2; ++bj)
#pragma unroll
                            for (int n = 0; n < 2; ++n) s += (v[bj][n][0] * v[bj][n][0] + v[bj][n][1] * v[bj][n][1]) + (v[bj][n][2] * v[bj][n][2] + v[bj][n][3] * v[bj][n][3]);
                        s += __shfl_xor(s, 16); s += __shfl_xor(s, 32);
                        const float rs = __builtin_amdgcn_rsqf(s * (1.0f / 64.0f) + EPS);
#pragma unroll
                        for (int bj = 0; bj < 2; ++bj)
#pragma unroll
                            for (int n = 0; n < 2; ++n) v[bj][n] = v[bj][n] * rs * g[bj][n]; }
#pragma unroll
                    for (int bj = 0; bj < 2; ++bj) { u32x4 w; w.x = cvt_pk_bf16(v[bj][0][0], v[bj][0][1]); w.y = cvt_pk_bf16(v[bj][0][2], v[bj][0][3]); w.z = cvt_pk_bf16(v[bj][1][0], v[bj][1][1]); w.w = cvt_pk_bf16(v[bj][1][2], v[bj][1][3]);
                        *(GAS u32x4*)(P + (size_t)row * NPROJ1 + 64 * head8 + 32 * bj + 8 * fq) = w; } }
        } else {
#pragma unroll
            for (int ai = 0; ai < 2; ++ai)
#pragma unroll
                for (int m = 0; m < 4; ++m) { const int row = EPI_ROW(ai, m); float s0 = 0.f, s1 = 0.f;
#pragma unroll
                    for (int bj = 0; bj < 2; ++bj) { const f32x4 v0 = acc[ai][bj][m][0] * sc[ai][m], v1 = acc[ai][bj][m][1] * sc[ai][m];
                        const float q = (v0[0] * v0[0] + v0[1] * v0[1]) + (v0[2] * v0[2] + v0[3] * v0[3]) + (v1[0] * v1[0] + v1[1] * v1[1]) + (v1[2] * v1[2] + v1[3] * v1[3]);
                        if (bj == 0) s0 = q; else s1 = q;
                        u32x4 w; w.x = cvt_pk_bf16(v0[0], v0[1]); w.y = cvt_pk_bf16(v0[2], v0[3]); w.z = cvt_pk_bf16(v1[0], v1[1]); w.w = cvt_pk_bf16(v1[2], v1[3]);
                        *(GAS u32x4*)(P + (size_t)row * NPROJ1 + EPI_COL(bj)) = w; }
                    float s = (u.pn == 3) ? s0 + s1 : s0;
                    s += __shfl_xor(s, 16); s += __shfl_xor(s, 32);
                    if (fq == 0) ((u.pn == 3) ? pcq : pckv)[(size_t)row * 4 + wc] = s;
                    if (u.pn == 4 && wc == 0) { float t = s1; t += __shfl_xor(t, 16); t += __shfl_xor(t, 32); if (fq == 0) pkpe[row] = t; } }
        }
    }
};
struct EpiRowNorm4 {
    static constexpr bool PERM = true;
    GAS unsigned char* O; int ldc; const GAS float* part; float invn;
    __device__ __forceinline__ void operator()(const f32x4 (&acc)[2][2][4][2], const Unit& u, int wr, int wc, int fr, int fq) const {
        f32x4 p[2][4];
#pragma unroll
        for (int ai = 0; ai < 2; ++ai)
#pragma unroll
            for (int m = 0; m < 4; ++m) p[ai][m] = *(const GAS f32x4*)(part + (size_t)EPI_ROW(ai, m) * 4);
#pragma unroll
        for (int ai = 0; ai < 2; ++ai)
#pragma unroll
            for (int m = 0; m < 4; ++m) { const int row = EPI_ROW(ai, m); const float s = __builtin_amdgcn_rsqf(((p[ai][m].x + p[ai][m].y) + (p[ai][m].z + p[ai][m].w)) * invn + EPS);
                const f32x4 a0 = acc[ai][0][m][0] * s, a1 = acc[ai][0][m][1] * s, b0 = acc[ai][1][m][0] * s, b1 = acc[ai][1][m][1] * s;
                u32x4 w; w.x = pk4_fp8(a0[0], a0[1], a0[2], a0[3]); w.y = pk4_fp8(a1[0], a1[1], a1[2], a1[3]); w.z = pk4_fp8(b0[0], b0[1], b0[2], b0[3]); w.w = pk4_fp8(b1[0], b1[1], b1[2], b1[3]);
                *(GAS u32x4*)(O + (size_t)row * ldc + EPI_COL16) = w; }
    }
};
struct EpiGates {
    static constexpr bool PERM = true;
    GAS bf16_t* O; const GAS float* ssq; const GAS float* bias; const GAS float* rowmul; float wsc;
    __device__ __forceinline__ void operator()(const f32x4 (&acc)[2][2][4][2], const Unit& u, int wr, int wc, int fr, int fq) const {
        f32x4 bv[2][2]; float a[2][4], r[2][4], sc[2][4];
#pragma unroll
        for (int bj = 0; bj < 2; ++bj)
#pragma unroll
            for (int n = 0; n < 2; ++n) bv[bj][n] = *(const GAS f32x4*)(bias + EPI_COL(bj) + 4 * n);
#pragma unroll
        for (int ai = 0; ai < 2; ++ai)
#pragma unroll
            for (int m = 0; m < 4; ++m) { const int row = EPI_ROW(ai, m); a[ai][m] = ssq[row]; r[ai][m] = rowmul[row]; }
#pragma unroll
        for (int ai = 0; ai < 2; ++ai)
#pragma unroll
            for (int m = 0; m < 4; ++m) sc[ai][m] = __builtin_amdgcn_rsqf(a[ai][m] * (1.0f / 1024.0f) + EPS) * r[ai][m] * wsc;
#pragma unroll
        for (int ai = 0; ai < 2; ++ai)
#pragma unroll
            for (int m = 0; m < 4; ++m) { const int row = EPI_ROW(ai, m); const float s = sc[ai][m];
#pragma unroll
                for (int bj = 0; bj < 2; ++bj) { f32x4 v0 = acc[ai][bj][m][0] * s + bv[bj][0], v1 = acc[ai][bj][m][1] * s + bv[bj][1];
#pragma unroll
                    for (int i = 0; i < 4; ++i) { v0[i] = fsigmoid(v0[i]); v1[i] = fsigmoid(v1[i]); }
                    u32x4 w; w.x = cvt_pk_bf16(v0[0], v0[1]); w.y = cvt_pk_bf16(v0[2], v0[3]); w.z = cvt_pk_bf16(v1[0], v1[1]); w.w = cvt_pk_bf16(v1[2], v1[3]);
                    *(GAS u32x4*)(O + (size_t)row * 2048 + EPI_COL(bj)) = w; } }
    }
};
struct EpiKv {
    static constexpr bool PERM = true;
    GAS bf16_t* KBo; GAS bf16_t* Vo; const GAS float* pckv; const GAS float* pkpe; const GAS bf16_t* P; const GAS float* gbk; const GAS float* rope;
    __device__ __forceinline__ void operator()(const f32x4 (&acc)[2][2][4][2], const Unit& u, int wr, int wc, int fr, int fq) const {
        asm volatile("" : "+v"(fr), "+v"(fq));
        float rc[2][4];
        { f32x4 p[2][4];
#pragma unroll
          for (int ai = 0; ai < 2; ++ai)
#pragma unroll
              for (int m = 0; m < 4; ++m) p[ai][m] = *(const GAS f32x4*)(pckv + (unsigned)(EPI_ROW(ai, m) * 4));
#pragma unroll
          for (int ai = 0; ai < 2; ++ai)
#pragma unroll
              for (int m = 0; m < 4; ++m) rc[ai][m] = __builtin_amdgcn_rsqf(((p[ai][m].x + p[ai][m].y) + (p[ai][m].z + p[ai][m].w)) * (1.0f / 128.0f) + EPS); }
        const int head = 2 * u.pn + (wc & 1);
        if (wc >= 2) {
#pragma unroll
            for (int ai = 0; ai < 2; ++ai)
#pragma unroll
                for (int m = 0; m < 4; ++m) { const int row = EPI_ROW(ai, m);
#pragma unroll
                    for (int bj = 0; bj < 2; ++bj) { const f32x4 v0 = acc[ai][bj][m][0] * rc[ai][m], v1 = acc[ai][bj][m][1] * rc[ai][m];
                        u32x4 w; w.x = cvt_pk_bf16(v0[0], v0[1]); w.y = cvt_pk_bf16(v0[2], v0[3]); w.z = cvt_pk_bf16(v1[0], v1[1]); w.w = cvt_pk_bf16(v1[2], v1[3]);
                        *(GAS u32x4*)(Vo + (unsigned)(row * 1024 + 128 * head + 64 + 32 * bj + 8 * fq)) = w; } }
        } else {
            float rsh[2][4];
            {
                float sk[2][4];
#pragma unroll
                for (int ai = 0; ai < 2; ++ai)
#pragma unroll
                    for (int m = 0; m < 4; ++m) sk[ai][m] = pkpe[(unsigned)EPI_ROW(ai, m)];
                f32x4 g[2][2];
#pragma unroll
                for (int bj = 0; bj < 2; ++bj)
#pragma unroll
                    for (int n = 0; n < 2; ++n) g[bj][n] = *(const GAS f32x4*)(gbk + (unsigned)(32 * bj + 8 * fq + 4 * n));
#pragma unroll
                for (int ai = 0; ai < 2; ++ai)
#pragma unroll
                    for (int m = 0; m < 4; ++m) { const int row = EPI_ROW(ai, m); f32x4 v[2][2]; float s = 0.f;
#pragma unroll
                        for (int bj = 0; bj < 2; ++bj)
#pragma unroll
                            for (int n = 0; n < 2; ++n) { v[bj][n] = acc[ai][bj][m][n] * rc[ai][m]; s += (v[bj][n][0] * v[bj][n][0] + v[bj][n][1] * v[bj][n][1]) + (v[bj][n][2] * v[bj][n][2] + v[bj][n][3] * v[bj][n][3]); }
                        s += __shfl_xor(s, 16); s += __shfl_xor(s, 32);
                        const float rs = __builtin_amdgcn_rsqf((s + sk[ai][m]) * (1.0f / 96.0f) + EPS); rsh[ai][m] = rs;
                        const unsigned dof = (unsigned)((((row >> 12) * 8 + head) * 64 + ((row & (SEQ - 1)) >> 6)) * 12 * 512 + (row & 63) * 8);
#pragma unroll
                        for (int bj = 0; bj < 2; ++bj) { const f32x4 a0 = v[bj][0] * rs * g[bj][0], a1 = v[bj][1] * rs * g[bj][1];
                            u32x4 w; w.x = cvt_pk_bf16(a0[0], a0[1]); w.y = cvt_pk_bf16(a0[2], a0[3]); w.z = cvt_pk_bf16(a1[0], a1[1]); w.w = cvt_pk_bf16(a1[2], a1[3]);
                            *(GAS u32x4*)(KBo + (dof + (4 * bj + fq) * 512)) = w; }
                        }
            }
            asm volatile("" : "+v"(fq), "+v"(fr) :: "memory");
            {
                const f32x4 gr0 = *(const GAS f32x4*)(gbk + (unsigned)(64 + 4 * fq)), gr1 = *(const GAS f32x4*)(gbk + (unsigned)(80 + 4 * fq));
#pragma unroll
                for (int ai = 0; ai < 2; ++ai) { u32x2 kp0[4], kp1[4]; f32x4 cs[4], sn[4];
#pragma unroll
                    for (int m = 0; m < 4; ++m) { const int row = EPI_ROW(ai, m);
                        const unsigned pof = (unsigned)(row * NPROJ1 + C_KPE + 4 * fq); kp0[m] = *(const GAS u32x2*)(P + pof); kp1[m] = *(const GAS u32x2*)(P + (pof + 16));
                        const unsigned rof = (unsigned)((row & (SEQ - 1)) * 32 + 4 * fq); cs[m] = *(const GAS f32x4*)(rope + rof); sn[m] = *(const GAS f32x4*)(rope + (rof + 16)); }
#pragma unroll
                    for (int m = 0; m < 4; ++m) { const int row = EPI_ROW(ai, m); const float rs = rsh[ai][m]; const unsigned dof = (unsigned)((((row >> 12) * 8 + head) * 64 + ((row & (SEQ - 1)) >> 6)) * 12 * 512 + (row & 63) * 8);
                        const f32x4 x1 = (f32x4){bflo(kp0[m].x), bfhi(kp0[m].x), bflo(kp0[m].y), bfhi(kp0[m].y)} * rs * gr0, x2 = (f32x4){bflo(kp1[m].x), bfhi(kp1[m].x), bflo(kp1[m].y), bfhi(kp1[m].y)} * rs * gr1;
                        const f32x4 o1 = x1 * cs[m] - x2 * sn[m], o2 = x1 * sn[m] + x2 * cs[m];
                        u32x2 w1, w2; w1.x = cvt_pk_bf16(o1[0], o1[1]); w1.y = cvt_pk_bf16(o1[2], o1[3]); w2.x = cvt_pk_bf16(o2[0], o2[1]); w2.y = cvt_pk_bf16(o2[2], o2[3]);
                        *(GAS u32x2*)(KBo + (dof + (8 + (fq >> 1)) * 512 + 4 * (fq & 1))) = w1; *(GAS u32x2*)(KBo + (dof + (10 + (fq >> 1)) * 512 + 4 * (fq & 1))) = w2; }
                    asm volatile("" ::: "memory"); }
            }
        }
    }
};
struct EpiGates2 {
    static constexpr bool PERM = true;
    GAS unsigned char* GP; const GAS float* ssq; const GAS float* bias; const GAS float* rowmul; float wsc;
    __device__ __forceinline__ void operator()(const f32x4 (&acc)[2][2][4][2], const Unit& u, int wr, int wc, int fr, int fq) const {
        f32x4 ba[2], bb[2]; float a[2][4], r[2][4], sc[2][4];
        const int c0 = u.pn * 128 + wc * 32 + 8 * fq;
#pragma unroll
        for (int n = 0; n < 2; ++n) { ba[n] = *(const GAS f32x4*)(bias + c0 + 4 * n) * (-LOG2E); bb[n] = *(const GAS f32x4*)(bias + 1024 + c0 + 4 * n) * (-LOG2E); }
#pragma unroll
        for (int ai = 0; ai < 2; ++ai)
#pragma unroll
            for (int m = 0; m < 4; ++m) { const int row = EPI_ROW(ai, m); a[ai][m] = ssq[row]; r[ai][m] = rowmul[row]; }
#pragma unroll
        for (int ai = 0; ai < 2; ++ai)
#pragma unroll
            for (int m = 0; m < 4; ++m) sc[ai][m] = __builtin_amdgcn_rsqf(a[ai][m] * (1.0f / 1024.0f) + EPS) * r[ai][m] * (wsc * -LOG2E);
#pragma unroll
        for (int ai = 0; ai < 2; ++ai)
#pragma unroll
            for (int m = 0; m < 4; ++m) { const int row = EPI_ROW(ai, m); const float s = sc[ai][m]; f32x4 sa[2], sb[2];
#pragma unroll
                for (int n = 0; n < 2; ++n) { const f32x4 la = acc[ai][0][m][n] * s + ba[n], lb = acc[ai][1][m][n] * s + bb[n];
#pragma unroll
                    for (int i = 0; i < 4; ++i) { const float ea = __builtin_amdgcn_exp2f(la[i]), eb = __builtin_amdgcn_exp2f(lb[i]); sb[n][i] = __builtin_amdgcn_rcpf(1.0f + eb); sa[n][i] = __builtin_fminf((1.0f + eb) * __builtin_amdgcn_rcpf(1.0f + ea), 448.0f); } }
                u32x4 w; w.x = pk4_fp8(sa[0][0], sb[0][0], sa[0][1], sb[0][1]); w.y = pk4_fp8(sa[0][2], sb[0][2], sa[0][3], sb[0][3]);
                w.z = pk4_fp8(sa[1][0], sb[1][0], sa[1][1], sb[1][1]); w.w = pk4_fp8(sa[1][2], sb[1][2], sa[1][3], sb[1][3]);
                *(GAS u32x4*)(GP + ((size_t)row * 1024 + c0) * 2) = w; }
    }
};
struct EpiMerge {
    static constexpr bool PERM = true; static constexpr bool HAS_MID = true;
    GAS bf16_t* Mo; const GAS unsigned char* GP;
    template <bool FIN> __device__ __forceinline__ void apply(f32x4 (&acc)[2][2][4][2], const Unit& u, int wr, int wc, int fr, int fq) const {
#pragma unroll
        for (int ai = 0; ai < 2; ++ai) { u32x4 gv[4][2];
#pragma unroll
            for (int m = 0; m < 4; ++m)
#pragma unroll
                for (int bj = 0; bj < 2; ++bj) gv[m][bj] = *(const GAS u32x4*)(GP + ((size_t)EPI_ROW(ai, m) * 1024 + EPI_COL16 + 8 * bj) * 2);
#pragma unroll
            for (int m = 0; m < 4; ++m) { u32x4 w;
#pragma unroll
                for (int bj = 0; bj < 2; ++bj) { const u32x4 g = gv[m][bj]; f32x4 v0 = acc[ai][bj][m][0], v1 = acc[ai][bj][m][1];
                    if constexpr (FIN) {
                        v0[0] *= __builtin_amdgcn_cvt_f32_fp8((int)g.x, 1); v0[1] *= __builtin_amdgcn_cvt_f32_fp8((int)g.x, 3); v0[2] *= __builtin_amdgcn_cvt_f32_fp8((int)g.y, 1); v0[3] *= __builtin_amdgcn_cvt_f32_fp8((int)g.y, 3);
                        v1[0] *= __builtin_amdgcn_cvt_f32_fp8((int)g.z, 1); v1[1] *= __builtin_amdgcn_cvt_f32_fp8((int)g.z, 3); v1[2] *= __builtin_amdgcn_cvt_f32_fp8((int)g.w, 1); v1[3] *= __builtin_amdgcn_cvt_f32_fp8((int)g.w, 3);
                        v0 = v0 * W8I; v1 = v1 * W8I; const unsigned lo_ = pk4_fp8(v0[0], v0[1], v0[2], v0[3]), hi_ = pk4_fp8(v1[0], v1[1], v1[2], v1[3]);
                        if (bj == 0) { w.x = lo_; w.y = hi_; } else { w.z = lo_; w.w = hi_; } }
                    else {
                        v0[0] *= __builtin_amdgcn_cvt_f32_fp8((int)g.x, 0); v0[1] *= __builtin_amdgcn_cvt_f32_fp8((int)g.x, 2); v0[2] *= __builtin_amdgcn_cvt_f32_fp8((int)g.y, 0); v0[3] *= __builtin_amdgcn_cvt_f32_fp8((int)g.y, 2);
                        v1[0] *= __builtin_amdgcn_cvt_f32_fp8((int)g.z, 0); v1[1] *= __builtin_amdgcn_cvt_f32_fp8((int)g.z, 2); v1[2] *= __builtin_amdgcn_cvt_f32_fp8((int)g.w, 0); v1[3] *= __builtin_amdgcn_cvt_f32_fp8((int)g.w, 2);
                        acc[ai][bj][m][0] = v0; acc[ai][bj][m][1] = v1; } }
                if constexpr (FIN) *(GAS u32x4*)((GAS unsigned char*)Mo + (size_t)EPI_ROW(ai, m) * 1024 + EPI_COL16) = w; }
            asm volatile("" ::: "memory"); }
    }
    __device__ __forceinline__ void mid(f32x4 (&acc)[2][2][4][2], const Unit& u, int wr, int wc, int fr, int fq) const { apply<false>(acc, u, wr, wc, fr, fq); }
    __device__ __forceinline__ void operator()(f32x4 (&acc)[2][2][4][2], const Unit& u, int wr, int wc, int fr, int fq) const { apply<true>(acc, u, wr, wc, fr, fq); }
};
template <bool ACCUM> struct EpiGateMul {
    static constexpr bool PERM = true;
    GAS bf16_t* Mo; const GAS bf16_t* gates; int goff;
    __device__ __forceinline__ void operator()(const f32x4 (&acc)[2][2][4][2], const Unit& u, int wr, int wc, int fr, int fq) const {
#pragma unroll
        for (int ai = 0; ai < 2; ++ai) { u32x4 gv[4][2], pv[4][2];
#pragma unroll
            for (int m = 0; m < 4; ++m) { const int row = EPI_ROW(ai, m);
#pragma unroll
                for (int bj = 0; bj < 2; ++bj) { const int col = EPI_COL(bj); gv[m][bj] = *(const GAS u32x4*)(gates + (size_t)row * 2048 + goff + col);
                    if (ACCUM) pv[m][bj] = *(const GAS u32x4*)(Mo + (size_t)row * 1024 + col); } }
#pragma unroll
            for (int m = 0; m < 4; ++m) { const int row = EPI_ROW(ai, m);
#pragma unroll
                for (int bj = 0; bj < 2; ++bj) { const int col = EPI_COL(bj); const u32x4 g = gv[m][bj];
                    f32x4 v0 = acc[ai][bj][m][0], v1 = acc[ai][bj][m][1];
                    v0[0] *= bflo(g.x); v0[1] *= bfhi(g.x); v0[2] *= bflo(g.y); v0[3] *= bfhi(g.y);
                    v1[0] *= bflo(g.z); v1[1] *= bfhi(g.z); v1[2] *= bflo(g.w); v1[3] *= bfhi(g.w);
                    if (ACCUM) { const u32x4 p = pv[m][bj];
                        v0[0] += bflo(p.x); v0[1] += bfhi(p.x); v0[2] += bflo(p.y); v0[3] += bfhi(p.y);
                        v1[0] += bflo(p.z); v1[1] += bfhi(p.z); v1[2] += bflo(p.w); v1[3] += bfhi(p.w); }
                    u32x4 w; w.x = cvt_pk_bf16(v0[0], v0[1]); w.y = cvt_pk_bf16(v0[2], v0[3]); w.z = cvt_pk_bf16(v1[0], v1[1]); w.w = cvt_pk_bf16(v1[2], v1[3]);
                    *(GAS u32x4*)(Mo + (size_t)row * 1024 + col) = w; } }
            asm volatile("" ::: "memory"); }
    }
};
struct EpiResid {
    static constexpr bool PERM = true;
    const GAS float* xres; GAS bf16_t* xb; GAS float* ssq;
    __device__ __forceinline__ void operator()(const f32x4 (&acc)[2][2][4][2], const Unit& u, int wr, int wc, int fr, int fq) const {
#pragma unroll
        for (int ai = 0; ai < 2; ++ai) { f32x4 pre[4][2][2];
            if (xres) {
#pragma unroll
                for (int m = 0; m < 4; ++m) { const int row = EPI_ROW(ai, m);
#pragma unroll
                    for (int bj = 0; bj < 2; ++bj) { const size_t off = (size_t)row * 1024 + EPI_COL16 + 8 * bj; pre[m][bj][0] = *(const GAS f32x4*)(xres + off); pre[m][bj][1] = *(const GAS f32x4*)(xres + off + 4); } }
            } else {
                u32x4 pb[4][2];
#pragma unroll
                for (int m = 0; m < 4; ++m) { const int row = EPI_ROW(ai, m);
#pragma unroll
                    for (int bj = 0; bj < 2; ++bj) pb[m][bj] = *(const GAS u32x4*)(xb + (size_t)row * 1024 + EPI_COL16 + 8 * bj); }
#pragma unroll
                for (int m = 0; m < 4; ++m)
#pragma unroll
                    for (int bj = 0; bj < 2; ++bj) { const u32x4 p = pb[m][bj]; pre[m][bj][0] = (f32x4){bflo(p.x), bfhi(p.x), bflo(p.y), bfhi(p.y)}; pre[m][bj][1] = (f32x4){bflo(p.z), bfhi(p.z), bflo(p.w), bfhi(p.w)}; }
            }
#pragma unroll
            for (int m = 0; m < 4; ++m) { const int row = EPI_ROW(ai, m); float s = 0.f;
#pragma unroll
                for (int bj = 0; bj < 2; ++bj) { const size_t off = (size_t)row * 1024 + EPI_COL16 + 8 * bj;
                    const f32x4 v0 = acc[ai][bj][m][0] * W8I + pre[m][bj][0], v1 = acc[ai][bj][m][1] * W8I + pre[m][bj][1];
                    s += (v0[0] * v0[0] + v0[1] * v0[1]) + (v0[2] * v0[2] + v0[3] * v0[3]) + (v1[0] * v1[0] + v1[1] * v1[1]) + (v1[2] * v1[2] + v1[3] * v1[3]);
                    u32x4 w; w.x = cvt_pk_bf16(v0[0], v0[1]); w.y = cvt_pk_bf16(v0[2], v0[3]); w.z = cvt_pk_bf16(v1[0], v1[1]); w.w = cvt_pk_bf16(v1[2], v1[3]);
                    *(GAS u32x4*)(xb + off) = w; }
                s += __shfl_xor(s, 16); s += __shfl_xor(s, 32);
                if (fq == 0) ssq[(size_t)row * 16 + u.pn * 4 + wc] = s; }
            asm volatile("" ::: "memory"); }
    }
};
struct EpiLogits {
    static constexpr bool PERM = true;
    GAS float* L; const GAS float* ssqp;
    __device__ __forceinline__ void operator()(const f32x4 (&acc)[2][2][4][2], const Unit& u, int wr, int wc, int fr, int fq) const {
        if (u.pn != 0 || wc > 1) return;
#pragma unroll
        for (int ai = 0; ai < 2; ++ai) { f32x4 pp[4][4];
#pragma unroll
            for (int m = 0; m < 4; ++m) { const GAS f32x4* p = (const GAS f32x4*)(ssqp + (size_t)EPI_ROW(ai, m) * 16); pp[m][0] = p[0]; pp[m][1] = p[1]; pp[m][2] = p[2]; pp[m][3] = p[3]; }
#pragma unroll
            for (int m = 0; m < 4; ++m) { const int row = EPI_ROW(ai, m); const f32x4 a = pp[m][0], b = pp[m][1], c = pp[m][2], d = pp[m][3];
                const float sc = __builtin_amdgcn_rsqf((((a.x + a.y) + (a.z + a.w)) + ((b.x + b.y) + (b.z + b.w)) + ((c.x + c.y) + (c.z + c.w)) + ((d.x + d.y) + (d.z + d.w))) * (1.0f / 1024.0f) + EPS);
#pragma unroll
                for (int n = 0; n < 2; ++n) { const int col = wc * 32 + 8 * fq + 4 * n; if (col < 36) *(GAS f32x4*)(L + (size_t)row * 64 + col) = acc[ai][0][m][n] * sc; } } }
    }
};
struct EpiGateUp {
    static constexpr bool PERM = true;
    GAS bf16_t* act; const GAS float* tabf; const LAS int* pend; const LAS int* pcnt; float wsc;
    __device__ __forceinline__ void operator()(const f32x4 (&acc)[2][2][4][2], const Unit& u, int wr, int wc, int fr, int fq) const {
        int e = 0; while (e < NEXP - 1 && pend[e] <= u.pm) ++e;
        const int lp = u.pm - (e ? pend[e - 1] : 0), cnt = pcnt[e] - lp * 256; const unsigned base = (unsigned)(e * MOE_CAP + lp * 256);
        float sc[2][4];
#pragma unroll
        for (int ai = 0; ai < 2; ++ai)
#pragma unroll
            for (int m = 0; m < 4; ++m) { const int r = ai * 128 + wr * 64 + m * 16 + fr; const float v = tabf[(size_t)(base + r) * 4 + 1]; sc[ai][m] = (r < cnt) ? v : 0.f; }
#pragma unroll
        for (int ai = 0; ai < 2; ++ai)
#pragma unroll
            for (int m = 0; m < 4; ++m) { const int row = EPI_ROW(ai, m); const float s = sc[ai][m] * wsc; f32x4 a[2];
#pragma unroll
                for (int n = 0; n < 2; ++n) { const f32x4 gg = acc[ai][0][m][n] * s, uu = acc[ai][1][m][n] * s;
#pragma unroll
                    for (int i = 0; i < 4; ++i) a[n][i] = gg[i] * fsigmoid(gg[i]) * uu[i]; }
                u32x4 w; w.x = cvt_pk_bf16(a[0][0], a[0][1]); w.y = cvt_pk_bf16(a[0][2], a[0][3]); w.z = cvt_pk_bf16(a[1][0], a[1][1]); w.w = cvt_pk_bf16(a[1][2], a[1][3]);
                *(GAS u32x4*)(act + (size_t)row * 256 + u.pn * 128 + wc * 32 + 8 * fq) = w; }
    }
};
struct EpiDown {
    static constexpr bool PERM = true;
    GAS bf16_t* ybuf; const GAS int* tabi; const LAS int* pend; const LAS int* pcnt;
    __device__ __forceinline__ void operator()(const f32x4 (&acc)[2][2][4][2], const Unit& u, int wr, int wc, int fr, int fq) const {
        int e = 0; while (e < NEXP - 1 && pend[e] <= u.pm) ++e;
        const int lp = u.pm - (e ? pend[e - 1] : 0), cnt = pcnt[e] - lp * 256; const unsigned base = (unsigned)(e * MOE_CAP + lp * 256);
        int yd[2][4]; float sw[2][4];
#pragma unroll
        for (int ai = 0; ai < 2; ++ai)
#pragma unroll
            for (int m = 0; m < 4; ++m) { const int r = ai * 128 + wr * 64 + m * 16 + fr; const GAS int* en = tabi + (size_t)(base + r) * 4; const int y_ = en[2]; const float w_ = __int_as_float(en[3]);
                yd[ai][m] = (r < cnt) ? y_ : -1; sw[ai][m] = w_; }
#pragma unroll
        for (int ai = 0; ai < 2; ++ai)
#pragma unroll
            for (int m = 0; m < 4; ++m) { const float sc = sw[ai][m];
                if (yd[ai][m] >= 0) { const float s8 = sc * Y8S;
                    const f32x4 a0 = acc[ai][0][m][0] * s8, a1 = acc[ai][0][m][1] * s8, b0 = acc[ai][1][m][0] * s8, b1 = acc[ai][1][m][1] * s8;
                    u32x4 w; w.x = pk4_fp8(a0[0], a0[1], a0[2], a0[3]); w.y = pk4_fp8(a1[0], a1[1], a1[2], a1[3]); w.z = pk4_fp8(b0[0], b0[1], b0[2], b0[3]); w.w = pk4_fp8(b1[0], b1[1], b1[2], b1[3]);
                    *(GAS u32x4*)((GAS unsigned char*)ybuf + (size_t)yd[ai][m] * 1024 + EPI_COL16) = w; } }
    }
};

typedef int v4i32_t __attribute__((ext_vector_type(4)));
typedef long i64x2_t __attribute__((ext_vector_type(2)));
template <class Epi, class Sched, bool I8 = false, bool MID = false, bool F8 = false, bool ALIGN_EPI = true, bool SP2 = true>
__device__ __forceinline__ void gemm_phase(LAS unsigned char* lds, const Gemm g, const Sched& S, const Epi& E) {
    int tid_ = threadIdx.x; asm volatile("" : "+v"(tid_));
    const int tid = tid_, wid = __builtin_amdgcn_readfirstlane(tid >> 6), lane = tid & 63, wr = wid >> 2, wc = wid & 3, fr = lane & 15, fq = lane >> 4;
    int K_ = g.K; asm volatile("" : "+s"(K_));
    const int K = K_, nt = K / BK;
    unsigned voffA[2], voffB[2];
#pragma unroll
    for (int i = 0; i < 2; ++i) { int R, C; stage_rc(tid * 16 + i * 8192, R, C); const int Rb = Epi::PERM ? ((R & ~31) + perm32(R & 31)) : R;
        voffA[i] = (unsigned)(R * g.lda + C) * 2u; voffB[i] = (unsigned)(Rb * g.ldb + C) * 2u; }
    const size_t kstep = (size_t)(BK * 2);
    const size_t hstepA = (size_t)HALF * g.lda * 2, hstepB = (size_t)HALF * g.ldb * 2;
    const unsigned ldsw = (unsigned)wid * 1024u;
    const int aoff = lds_byte(wr * 64 + fr, fq * 8), boff = lds_byte(wc * 32 + fr, fq * 8);
#define PG8_SA(b, h) (((b) * 2 + (h)) * HTB)
#define PG8_SB(b, h) ((4 + (b) * 2 + (h)) * HTB)
#define PG8_STAGE(bufoff, gbase, voff) do { _Pragma("unroll") for (int _i = 0; _i < 2; ++_i) \
        __builtin_amdgcn_global_load_lds((const GAS unsigned*)((const char*)(gbase) + (voff)[_i]), (LAS unsigned*)(lds + (bufoff) + ldsw + _i * 8192), 16, 0, 0); } while (0)
#define PG8_LDA(dst, b, h) do { _Pragma("unroll") for (int m = 0; m < 4; ++m) _Pragma("unroll") for (int k = 0; k < 2; ++k) dst[m][k] = *(const LAS bf16x8*)(lds + PG8_SA(b, h) + aoff + m * 2048 + k * 1024); } while (0)
#define PG8_LDB(dst, b, h) do { _Pragma("unroll") for (int n = 0; n < 2; ++n) _Pragma("unroll") for (int k = 0; k < 2; ++k) dst[n][k] = *(const LAS bf16x8*)(lds + PG8_SB(b, h) + boff + n * 2048 + k * 1024); } while (0)
#define PG8_MMA(ai, bj, At, Bt) do { __builtin_amdgcn_s_setprio(1); _Pragma("unroll") for (int m = 0; m < 4; ++m) _Pragma("unroll") for (int n = 0; n < 2; ++n) _Pragma("unroll") for (int k = 0; k < 2; ++k) { \
        if constexpr (I8) acc[ai][bj][m][n] = __builtin_bit_cast(f32x4, __builtin_amdgcn_mfma_i32_16x16x64_i8(__builtin_bit_cast(v4i32_t, Bt[n][k]), __builtin_bit_cast(v4i32_t, At[m][k]), __builtin_bit_cast(v4i32_t, acc[ai][bj][m][n]), 0, 0, 0)); \
        else if constexpr (F8) { const i64x2_t b_ = __builtin_bit_cast(i64x2_t, Bt[n][k]), a_ = __builtin_bit_cast(i64x2_t, At[m][k]); \
            acc[ai][bj][m][n] = __builtin_amdgcn_mfma_f32_16x16x32_fp8_fp8(b_[0], a_[0], acc[ai][bj][m][n], 0, 0, 0); acc[ai][bj][m][n] = __builtin_amdgcn_mfma_f32_16x16x32_fp8_fp8(b_[1], a_[1], acc[ai][bj][m][n], 0, 0, 0); } \
        else acc[ai][bj][m][n] = __builtin_amdgcn_mfma_f32_16x16x32_bf16(Bt[n][k], At[m][k], acc[ai][bj][m][n], 0, 0, 0); } \
        __builtin_amdgcn_s_setprio(0); } while (0)
#define PG8_WAIT_V(n) asm volatile("s_waitcnt vmcnt(" #n ")" ::: "memory")
#define PG8_WAIT_L(n) asm volatile("s_waitcnt lgkmcnt(" #n ")" ::: "memory")
#define PG8_BAR __builtin_amdgcn_s_barrier()
#define PG8_SCHED __builtin_amdgcn_sched_barrier(0)
    Unit cur, nxt; int ui = 0;
    if (!S.next(0, cur)) return;
    unsigned gvc[2][2], gvn[2][2];
    if constexpr (Sched::GATHER) { S.gather(g, cur, tid, gvc); gvn[0][0] = gvc[0][0]; gvn[0][1] = gvc[0][1]; gvn[1][0] = gvc[1][0]; gvn[1][1] = gvc[1][1]; }
#define PG8_STAGE_A(b, h, aptr, ko, nx) do { if constexpr (Sched::GATHER) { unsigned sv_[2] = {(nx) ? gvn[h][0] : gvc[h][0], (nx) ? gvn[h][1] : gvc[h][1]}; PG8_STAGE(PG8_SA(b, h), (const char*)g.A + (ko), sv_); } \
        else PG8_STAGE(PG8_SA(b, h), (aptr), voffA); } while (0)
    f32x4 acc[2][2][4][2];
#pragma unroll
    for (int a = 0; a < 2; ++a)
#pragma unroll
        for (int b = 0; b < 2; ++b)
#pragma unroll
            for (int m = 0; m < 4; ++m)
#pragma unroll
                for (int n = 0; n < 2; ++n) acc[a][b][m][n] = (f32x4){0.f, 0.f, 0.f, 0.f};
    bf16x8 At[4][2], B0[2][2], B1[2][2];
    const char* cA = (const char*)g.A + S.aoff(g, cur); const char* cB = (const char*)g.Bt + S.boff(g, cur);
    const int ntm = nt - 1;
#define PG8_ROT(u_) ((MID || nt < 4) ? 0 : (((u_).pn & 3) * (nt >> 2)))
#define PG8_KO(rot_, t_) ((size_t)(((t_) + (rot_)) & ntm) * kstep)
    int rotc = PG8_ROT(cur);
    if constexpr (SP2) {
        PG8_STAGE(PG8_SB(0, 0), cB + PG8_KO(rotc, 0), voffB); PG8_STAGE(PG8_SB(0, 1), cB + hstepB + PG8_KO(rotc, 0), voffB); PG8_STAGE_A(0, 0, cA + PG8_KO(rotc, 0), PG8_KO(rotc, 0), false); PG8_STAGE_A(0, 1, cA + hstepA + PG8_KO(rotc, 0), PG8_KO(rotc, 0), false);
        if (wr == 1) PG8_BAR;
        PG8_WAIT_V(2); PG8_BAR;
        PG8_STAGE(PG8_SB(1, 0), cB + PG8_KO(rotc, 1), voffB); PG8_STAGE_A(1, 0, cA + PG8_KO(rotc, 1), PG8_KO(rotc, 1), false); PG8_STAGE(PG8_SB(1, 1), cB + hstepB + PG8_KO(rotc, 1), voffB);
        PG8_WAIT_V(6); PG8_BAR;
    }
    for (;;) {
        const bool has_next = S.next(ui + 1, nxt);
        const char* nA = has_next ? (const char*)g.A + S.aoff(g, nxt) : cA; const char* nB = has_next ? (const char*)g.Bt + S.boff(g, nxt) : cB;
        const int rotn = has_next ? PG8_ROT(nxt) : rotc;
        if constexpr (Sched::GATHER) { if (has_next) S.gather(g, nxt, tid, gvn); }
        for (int t = 0; t < nt; t += 2) {
            if constexpr (MID) { if (t == (nt >> 1)) E.mid(acc, cur, wr, wc, fr, fq); }
            const bool last = (t == nt - 2);
            const char* a1 = cA + PG8_KO(rotc, t + 1);
            const char* a2 = last ? nA + PG8_KO(rotn, 0) : cA + PG8_KO(rotc, t + 2); const char* b2 = last ? nB + PG8_KO(rotn, 0) : cB + PG8_KO(rotc, t + 2);
            const char* a3 = last ? nA + PG8_KO(rotn, 1) : cA + PG8_KO(rotc, t + 3); const char* b3 = last ? nB + PG8_KO(rotn, 1) : cB + PG8_KO(rotc, t + 3);
            const size_t ko1 = PG8_KO(rotc, t + 1), ko2 = last ? PG8_KO(rotn, 0) : PG8_KO(rotc, t + 2), ko3 = last ? PG8_KO(rotn, 1) : PG8_KO(rotc, t + 3); (void)ko1; (void)ko2; (void)ko3;
            PG8_LDB(B0, 0, 0); PG8_LDB(B1, 0, 1); PG8_SCHED; PG8_LDA(At, 0, 0); PG8_STAGE_A(1, 1, a1 + hstepA, ko1, false);
            PG8_WAIT_V(8); PG8_WAIT_L(0); PG8_BAR; PG8_MMA(0, 0, At, B0); PG8_MMA(0, 1, At, B1); PG8_BAR; PG8_SCHED;
            PG8_LDA(At, 0, 1); PG8_STAGE(PG8_SB(0, 0), b2, voffB); PG8_STAGE(PG8_SB(0, 1), b2 + hstepB, voffB); PG8_STAGE_A(0, 0, a2, ko2, last);
            PG8_WAIT_V(8); PG8_WAIT_L(0); PG8_BAR; PG8_MMA(1, 0, At, B0); PG8_MMA(1, 1, At, B1); PG8_BAR; PG8_SCHED;
            PG8_LDB(B0, 1, 0); PG8_LDB(B1, 1, 1); PG8_SCHED; PG8_LDA(At, 1, 0); PG8_STAGE_A(0, 1, a2 + hstepA, ko2, last);
            PG8_WAIT_V(8); PG8_WAIT_L(0); PG8_BAR; PG8_MMA(0, 0, At, B0); PG8_MMA(0, 1, At, B1); PG8_BAR; PG8_SCHED;
            PG8_LDA(At, 1, 1); PG8_STAGE(PG8_SB(1, 0), b3, voffB); PG8_STAGE(PG8_SB(1, 1), b3 + hstepB, voffB); PG8_STAGE_A(1, 0, a3, ko3, last);
            PG8_WAIT_V(8); PG8_WAIT_L(0); PG8_BAR; PG8_MMA(1, 0, At, B0); PG8_MMA(1, 1, At, B1); PG8_BAR; PG8_SCHED;
        }
        if constexpr (ALIGN_EPI) { if (wr == 0) PG8_BAR; }
        if constexpr (I8) {
#pragma unroll
            for (int a = 0; a < 2; ++a)
#pragma unroll
                for (int b = 0; b < 2; ++b)
#pragma unroll
                    for (int m = 0; m < 4; ++m)
#pragma unroll
                        for (int n = 0; n < 2; ++n) { const v4i32_t q = __builtin_bit_cast(v4i32_t, acc[a][b][m][n]); acc[a][b][m][n] = (f32x4){(float)q[0], (float)q[1], (float)q[2], (float)q[3]}; }
        }
        E(acc, cur, wr, wc, fr, fq);
        if (!has_next) break;
#pragma unroll
        for (int a = 0; a < 2; ++a)
#pragma unroll
            for (int b = 0; b < 2; ++b)
#pragma unroll
                for (int m = 0; m < 4; ++m)
#pragma unroll
                    for (int n = 0; n < 2; ++n) acc[a][b][m][n] = (f32x4){0.f, 0.f, 0.f, 0.f};
        cur = nxt; cA = nA; cB = nB; rotc = rotn; ++ui;
        if constexpr (Sched::GATHER) { gvc[0][0] = gvn[0][0]; gvc[0][1] = gvn[0][1]; gvc[1][0] = gvn[1][0]; gvc[1][1] = gvn[1][1]; }
        if constexpr (ALIGN_EPI) { if (wr == 1) PG8_BAR; }
    }
    PG8_WAIT_V(0);
    if constexpr (!ALIGN_EPI) { if (wr == 0) PG8_BAR; }
    PG8_BAR;
#undef PG8_SA
#undef PG8_SB
#undef PG8_STAGE
#undef PG8_STAGE_A
#undef PG8_LDA
#undef PG8_LDB
#undef PG8_MMA
#undef PG8_ROT
#undef PG8_KO
#undef PG8_WAIT_V
#undef PG8_WAIT_L
#undef PG8_BAR
#undef PG8_SCHED
}
}

namespace att {
typedef LAS const char* lds_cptr;
typedef short v4i16_t __attribute__((ext_vector_type(4)));
typedef float f32x2_t __attribute__((ext_vector_type(2))); typedef __bf16 bf16x2_t __attribute__((ext_vector_type(2)));
__device__ __forceinline__ int crow(int r, int hi) { return (r & 3) + 8 * (r >> 2) + 4 * hi; }
__device__ __forceinline__ void glds16(const GAS void* gsrc, unsigned lds_dst) { unsigned keep;
    asm volatile("s_mov_b32 %0, m0\n\ts_mov_b32 m0, %2\n\ts_nop 0\n\tglobal_load_lds_dwordx4 %1, off\n\ts_mov_b32 m0, %0" : "=&s"(keep) : "v"(gsrc), "s"(lds_dst) : "memory"); }
__device__ __forceinline__ void glds16s(const GAS void* sbase, unsigned voff, unsigned lds_dst) { unsigned keep;
    asm volatile("s_mov_b32 %0, m0\n\ts_mov_b32 m0, %3\n\ts_nop 0\n\tglobal_load_lds_dwordx4 %1, %2\n\ts_mov_b32 m0, %0" : "=&s"(keep) : "v"(voff), "s"(sbase), "s"(lds_dst) : "memory"); }
__device__ __forceinline__ unsigned cvtpk_s(float lo, float hi) { f32x2_t v = {lo, hi}; bf16x2_t b = __builtin_convertvector(v, bf16x2_t); return __builtin_bit_cast(unsigned, b); }
#define ATT_WAIT_BAR() asm volatile("s_waitcnt vmcnt(0) lgkmcnt(0)\n\ts_barrier" ::: "memory")
constexpr float THR = 8.0f;

template <int NQ> __device__ __forceinline__ void qk_tile(f32x16& p0, f32x16& p1, lds_cptr kslot, const bf16x8* qr, const f32x16& negm, int r32, int hi) {
    lds_cptr kb = kslot + hi * 1024 + r32 * 16;
    p0 = negm; p1 = negm;
#pragma unroll
    for (int d0 = 0; d0 < NQ; ++d0) {
        const bf16x8 b0 = *(const LAS bf16x8*)(kb + d0 * 2048);
        const bf16x8 b1 = *(const LAS bf16x8*)(kb + d0 * 2048 + 512);
        p0 = __builtin_amdgcn_mfma_f32_32x32x16_bf16(b0, qr[d0], p0, 0, 0, 0);
        p1 = __builtin_amdgcn_mfma_f32_32x32x16_bf16(b1, qr[d0], p1, 0, 0, 0);
    }
}
__device__ __forceinline__ void pv(f32x16* o, int vb, bf16x8 pa0, bf16x8 pa1, bf16x8 pa2, bf16x8 pa3) {
#pragma unroll
    for (int d0 = 0; d0 < 2; ++d0) { s16x4 lo[4], hi[4];
#pragma unroll
        for (int ks = 0; ks < 4; ++ks) {
            asm volatile("ds_read_b64_tr_b16 %0,%1 offset:%c2" : "=&v"(lo[ks]) : "v"(vb), "i"(d0 * 4096 + ks * 1024) : "memory");
            asm volatile("ds_read_b64_tr_b16 %0,%1 offset:%c2" : "=&v"(hi[ks]) : "v"(vb), "i"(d0 * 4096 + ks * 1024 + 512) : "memory"); }
        asm volatile("s_waitcnt lgkmcnt(0)" ::: "memory"); __builtin_amdgcn_sched_barrier(0);
#define PK(k) (bf16x8){lo[k][0], lo[k][1], lo[k][2], lo[k][3], hi[k][0], hi[k][1], hi[k][2], hi[k][3]}
        o[d0] = __builtin_amdgcn_mfma_f32_32x32x16_bf16(pa0, PK(0), o[d0], 0, 0, 0);
        o[d0] = __builtin_amdgcn_mfma_f32_32x32x16_bf16(pa1, PK(1), o[d0], 0, 0, 0);
        o[d0] = __builtin_amdgcn_mfma_f32_32x32x16_bf16(pa2, PK(2), o[d0], 0, 0, 0);
        o[d0] = __builtin_amdgcn_mfma_f32_32x32x16_bf16(pa3, PK(3), o[d0], 0, 0, 0);
#undef PK
    }
}
__device__ __forceinline__ void softmax_pv(f32x16& p0, f32x16& p1, float& mhat, float& l_reg, f32x16& negm, f32x16* o, bool first, LAS float* wsf, int vb, int r32, int hi) {
    float a = __builtin_fmaxf(p0[0], p1[0]);
#pragma unroll
    for (int r = 1; r < 16; ++r) a = __builtin_fmaxf(a, __builtin_fmaxf(p0[r], p1[r]));
    float rm = a;
    { auto rr = __builtin_amdgcn_permlane32_swap(__float_as_uint(rm), __float_as_uint(rm), false, false); rm = __builtin_fmaxf(__uint_as_float(rr[0]), __uint_as_float(rr[1])); }
    if (first) {
        const float dl = rm; mhat += dl;
#pragma unroll
        for (int r = 0; r < 16; ++r) { p0[r] -= dl; p1[r] -= dl; }
#pragma unroll
        for (int r = 0; r < 16; ++r) negm[r] = -mhat;
    } else if (__any(rm > THR)) {
        const float dl = __builtin_fmaxf(rm, 0.f); mhat += dl;
#pragma unroll
        for (int r = 0; r < 16; ++r) { p0[r] -= dl; p1[r] -= dl; }
#pragma unroll
        for (int r = 0; r < 16; ++r) negm[r] = -mhat;
        const float f = __builtin_amdgcn_exp2f(-dl); l_reg *= f;
        if (hi == 0) wsf[r32] = f;
        LDS_WAIT();
#pragma unroll
        for (int r = 0; r < 16; ++r) { const float fr_ = wsf[crow(r, hi)]; o[0][r] *= fr_; o[1][r] *= fr_; }
        LDS_WAIT();
    }
    float sacc = 0.f;
#pragma unroll
    for (int r = 0; r < 16; ++r) { p0[r] = __builtin_amdgcn_exp2f(p0[r]); p1[r] = __builtin_amdgcn_exp2f(p1[r]); sacc += p0[r] + p1[r]; }
    l_reg += sacc;
    u32x4 pw0, pw1, pw2, pw3;
    pw0 = (u32x4){cvtpk_s(p0[0], p0[1]), cvtpk_s(p0[2], p0[3]), cvtpk_s(p0[4], p0[5]), cvtpk_s(p0[6], p0[7])};
    pw1 = (u32x4){cvtpk_s(p0[8], p0[9]), cvtpk_s(p0[10], p0[11]), cvtpk_s(p0[12], p0[13]), cvtpk_s(p0[14], p0[15])};
    pw2 = (u32x4){cvtpk_s(p1[0], p1[1]), cvtpk_s(p1[2], p1[3]), cvtpk_s(p1[4], p1[5]), cvtpk_s(p1[6], p1[7])};
    pw3 = (u32x4){cvtpk_s(p1[8], p1[9]), cvtpk_s(p1[10], p1[11]), cvtpk_s(p1[12], p1[13]), cvtpk_s(p1[14], p1[15])};
    pv(o, vb, __builtin_bit_cast(bf16x8, pw0), __builtin_bit_cast(bf16x8, pw1), __builtin_bit_cast(bf16x8, pw2), __builtin_bit_cast(bf16x8, pw3));
}
__device__ __forceinline__ void softmax_pv_fixed(f32x16& p0, f32x16& p1, float& l_reg, f32x16* o, int vb) {
    float sacc = 0.f;
#pragma unroll
    for (int r = 0; r < 16; ++r) { p0[r] = __builtin_amdgcn_exp2f(p0[r]); p1[r] = __builtin_amdgcn_exp2f(p1[r]); sacc += p0[r] + p1[r]; }
    l_reg += sacc;
    u32x4 pw0, pw1, pw2, pw3;
    pw0 = (u32x4){cvtpk_s(p0[0], p0[1]), cvtpk_s(p0[2], p0[3]), cvtpk_s(p0[4], p0[5]), cvtpk_s(p0[6], p0[7])};
    pw1 = (u32x4){cvtpk_s(p0[8], p0[9]), cvtpk_s(p0[10], p0[11]), cvtpk_s(p0[12], p0[13]), cvtpk_s(p0[14], p0[15])};
    pw2 = (u32x4){cvtpk_s(p1[0], p1[1]), cvtpk_s(p1[2], p1[3]), cvtpk_s(p1[4], p1[5]), cvtpk_s(p1[6], p1[7])};
    pw3 = (u32x4){cvtpk_s(p1[8], p1[9]), cvtpk_s(p1[10], p1[11]), cvtpk_s(p1[12], p1[13]), cvtpk_s(p1[14], p1[15])};
    pv(o, vb, __builtin_bit_cast(bf16x8, pw0), __builtin_bit_cast(bf16x8, pw1), __builtin_bit_cast(bf16x8, pw2), __builtin_bit_cast(bf16x8, pw3));
}
__device__ __forceinline__ void store_o(const f32x16* o, float l_reg, LAS float* wsf, LAS bf16_t* stg, GAS bf16_t* Ow, int pitch, int lane, int r32, int hi) {
    { auto rr = __builtin_amdgcn_permlane32_swap(__float_as_uint(l_reg), __float_as_uint(l_reg), false, false); l_reg = __uint_as_float(rr[0]) + __uint_as_float(rr[1]); }
    if (hi == 0) wsf[32 + r32] = l_reg;
    LDS_WAIT();
    float rli[16];
#pragma unroll
    for (int r = 0; r < 16; ++r) rli[r] = __builtin_amdgcn_rcpf(wsf[32 + crow(r, hi)]);
#pragma unroll
    for (int r = 0; r < 16; ++r) { const int orow = crow(r, hi);
#pragma unroll
        for (int d0 = 0; d0 < 2; ++d0) stg[orow * 64 + d0 * 32 + r32] = (bf16_t)(cvt_pk_bf16(o[d0][r] * rli[r], 0.f) & 0xffffu); }
    LDS_WAIT();
#pragma unroll
    for (int i = 0; i < 4; ++i) { const int row = i * 8 + (lane >> 3), ch = lane & 7; const u32x4 v = *(const LAS u32x4*)(stg + row * 64 + ch * 8); *(GAS u32x4*)(Ow + (size_t)row * pitch + ch * 8) = v; }
    LDS_WAIT();
}

constexpr int M_NS = 4, M_KSLOT = 12288, M_VSLOT = 8192, M_LK = 0, M_LV = M_NS * M_KSLOT, M_LWS = M_LV + M_NS * M_VSLOT, M_LOST = M_LWS + 2048, M_LDS = M_LOST + 32768;
#define ATT_WAITN_BAR(N) asm volatile("s_waitcnt vmcnt(" #N ") lgkmcnt(0)\n\ts_barrier" ::: "memory")
__device__ __forceinline__ void mla_load_q(bf16x8 (&qr)[6], const GAS unsigned char* Qrow, const GAS float* gbq, const GAS float* rope, int pos, int hi) {
    u32x2 q8[6];
#pragma unroll
    for (int d0 = 0; d0 < 6; ++d0) q8[d0] = *(const GAS u32x2*)(Qrow + d0 * 16 + hi * 8);
    float f[6][8]; float ss = 0.f;
#pragma unroll
    for (int d0 = 0; d0 < 6; ++d0) { const int wx = (int)q8[d0].x, wy = (int)q8[d0].y;
        f[d0][0] = __builtin_amdgcn_cvt_f32_fp8(wx, 0); f[d0][1] = __builtin_amdgcn_cvt_f32_fp8(wx, 1); f[d0][2] = __builtin_amdgcn_cvt_f32_fp8(wx, 2); f[d0][3] = __builtin_amdgcn_cvt_f32_fp8(wx, 3);
        f[d0][4] = __builtin_amdgcn_cvt_f32_fp8(wy, 0); f[d0][5] = __builtin_amdgcn_cvt_f32_fp8(wy, 1); f[d0][6] = __builtin_amdgcn_cvt_f32_fp8(wy, 2); f[d0][7] = __builtin_amdgcn_cvt_f32_fp8(wy, 3);
#pragma unroll
        for (int j = 0; j < 8; ++j) ss += f[d0][j] * f[d0][j]; }
    ss += __shfl_xor(ss, 32);
    const float rs = __builtin_amdgcn_rsqf(ss * (1.0f / 96.0f) + EPS) * C2B;
#pragma unroll
    for (int d0 = 0; d0 < 6; ++d0) { const f32x4 g0 = *(const GAS f32x4*)(gbq + 16 * d0 + 8 * hi), g1 = *(const GAS f32x4*)(gbq + 16 * d0 + 8 * hi + 4);
        f[d0][0] *= rs * g0.x; f[d0][1] *= rs * g0.y; f[d0][2] *= rs * g0.z; f[d0][3] *= rs * g0.w; f[d0][4] *= rs * g1.x; f[d0][5] *= rs * g1.y; f[d0][6] *= rs * g1.z; f[d0][7] *= rs * g1.w; }
    { const GAS float* rp = rope + (size_t)pos * 32 + 8 * hi; const f32x4 c0 = *(const GAS f32x4*)rp, c1 = *(const GAS f32x4*)(rp + 4), s0 = *(const GAS f32x4*)(rp + 16), s1 = *(const GAS f32x4*)(rp + 20);
      const float cs[8] = {c0.x, c0.y, c0.z, c0.w, c1.x, c1.y, c1.z, c1.w}, sn[8] = {s0.x, s0.y, s0.z, s0.w, s1.x, s1.y, s1.z, s1.w};
#pragma unroll
      for (int j = 0; j < 8; ++j) { const float a = f[4][j], c = f[5][j]; f[4][j] = a * cs[j] - c * sn[j]; f[5][j] = a * sn[j] + c * cs[j]; } }
#pragma unroll
    for (int d0 = 0; d0 < 6; ++d0) { u32x4 w; w.x = cvt_pk_bf16(f[d0][0], f[d0][1]); w.y = cvt_pk_bf16(f[d0][2], f[d0][3]); w.z = cvt_pk_bf16(f[d0][4], f[d0][5]); w.w = cvt_pk_bf16(f[d0][6], f[d0][7]); qr[d0] = __builtin_bit_cast(bf16x8, w); }
}
__device__ __forceinline__ void qk_tile2(f32x16& a0, f32x16& a1, f32x16& b0, f32x16& b1, lds_cptr kslot, const bf16x8* qa, const bf16x8* qb, int r32, int hi) {
    lds_cptr kb = kslot + hi * 1024 + r32 * 16;
    a0 = f32x16{}; a1 = f32x16{}; b0 = f32x16{}; b1 = f32x16{};
    bf16x8 k0 = *(const LAS bf16x8*)(kb), k1 = *(const LAS bf16x8*)(kb + 512);
#pragma unroll
    for (int d0 = 0; d0 < 6; ++d0) {
        bf16x8 n0 = k0, n1 = k1;
        if (d0 < 5) { n0 = *(const LAS bf16x8*)(kb + (d0 + 1) * 2048); n1 = *(const LAS bf16x8*)(kb + (d0 + 1) * 2048 + 512); }
        __builtin_amdgcn_sched_barrier(0);
        a0 = __builtin_amdgcn_mfma_f32_32x32x16_bf16(k0, qa[d0], a0, 0, 0, 0);
        a1 = __builtin_amdgcn_mfma_f32_32x32x16_bf16(k1, qa[d0], a1, 0, 0, 0);
        b0 = __builtin_amdgcn_mfma_f32_32x32x16_bf16(k0, qb[d0], b0, 0, 0, 0);
        b1 = __builtin_amdgcn_mfma_f32_32x32x16_bf16(k1, qb[d0], b1, 0, 0, 0);
        __builtin_amdgcn_sched_barrier(0);
        k0 = n0; k1 = n1;
    }
}
__device__ __forceinline__ void exp_pack(f32x16& p0, f32x16& p1, float& l_reg, bf16x8 (&pa)[4], float sub) {
    float sacc = 0.f;
    if (sub != 0.f) {
#pragma unroll
        for (int r = 0; r < 16; ++r) { p0[r] -= sub; p1[r] -= sub; } }
#pragma unroll
    for (int r = 0; r < 16; ++r) { p0[r] = __builtin_amdgcn_exp2f(p0[r]); p1[r] = __builtin_amdgcn_exp2f(p1[r]); sacc += p0[r] + p1[r]; }
    l_reg += sacc;
    pa[0] = __builtin_bit_cast(bf16x8, (u32x4){cvtpk_s(p0[0], p0[1]), cvtpk_s(p0[2], p0[3]), cvtpk_s(p0[4], p0[5]), cvtpk_s(p0[6], p0[7])});
    pa[1] = __builtin_bit_cast(bf16x8, (u32x4){cvtpk_s(p0[8], p0[9]), cvtpk_s(p0[10], p0[11]), cvtpk_s(p0[12], p0[13]), cvtpk_s(p0[14], p0[15])});
    pa[2] = __builtin_bit_cast(bf16x8, (u32x4){cvtpk_s(p1[0], p1[1]), cvtpk_s(p1[2], p1[3]), cvtpk_s(p1[4], p1[5]), cvtpk_s(p1[6], p1[7])});
    pa[3] = __builtin_bit_cast(bf16x8, (u32x4){cvtpk_s(p1[8], p1[9]), cvtpk_s(p1[10], p1[11]), cvtpk_s(p1[12], p1[13]), cvtpk_s(p1[14], p1[15])});
}
__device__ __forceinline__ void pv2(f32x16* oa, f32x16* ob, int vb, const bf16x8 (&pa)[4], const bf16x8 (&pb)[4], bool doA, bool doB) {
    s16x4 lo[2][4], hi[2][4];
#pragma unroll
    for (int d0 = 0; d0 < 2; ++d0)
#pragma unroll
        for (int ks = 0; ks < 4; ++ks) {
            asm volatile("ds_read_b64_tr_b16 %0,%1 offset:%c2" : "=&v"(lo[d0][ks]) : "v"(vb), "i"(d0 * 4096 + ks * 1024) : "memory");
            asm volatile("ds_read_b64_tr_b16 %0,%1 offset:%c2" : "=&v"(hi[d0][ks]) : "v"(vb), "i"(d0 * 4096 + ks * 1024 + 512) : "memory"); }
#define PK(d, k) (bf16x8){lo[d][k][0], lo[d][k][1], lo[d][k][2], lo[d][k][3], hi[d][k][0], hi[d][k][1], hi[d][k][2], hi[d][k][3]}
#pragma unroll
    for (int d0 = 0; d0 < 2; ++d0) {
        if (d0 == 0) asm volatile("s_waitcnt lgkmcnt(8)" ::: "memory"); else asm volatile("s_waitcnt lgkmcnt(0)" ::: "memory");
        __builtin_amdgcn_sched_barrier(0);
        if (doA) {
#pragma unroll
            for (int k = 0; k < 4; ++k) oa[d0] = __builtin_amdgcn_mfma_f32_32x32x16_bf16(pa[k], PK(d0, k), oa[d0], 0, 0, 0); }
        if (doB) {
#pragma unroll
            for (int k = 0; k < 4; ++k) ob[d0] = __builtin_amdgcn_mfma_f32_32x32x16_bf16(pb[k], PK(d0, k), ob[d0], 0, 0, 0); }
    }
#undef PK
}
__device__ __forceinline__ void qk_one(f32x16& a0, f32x16& a1, lds_cptr kslot, const bf16x8* qa, int r32, int hi) {
    lds_cptr kb = kslot + hi * 1024 + r32 * 16;
    a0 = f32x16{}; a1 = f32x16{};
    bf16x8 k0 = *(const LAS bf16x8*)(kb), k1 = *(const LAS bf16x8*)(kb + 512);
#pragma unroll
    for (int d0 = 0; d0 < 6; ++d0) {
        bf16x8 n0 = k0, n1 = k1;
        if (d0 < 5) { n0 = *(const LAS bf16x8*)(kb + (d0 + 1) * 2048); n1 = *(const LAS bf16x8*)(kb + (d0 + 1) * 2048 + 512); }
        __builtin_amdgcn_sched_barrier(0);
        a0 = __builtin_amdgcn_mfma_f32_32x32x16_bf16(k0, qa[d0], a0, 0, 0, 0);
        a1 = __builtin_amdgcn_mfma_f32_32x32x16_bf16(k1, qa[d0], a1, 0, 0, 0);
        __builtin_amdgcn_sched_barrier(0);
        k0 = n0; k1 = n1;
    }
}
__device__ __forceinline__ void qkB_expA(f32x16& b0, f32x16& b1, f32x16& pA0, f32x16& pA1, float& la, bf16x8 (&pa)[4], lds_cptr kslot, const bf16x8* qb, int r32, int hi) {
    lds_cptr kb = kslot + hi * 1024 + r32 * 16;
    b0 = f32x16{}; b1 = f32x16{};
    bf16x8 k0 = *(const LAS bf16x8*)(kb), k1 = *(const LAS bf16x8*)(kb + 512);
    float sacc = 0.f;
#define EXPG(g) do { f32x16& P_ = ((g) < 4) ? pA0 : pA1; constexpr int r0_ = 4 * ((g) & 3); \
        float e0_ = __builtin_amdgcn_exp2f(P_[r0_]), e1_ = __builtin_amdgcn_exp2f(P_[r0_ + 1]), e2_ = __builtin_amdgcn_exp2f(P_[r0_ + 2]), e3_ = __builtin_amdgcn_exp2f(P_[r0_ + 3]); \
        sacc += (e0_ + e1_) + (e2_ + e3_); asm volatile("" : "+v"(e0_), "+v"(e1_), "+v"(e2_), "+v"(e3_), "+v"(sacc)); P_[r0_] = e0_; P_[r0_ + 1] = e1_; P_[r0_ + 2] = e2_; P_[r0_ + 3] = e3_; } while (0)
#define PACK(j) do { const f32x16& P_ = ((j) < 2) ? pA0 : pA1; constexpr int r0_ = 8 * ((j) & 1); u32x4 w_ = {cvtpk_s(P_[r0_], P_[r0_ + 1]), cvtpk_s(P_[r0_ + 2], P_[r0_ + 3]), cvtpk_s(P_[r0_ + 4], P_[r0_ + 5]), cvtpk_s(P_[r0_ + 6], P_[r0_ + 7])}; \
        asm volatile("" : "+v"(w_)); pa[j] = __builtin_bit_cast(bf16x8, w_); } while (0)
#pragma unroll
    for (int d0 = 0; d0 < 6; ++d0) {
        bf16x8 n0 = k0, n1 = k1;
        if (d0 < 5) { n0 = *(const LAS bf16x8*)(kb + (d0 + 1) * 2048); n1 = *(const LAS bf16x8*)(kb + (d0 + 1) * 2048 + 512); }
        __builtin_amdgcn_sched_barrier(0);
        b0 = __builtin_amdgcn_mfma_f32_32x32x16_bf16(k0, qb[d0], b0, 0, 0, 0);
        if (d0 == 0) EXPG(0); else if (d0 == 1) EXPG(2); else if (d0 == 2) EXPG(4); else if (d0 == 3) EXPG(6); else if (d0 == 4) PACK(0); else PACK(2);
        __builtin_amdgcn_sched_barrier(0);
        b1 = __builtin_amdgcn_mfma_f32_32x32x16_bf16(k1, qb[d0], b1, 0, 0, 0);
        if (d0 == 0) EXPG(1); else if (d0 == 1) EXPG(3); else if (d0 == 2) EXPG(5); else if (d0 == 3) EXPG(7); else if (d0 == 4) PACK(1); else PACK(3);
        __builtin_amdgcn_sched_barrier(0);
        k0 = n0; k1 = n1;
    }
#undef EXPG
#undef PACK
    la += sacc;
}
__device__ __forceinline__ void tail_pvA_expB_pvB(f32x16& pB0, f32x16& pB1, float& lb, const bf16x8 (&pa)[4], f32x16* oa, f32x16* ob, int vb) {
    s16x4 lo[2][4], hi[2][4];
#pragma unroll
    for (int d0 = 0; d0 < 2; ++d0)
#pragma unroll
        for (int ks = 0; ks < 4; ++ks) {
            asm volatile("ds_read_b64_tr_b16 %0,%1 offset:%c2" : "=&v"(lo[d0][ks]) : "v"(vb), "i"(d0 * 4096 + ks * 1024) : "memory");
            asm volatile("ds_read_b64_tr_b16 %0,%1 offset:%c2" : "=&v"(hi[d0][ks]) : "v"(vb), "i"(d0 * 4096 + ks * 1024 + 512) : "memory"); }
#define PK(d, k) (bf16x8){lo[d][k][0], lo[d][k][1], lo[d][k][2], lo[d][k][3], hi[d][k][0], hi[d][k][1], hi[d][k][2], hi[d][k][3]}
#define EXPG(g) do { f32x16& P_ = ((g) < 4) ? pB0 : pB1; constexpr int r0_ = 4 * ((g) & 3); \
        float e0_ = __builtin_amdgcn_exp2f(P_[r0_]), e1_ = __builtin_amdgcn_exp2f(P_[r0_ + 1]), e2_ = __builtin_amdgcn_exp2f(P_[r0_ + 2]), e3_ = __builtin_amdgcn_exp2f(P_[r0_ + 3]); \
        sacc += (e0_ + e1_) + (e2_ + e3_); asm volatile("" : "+v"(e0_), "+v"(e1_), "+v"(e2_), "+v"(e3_), "+v"(sacc)); P_[r0_] = e0_; P_[r0_ + 1] = e1_; P_[r0_ + 2] = e2_; P_[r0_ + 3] = e3_; } while (0)
    float sacc = 0.f;
    EXPG(0);
    asm volatile("s_waitcnt lgkmcnt(8)" ::: "memory"); __builtin_amdgcn_sched_barrier(0);
#define STEP(g) do { oa[(g) >> 2] = __builtin_amdgcn_mfma_f32_32x32x16_bf16(pa[(g) & 3], PK((g) >> 2, (g) & 3), oa[(g) >> 2], 0, 0, 0); \
        if ((g) + 1 < 8) EXPG((g) + 1); if ((g) == 3) asm volatile("s_waitcnt lgkmcnt(0)" ::: "memory"); __builtin_amdgcn_sched_barrier(0); } while (0)
    STEP(0); STEP(1); STEP(2); STEP(3); STEP(4); STEP(5); STEP(6); STEP(7);
#undef STEP
#undef EXPG
    lb += sacc;
    bf16x8 pb[4];
    pb[0] = __builtin_bit_cast(bf16x8, (u32x4){cvtpk_s(pB0[0], pB0[1]), cvtpk_s(pB0[2], pB0[3]), cvtpk_s(pB0[4], pB0[5]), cvtpk_s(pB0[6], pB0[7])});
    pb[1] = __builtin_bit_cast(bf16x8, (u32x4){cvtpk_s(pB0[8], pB0[9]), cvtpk_s(pB0[10], pB0[11]), cvtpk_s(pB0[12], pB0[13]), cvtpk_s(pB0[14], pB0[15])});
    pb[2] = __builtin_bit_cast(bf16x8, (u32x4){cvtpk_s(pB1[0], pB1[1]), cvtpk_s(pB1[2], pB1[3]), cvtpk_s(pB1[4], pB1[5]), cvtpk_s(pB1[6], pB1[7])});
    pb[3] = __builtin_bit_cast(bf16x8, (u32x4){cvtpk_s(pB1[8], pB1[9]), cvtpk_s(pB1[10], pB1[11]), cvtpk_s(pB1[12], pB1[13]), cvtpk_s(pB1[14], pB1[15])});
#pragma unroll
    for (int d0 = 0; d0 < 2; ++d0)
#pragma unroll
        for (int k = 0; k < 4; ++k) ob[d0] = __builtin_amdgcn_mfma_f32_32x32x16_bf16(pb[k], PK(d0, k), ob[d0], 0, 0, 0);
#undef PK
}
__device__ __forceinline__ void store_o8(const f32x16* o, float l_reg, LAS float* wsf, LAS unsigned char* stg, GAS unsigned char* Ow8, int pitch, int lane, int r32, int hi) {
    { auto rr = __builtin_amdgcn_permlane32_swap(__float_as_uint(l_reg), __float_as_uint(l_reg), false, false); l_reg = __uint_as_float(rr[0]) + __uint_as_float(rr[1]); }
    if (hi == 0) wsf[32 + r32] = l_reg;
    LDS_WAIT();
    float rli[16];
#pragma unroll
    for (int r = 0; r < 16; ++r) rli[r] = __builtin_amdgcn_rcpf(wsf[32 + crow(r, hi)]);
#pragma unroll
    for (int r = 0; r < 16; ++r) { const int orow = crow(r, hi);
        const int p = __builtin_amdgcn_cvt_pk_fp8_f32(o[0][r] * rli[r], o[1][r] * rli[r], 0, false);
        stg[orow * 64 + r32] = (unsigned char)(p & 0xff); stg[orow * 64 + 32 + r32] = (unsigned char)((p >> 8) & 0xff); }
    LDS_WAIT();
    { const int row = lane >> 1, hf = lane & 1; const u32x4 v0 = *(const LAS u32x4*)(stg + row * 64 + hf * 32), v1 = *(const LAS u32x4*)(stg + row * 64 + hf * 32 + 16);
      GAS unsigned char* d = Ow8 + (size_t)row * pitch + hf * 32; *(GAS u32x4*)d = v0; *(GAS u32x4*)(d + 16) = v1; }
    LDS_WAIT();
}
__device__ __forceinline__ void mla_unit(int b, int h, int qb, const GAS bf16_t* Q, const GAS bf16_t* K, const GAS bf16_t* V, GAS bf16_t* O, char* shm, float mfix, const GAS float* gbq, const GAS float* rope) {
    int tid_ = threadIdx.x; asm volatile("" : "+v"(tid_));
    const int tid = tid_, lane = tid & 63, r32 = lane & 31, hi = lane >> 5; const int wid = __builtin_amdgcn_readfirstlane(tid >> 6);
    const long rowbase = (long)b * SEQ; const int q0 = qb * 512;
    const unsigned lds0 = (unsigned)(uintptr_t)shm;
    const lds_cptr shm3 = (lds_cptr)shm;
    LAS float* wsf = (LAS float*)(shm3 + M_LWS) + wid * 64;
    const GAS bf16_t* Kb = K + (size_t)((b * 8 + h) * 64) * 12 * 512; const GAS bf16_t* Vb = V + rowbase * 1024 + h * 128 + 64;
    const unsigned kof0 = (unsigned)(lane * 8) * 2u;
    const unsigned vof = (unsigned)((16 * (wid & 3) + (lane >> 2)) * 1024 + (wid >> 2) * 32 + (lane & 3) * 8) * 2u;
    const int vb0 = (int)(lds0 + M_LV) + ((lane >> 4) & 1) * 32 + (lane & 3) * 8 + (4 * hi + ((lane & 15) >> 2)) * 64;
#define MLA_DMA(t, s) do { const GAS bf16_t* kt_ = Kb + (size_t)(t) * 12 * 512; const GAS bf16_t* vt_ = Vb + (size_t)(t) * 64 * 1024; \
        glds16s(kt_ + wid * 512, kof0, (unsigned)__builtin_amdgcn_readfirstlane(lds0 + M_LK + (s) * M_KSLOT + wid * 1024)); \
        glds16s(kt_ + (8 + (wid & 3)) * 512, kof0, (unsigned)__builtin_amdgcn_readfirstlane(lds0 + M_LK + (s) * M_KSLOT + (8 + (wid & 3)) * 1024)); \
        glds16s(vt_, vof, (unsigned)__builtin_amdgcn_readfirstlane(lds0 + M_LV + (s) * M_VSLOT + wid * 1024)); } while (0)
    const int NT = 8 * (qb + 1);
    MLA_DMA(0, 0); MLA_DMA(1, 1); MLA_DMA(2, 2);
    bf16x8 qa[6], qbb[6];
    mla_load_q(qa, (const GAS unsigned char*)Q + (rowbase + q0 + wid * 64 + r32) * 768 + h * 96, gbq, rope, q0 + wid * 64 + r32, hi);
    mla_load_q(qbb, (const GAS unsigned char*)Q + (rowbase + q0 + wid * 64 + 32 + r32) * 768 + h * 96, gbq, rope, q0 + wid * 64 + 32 + r32, hi);
    float la = 0.f, lb = 0.f; f32x16 oa[2], ob[2]; oa[0] = f32x16{}; oa[1] = f32x16{}; ob[0] = f32x16{}; ob[1] = f32x16{};
    const float sub = __builtin_fmaxf(mfix - 40.0f, 0.0f);
    const int qrelA = wid * 64 + r32, qrelB = qrelA + 32;
    const int NTw = NT - 7 + wid;
    for (int t = 0; t < NT; ++t) {
        const int rem = NT - 1 - t;
        if (rem >= 2) ATT_WAITN_BAR(6); else if (rem == 1) ATT_WAITN_BAR(3); else ATT_WAITN_BAR(0);
        if (t + 3 < NT) MLA_DMA(t + 3, (t + 3) & 3);
        if (t >= NTw) continue;
        const int s = t & 3, jb = t - (NT - 8);
        f32x16 pA0, pA1, pB0, pB1; bf16x8 pa[4];
        const int kb = 64 * jb + 4 * hi;
        qk_one(pA0, pA1, shm3 + M_LK + s * M_KSLOT, qa, r32, hi);
        if (jb >= 0) {
#pragma unroll
            for (int r = 0; r < 16; ++r) { const int kv = kb + (r & 3) + 8 * (r >> 2); if (kv > qrelA) pA0[r] = -INFINITY; if (kv + 32 > qrelA) pA1[r] = -INFINITY; } }
        if (sub != 0.f) {
#pragma unroll
            for (int r = 0; r < 16; ++r) { pA0[r] -= sub; pA1[r] -= sub; } }
        qkB_expA(pB0, pB1, pA0, pA1, la, pa, shm3 + M_LK + s * M_KSLOT, qbb, r32, hi);
        if (jb >= 0) {
#pragma unroll
            for (int r = 0; r < 16; ++r) { const int kv = kb + (r & 3) + 8 * (r >> 2); if (kv > qrelB) pB0[r] = -INFINITY; if (kv + 32 > qrelB) pB1[r] = -INFINITY; } }
        if (sub != 0.f) {
#pragma unroll
            for (int r = 0; r < 16; ++r) { pB0[r] -= sub; pB1[r] -= sub; } }
        tail_pvA_expB_pvB(pB0, pB1, lb, pa, oa, ob, vb0 + s * M_VSLOT);
    }
    store_o8(oa, la, wsf, (LAS unsigned char*)(shm3 + M_LOST) + wid * 4096, (GAS unsigned char*)O + (rowbase + q0 + wid * 64) * 1024 + 512 + h * 64, 1024, lane, r32, hi);
    store_o8(ob, lb, wsf, (LAS unsigned char*)(shm3 + M_LOST) + wid * 4096, (GAS unsigned char*)O + (rowbase + q0 + wid * 64 + 32) * 1024 + 512 + h * 64, 1024, lane, r32, hi);
    ATT_WAIT_BAR();
#undef MLA_DMA
}

constexpr int S_LK = 0, S_LV = 32768, S_LBIAS = 65536, S_LWS = S_LBIAS + 4096, S_LOST = S_LWS + 2048, S_LDS = S_LOST + 32768;
__device__ __forceinline__ void swa_unit(int b, int n, int g, const GAS bf16_t* P, GAS bf16_t* O, const GAS float* sinks, char* shm, float sbound) {
    int tid_ = threadIdx.x; asm volatile("" : "+v"(tid_));
    const int tid = tid_, lane = tid & 63, r32 = lane & 31, hi = lane >> 5; const int wid = __builtin_amdgcn_readfirstlane(tid >> 6);
    const unsigned lds0 = (unsigned)(uintptr_t)shm;
    const lds_cptr shm3 = (lds_cptr)shm;
    LAS float* wsf = (LAS float*)(shm3 + S_LWS) + wid * 64;
    const LAS float* biasl = (const LAS float*)(shm3 + S_LBIAS);
    const long kb0 = (long)b * SEQ + 128 * (n - 1);
    const int tt0 = (n == 0) ? 2 : 0;
    for (int tt = tt0; tt < 4; ++tt) {
        glds16(P + (kb0 + 64 * tt + lane) * NPROJ1 + C_KA + 64 * g + wid * 8, (unsigned)__builtin_amdgcn_readfirstlane(lds0 + S_LK + tt * 8192 + wid * 1024));
        glds16(P + (kb0 + 64 * tt + 16 * (wid & 3) + (lane >> 2)) * NPROJ1 + C_VA + 64 * g + (wid >> 2) * 32 + (lane & 3) * 8, (unsigned)__builtin_amdgcn_readfirstlane(lds0 + S_LV + tt * 8192 + wid * 1024));
    }
    const int vb0 = (int)(lds0 + S_LV) + ((lane >> 4) & 1) * 32 + (lane & 3) * 8 + (4 * hi + ((lane & 15) >> 2)) * 64;
    ATT_WAIT_BAR();
    for (int pass = 0; pass < 2; ++pass) {
        const int bq = wid + 8 * pass, hg = bq >> 2, j = bq & 3, head = 4 * g + hg;
        const long qrow0 = (long)b * SEQ + 128 * n + 32 * j;
        bf16x8 qr[4];
        { const GAS bf16_t* Qw = P + (qrow0 + r32) * NPROJ1 + C_QA + 64 * head + hi * 8;
#pragma unroll
          for (int d0 = 0; d0 < 4; ++d0) qr[d0] = *(const GAS bf16x8*)(Qw + d0 * 16); }
        const float sink2 = sinks[head] * LOG2E, mfix = __builtin_fmaxf(sbound, sink2);
        float l_reg = (hi == 0) ? __builtin_amdgcn_exp2f(sink2 - mfix) : 0.0f; f32x16 o[2]; o[0] = f32x16{}; o[1] = f32x16{}; f32x16 negm;
#pragma unroll
        for (int r = 0; r < 16; ++r) negm[r] = -mfix;
        const int ts = (j < 2) ? 0 : 1;
        for (int tt = ts; tt < ts + 3; ++tt) {
            if (tt < tt0) continue;
            f32x16 p0, p1;
            qk_tile<4>(p0, p1, shm3 + S_LK + tt * 8192, qr, negm, r32, hi);
            const int dbase = 32 * j + r32 + 128 - 64 * tt - 4 * hi;
#pragma unroll
            for (int r = 0; r < 16; ++r) { const int d0_ = dbase - ((r & 3) + 8 * (r >> 2)), d1_ = d0_ - 32;
                const float b0 = biasl[head * 128 + (d0_ & 127)], b1 = biasl[head * 128 + (d1_ & 127)];
                p0[r] = (d0_ >= 0 && d0_ < 128) ? p0[r] + b0 : -INFINITY;
                p1[r] = (d1_ >= 0 && d1_ < 128) ? p1[r] + b1 : -INFINITY; }
            softmax_pv_fixed(p0, p1, l_reg, o, vb0 + tt * 8192);
        }
        store_o8(o, l_reg, wsf, (LAS unsigned char*)(shm3 + S_LOST) + wid * 4096, (GAS unsigned char*)O + qrow0 * 1024 + 64 * head, 1024, lane, r32, hi);
    }
    ATT_WAIT_BAR();
}
}

#define XB_TMO      128
#define XB_XCNT(j)  (256  + 64 * (j))
#define XB_XSUB(j)  (1280 + 64 * (j))
#define XB_XGEN(j)  (2304 + 64 * (j))
#define XB_TOP      3328
#define XB_TOPGEN   3392
#define XCD_BAR_WORDS 3456
#define XB_SPIN_CAP (1u << 22)
__device__ __forceinline__ unsigned xb_ld(unsigned* p)              { return __hip_atomic_load(p, __ATOMIC_RELAXED, __HIP_MEMORY_SCOPE_AGENT); }
__device__ __forceinline__ unsigned xb_add(unsigned* p, unsigned v) { return __hip_atomic_fetch_add(p, v, __ATOMIC_RELAXED, __HIP_MEMORY_SCOPE_AGENT); }
__device__ __forceinline__ unsigned xb_xcc_id() { return (unsigned)__builtin_amdgcn_s_getreg((3 << 11) | 20) & 0xFu; }
#define XB_SPIN(cond, bar) do { unsigned _sp = 0; while (cond) { __builtin_amdgcn_s_sleep(1); \
    if ((++_sp & 255u) == 0u) { if (xb_ld(&(bar)[XB_TMO])) break; if (_sp > XB_SPIN_CAP) { atomicAdd(&(bar)[XB_TMO], 1u); break; } } } } while (0)
struct XcdBarrier { unsigned* bar; unsigned x; volatile LAS unsigned* st; };
__device__ __forceinline__ XcdBarrier xcd_barrier_post(unsigned* bar, volatile LAS unsigned* st) {
    XcdBarrier b; b.bar = bar; b.x = xb_xcc_id(); b.st = st;
    if (threadIdx.x == 0) (void)xb_add(&bar[XB_XCNT(b.x)], 1u);
    return b;
}
__device__ __forceinline__ void xcd_barrier_complete(unsigned* bar, unsigned x, unsigned& nloc, unsigned& nx) {
    const unsigned G = gridDim.x * gridDim.y * gridDim.z;
    unsigned sum, cnt, mine, sp = 0u;
    for (;;) {
        sum = 0u; cnt = 0u; mine = 0u;
#pragma unroll
        for (unsigned j = 0; j < 16; ++j) { const unsigned c = xb_ld(&bar[XB_XCNT(j)]); sum += c; cnt += (c > 0u) ? 1u : 0u; mine = (j == x) ? c : mine; }
        if (sum == G) break;
        __builtin_amdgcn_s_sleep(1);
        if ((++sp & 255u) == 0u) { if (xb_ld(&bar[XB_TMO])) break; if (sp > XB_SPIN_CAP) { atomicAdd(&bar[XB_TMO], 1u); break; } }
    }
    nloc = mine > 0u ? mine : 1u; nx = cnt > 0u ? cnt : 1u;
}
__device__ __forceinline__ void xcd_barrier(const XcdBarrier& b) {
    asm volatile("s_waitcnt vmcnt(0)" ::: "memory");
    __syncthreads();
    if (threadIdx.x == 0) {
        unsigned* bar = b.bar;
        __builtin_amdgcn_s_waitcnt(0);
        unsigned nloc = b.st[0], nx = b.st[1];
        if (nloc == 0u) { xcd_barrier_complete(bar, b.x, nloc, nx); b.st[0] = nloc; b.st[1] = nx; }
        const unsigned old = xb_add(&bar[XB_XSUB(b.x)], 1u);
        const unsigned gen = old / nloc;
        if (old + 1u == (gen + 1u) * nloc) {
            __builtin_amdgcn_fence(__ATOMIC_RELEASE, "agent");
            asm volatile("s_waitcnt vmcnt(0)" ::: "memory");
            const unsigned og = xb_add(&bar[XB_TOP], 1u);
            const unsigned tg = og / nx;
            if (og + 1u == (tg + 1u) * nx) xb_add(&bar[XB_TOPGEN], 1u);
            else XB_SPIN(xb_ld(&bar[XB_TOPGEN]) == tg, bar);
            __builtin_amdgcn_fence(__ATOMIC_ACQUIRE, "agent");
            xb_add(&bar[XB_XGEN(b.x)], 1u);
            asm volatile("s_waitcnt vmcnt(0)" ::: "memory");
        } else {
            XB_SPIN(xb_ld(&bar[XB_XGEN(b.x)]) == gen, bar);
            __builtin_amdgcn_fence(__ATOMIC_ACQUIRE, "agent");
            asm volatile("s_waitcnt vmcnt(0)" ::: "memory");
        }
    }
    __syncthreads();
}

enum { MAP_NAT = 0, MAP_GU = 1, MAP_ROUTER = 2 };
template <int Q8 = 0> __device__ __forceinline__ void cvt_item(const GAS float* sp, int ns, const GAS float* gain, GAS bf16_t* dst, int ldd, int k0, int n0, LAS float* scr, int lane, float qs = 1.f) {
    { float vv[32], gg[32];
#pragma unroll
      for (int i = 0; i < 32; ++i) { const int kk = 2 * i + (lane >> 5); vv[i] = sp ? sp[(size_t)(k0 + kk) * ns] : 0.f; gg[i] = gain ? gain[k0 + kk] : 1.f; }
#pragma unroll
      for (int i = 0; i < 32; ++i) { const int kk = 2 * i + (lane >> 5); scr[kk * 33 + (lane & 31)] = vv[i] * gg[i]; } }
    LDS_WAIT(); asm volatile("" ::: "memory");
    const int ch = lane & 7;
#pragma unroll
    for (int j = 0; j < 4; ++j) { const int n = (lane >> 3) + 8 * j; const LAS float* s = scr + (8 * ch) * 33 + n;
        if constexpr (Q8 == 2) { u32x2 o; o.x = pk4_fp8(s[0 * 33] * qs, s[1 * 33] * qs, s[2 * 33] * qs, s[3 * 33] * qs); o.y = pk4_fp8(s[4 * 33] * qs, s[5 * 33] * qs, s[6 * 33] * qs, s[7 * 33] * qs);
            *(GAS u32x2*)((GAS unsigned char*)dst + (size_t)(n0 + n) * ldd + k0 + 8 * ch) = o; }
        else if constexpr (Q8 == 1) { u32x2 o; o.x = pk4_i8(s[0 * 33], s[1 * 33], s[2 * 33], s[3 * 33], qs); o.y = pk4_i8(s[4 * 33], s[5 * 33], s[6 * 33], s[7 * 33], qs);
            *(GAS u32x2*)((GAS unsigned char*)dst + (size_t)(n0 + n) * ldd + k0 + 8 * ch) = o; }
        else { u32x4 o; o.x = cvt_pk_bf16(s[0 * 33], s[1 * 33]); o.y = cvt_pk_bf16(s[2 * 33], s[3 * 33]); o.z = cvt_pk_bf16(s[4 * 33], s[5 * 33]); o.w = cvt_pk_bf16(s[6 * 33], s[7 * 33]);
            *(GAS u32x4*)(dst + (size_t)(n0 + n) * ldd + k0 + 8 * ch) = o; } }
    LDS_WAIT(); asm volatile("" ::: "memory");
}
template <int Q8 = 0> __device__ __forceinline__ void cvt_nat(const GAS float* src, int Nsrc, int coff, int nvalid, const GAS float* gain, GAS bf16_t* dst, int K, int Ndst, int item, LAS float* scr, int lane, float qs = 1.f) {
    const int nblk = Ndst / 32, kb = item / nblk, nb = item % nblk, n0 = 32 * nb, np = n0 + (lane & 31);
    cvt_item<Q8>(np < nvalid ? src + coff + np : nullptr, Nsrc, gain, dst, K, 64 * kb, n0, scr, lane, qs);
}

struct Args { const GAS float* in[25]; GAS float* out; unsigned char* ws; int ph_lo, ph_hi; };
constexpr int NPH_LAYER = 15, NPHASES = 1 + 2 * NPH_LAYER;

__global__ void __launch_bounds__(512, 2) fwd(Args args) {
    extern __shared__ __attribute__((aligned(16))) unsigned char lds[];
    LAS unsigned char* L = (LAS unsigned char*)lds;
    volatile LAS unsigned* MISC = (volatile LAS unsigned*)(L + MISC_OFF);
    LAS int* pend = (LAS int*)(L + MISC_OFF + 64);
    LAS int* pcnt = (LAS int*)(L + MISC_OFF + 256);
    const int tid = threadIdx.x, lane = tid & 63, wave = __builtin_amdgcn_readfirstlane(tid >> 6);
    const int G = gridDim.x, bx = blockIdx.x;
    const int vcu = (G % 8 == 0) ? (bx % 8) * (G / 8) + bx / 8 : bx;
    const int gw = vcu * 8 + wave, NGW = G * 8;
    typedef __attribute__((address_space(4))) const unsigned long long* karg_t;
    const karg_t ka0 = (karg_t)__builtin_amdgcn_kernarg_segment_ptr();
    unsigned char* ws = (unsigned char*)ka0[26];
    unsigned* ctl = (unsigned*)(ws + WS_CTL);
    for (int u = tid; u < 256; u += 512) ((LAS unsigned*)(L + MISC_OFF))[u] = 0u;
    __syncthreads();
#if ONE_LAUNCH
    XcdBarrier bar = xcd_barrier_post(ctl + CW_BAR, MISC);
#define GRID_BAR() xcd_barrier(bar)
#else
#define GRID_BAR() do {} while (0)
#endif
    const int lo = args.ph_lo, hi = args.ph_hi;
#ifndef PHONLY
#define PHONLY -1
#endif
#define PHSEL(k) (PHONLY < 0 || (((k) == 0 ? 0 : (((k) - 1) % 15) + 1)) == PHONLY)
#define IN(k) (PHSEL(k) && lo <= (k) && (k) < hi)
#define SEAM(k) do { if (IN(k) && IN((k) + 1)) GRID_BAR(); } while (0)
#define PH_BEGIN int tid = threadIdx.x; asm volatile("" : "+v"(tid)); const int lane = tid & 63; (void)lane; karg_t ka = ka0; asm volatile("" : "+s"(ka)); unsigned char* lw = (unsigned char*)ka[26]; GAS float* out = (GAS float*)ka[25]; (void)lw; (void)out;
#define INP(k) ((const GAS float*)ka[k])
#define SSQX ((GAS float*)(lw + WS_SSQX))
#define SSQP ((GAS float*)(lw + WS_SSQP))
#define WMAXP ((GAS float*)(lw + WS_SSQP))
#define WABSV ((GAS float*)(lw + 7 * MiB))
#define XSC ((GAS float*)(lw + WS_RSMID))
#define ROPE ((GAS float*)(lw + WS_ROPE))
#define ASE ((GAS int*)(lw + WS_ASE))
#define ASP ((GAS int*)(lw + WS_ASP))
#define ASW ((GAS float*)(lw + WS_ASW))
#define MY ((GAS int*)(lw + WS_MY))
#define MW ((GAS float*)(lw + WS_MW))
#define MRS ((GAS float*)(lw + WS_MRS))
#define LOGITS ((GAS float*)(lw + WS_LOGITS))
#define PCQ ((GAS float*)(lw + WS_LOGITS))
#define PCKV ((GAS float*)(lw + WS_LOGITS + MiB))
#define PKPE ((GAS float*)(lw + WS_LOGITS + 2 * MiB))
#define XB ((GAS bf16_t*)(lw + WS_XB))
#define XB8 ((GAS unsigned char*)(lw + WS_XB8))
#define PROJ1 ((GAS bf16_t*)(lw + WS_PROJ1))
#define QB ((GAS bf16_t*)(lw + WS_QB))
#define KVB ((GAS bf16_t*)(lw + WS_KVB))
#define KB ((GAS bf16_t*)(lw + WS_KB))
#define OB ((GAS bf16_t*)(lw + WS_O))
#define GATES ((GAS bf16_t*)(lw + WS_GATES))
#define MB ((GAS bf16_t*)(lw + WS_M))
#define XM8 ((GAS unsigned char*)(lw + WS_XR))
#define TAB ((GAS int*)(lw + WS_XR + 64 * MiB))
#define ACT ((GAS bf16_t*)(lw + WS_ACT))
#define YBUF ((GAS bf16_t*)(lw + WS_YBUF))

    if (IN(0)) {
        PH_BEGIN
        {
          float mx_in0 = 0.f, mx_in1 = 0.f;
          { const int l = gw >> 10, k = gw & 1023;
            for (int rr = gw; rr < 2048; rr += NGW) { const int l2 = rr >> 10, k2 = rr & 1023; const GAS float* row = INP(2) + ((size_t)l2 * 1024 + k2) * IN_COLS; float mx = 0.f;
                for (int c = lane * 4; c < IN_COLS; c += 256) { const f32x4 q = *(const GAS f32x4*)(row + c); mx = __builtin_fmaxf(mx, __builtin_fmaxf(__builtin_fmaxf(__builtin_fabsf(q.x), __builtin_fabsf(q.y)), __builtin_fmaxf(__builtin_fabsf(q.z), __builtin_fabsf(q.w)))); }
                mx = wave_max(mx) * __builtin_fabsf(INP(1)[l2 * 1024 + k2]);
                if (l2 == 0) mx_in0 = __builtin_fmaxf(mx_in0, mx); else mx_in1 = __builtin_fmaxf(mx_in1, mx); }
            (void)l; (void)k; }
          for (int l2 = 0; l2 < 2; ++l2) { float mxw = 0.f;
            for (int r0 = gw * 4; r0 < 2 * NEXP * 1024; r0 += NGW * 4) { f32x4 q[4];
#pragma unroll
                for (int r = 0; r < 4; ++r) { const int rr = r0 + r, which = rr >> 15, ek = rr & 32767; q[r] = ((const GAS f32x4*)((which ? INP(23) : INP(22)) + ((size_t)l2 * NEXP * 1024 + ek) * 256) + lane)[0]; }
#pragma unroll
                for (int r = 0; r < 4; ++r) { const int k2 = (r0 + r) & 1023; const float g = __builtin_fabsf(INP(17)[l2 * 1024 + k2]);
                    mxw = __builtin_fmaxf(mxw, g * __builtin_fmaxf(__builtin_fmaxf(__builtin_fabsf(q[r].x), __builtin_fabsf(q[r].y)), __builtin_fmaxf(__builtin_fabsf(q[r].z), __builtin_fabsf(q[r].w)))); } }
            mxw = wave_max(mxw);
            if (lane == 0) WMAXP[(l2 * 2 + 1) * 2048 + gw] = mxw; }
          if (lane == 0) { WMAXP[0 * 2048 + gw] = mx_in0; WMAXP[2 * 2048 + gw] = mx_in1; } }
        { const GAS float* x_in = INP(0);
        for (int m0 = gw * 8; m0 < T; m0 += NGW * 8) {
            f32x4 v[8][4];
#pragma unroll
            for (int r = 0; r < 8; ++r)
#pragma unroll
                for (int j = 0; j < 4; ++j) v[r][j] = ((const GAS f32x4*)(x_in + (size_t)(m0 + r) * DM) + lane)[64 * j];
#pragma unroll
            for (int r = 0; r < 8; ++r) { float s = 0.f, mx = 0.f;
#pragma unroll
                for (int j = 0; j < 4; ++j) { const f32x4 q = v[r][j]; s += (q.x * q.x + q.y * q.y) + (q.z * q.z + q.w * q.w);
                    mx = __builtin_fmaxf(mx, __builtin_fmaxf(__builtin_fmaxf(__builtin_fabsf(q.x), __builtin_fabsf(q.y)), __builtin_fmaxf(__builtin_fabsf(q.z), __builtin_fabsf(q.w))));
                    }
                s = wave_sum(s); mx = wave_max(mx); mx = mx > 0.f ? mx : 1.f; const float qs = 127.0f / mx;
#pragma unroll
                for (int j = 0; j < 4; ++j) { const f32x4 q = v[r][j]; ((GAS unsigned*)(XB8 + (size_t)(m0 + r) * DM) + lane)[64 * j] = pk4_i8(q.x, q.y, q.z, q.w, qs); }
                if (lane == 0) { SSQX[m0 + r] = s; XSC[m0 + r] = mx * (1.0f / 127.0f); } }
        } }
        for (int e = bx * 512 + tid; e < SEQ * 16; e += G * 512) { const int pos = e >> 4, i = e & 15;
            const int i4 = i & 3; const double m4 = (i4 == 0) ? 1.0 : (i4 == 1) ? 0.5623413251903491 : (i4 == 2) ? 0.31622776601683794 : 0.1778279410038923;
            const int i16 = i >> 2; const double d4 = (i16 == 0) ? 1.0 : (i16 == 1) ? 0.1 : (i16 == 2) ? 0.01 : 0.001;
            const float ang = (float)pos * (float)(m4 * d4);
            double rev = (double)ang * 0.15915494309189535; rev -= __builtin_rint(rev); const float fr_ = (float)rev;
            ROPE[pos * 32 + i] = __builtin_amdgcn_cosf(fr_); ROPE[pos * 32 + 16 + i] = __builtin_amdgcn_sinf(fr_); }
            GRID_BAR();
        float wabs[4];
#pragma unroll
        for (int q = 0; q < 4; ++q) { float m = 0.f; for (int i = lane; i < NGW; i += 64) m = __builtin_fmaxf(m, WMAXP[q * 2048 + i]); m = wave_max(m); wabs[q] = m > 0.f ? m : 1.f; }
        if (bx == 0 && tid == 0) { WABSV[0] = wabs[0]; WABSV[1] = wabs[1]; WABSV[2] = wabs[2]; WABSV[3] = wabs[3]; }
#define WDQ(l_, t_) (WABSV[2 * (l_) + (t_)] * (1.0f / 127.0f))
#define WQS(l_, t_) (127.0f / wabs[2 * (l_) + (t_)])
        const float qs_in0 = WQS(0, 0), qs_in1 = WQS(1, 0), qs_gu0 = WQS(0, 1), qs_gu1 = WQS(1, 1);
        LAS float* scr = (LAS float*)(L + wave * 16384);
        constexpr int I_WIN1 = 16 * 40, I_WG = 16 * 64, I_WQB = 4 * 24, I_WKVB = 2 * 32, I_WOA = 8 * 32, I_WO = 16 * 32, I_WR = 16 * 8, I_WGU = 32 * 16 * 16, I_WD = 32 * 4 * 32;
        constexpr int NIT = I_WIN1 + I_WG + I_WQB + I_WKVB + 2 * I_WOA + I_WO + I_WR + I_WGU + I_WD;
        for (int it = gw; it < 2 * NIT; it += NGW) {
            const int l = it >= NIT ? 1 : 0; int r = it - l * NIT;
            if (r < I_WIN1) {
                const int kb = r / 40, nb = r % 40, n0 = 32 * nb, np = n0 + (lane & 31);
                int sc_ = np; if (np < 768) { const int pn = np >> 8, q = np & 255; sc_ = 64 * (4 * pn + ((q >> 5) & 3)) + 32 * (q >> 7) + (q & 31); }
                cvt_item<1>(np < C_GATE ? INP(2) + (size_t)l * 1024 * IN_COLS + sc_ : nullptr, IN_COLS, INP(1) + l * 1024, (GAS bf16_t*)(lw + WS_WIN1 + (size_t)l * 1280 * 1024), 1024, 64 * kb, n0, scr, lane, (l ? qs_in1 : qs_in0)); continue; } r -= I_WIN1;
            if (r < I_WG) {
                const int kb = r / 64, nb = r % 64, n0 = 32 * nb, np = n0 + (lane & 31);
                const int q = np >> 8, p = np & 255, cc = 128 * q + (p & 127) + ((p >> 7) ? 1024 : 0);
                cvt_item<1>(INP(2) + (size_t)l * 1024 * IN_COLS + C_GATE + cc, IN_COLS, INP(1) + l * 1024, (GAS bf16_t*)(lw + WS_WG + (size_t)l * 2048 * 1024), 1024, 64 * kb, n0, scr, lane, (l ? qs_in1 : qs_in0)); continue; } r -= I_WG;
            if (r < I_WQB) { const int kb = r / 24, nb = r % 24, n0 = 32 * nb;
                cvt_item(INP(10) + (size_t)l * 256 * 768 + pg8::col16_src(n0 + (lane & 31)), 768, INP(9) + l * 256, (GAS bf16_t*)(lw + WS_WQB) + (size_t)l * 768 * 256, 256, 64 * kb, n0, scr, lane); continue; } r -= I_WQB;
            if (r < I_WKVB) {
                const int kb = r / 32, nb = r % 32, n0 = 32 * nb, np = n0 + (lane & 31);
                const int pn = np >> 8, q = np & 255, wc_ = (q >> 5) & 3; const int sc_ = 128 * (2 * pn + (wc_ & 1)) + 64 * (wc_ >> 1) + 32 * (q >> 7) + (q & 31);
                cvt_item(INP(12) + (size_t)l * 128 * 1024 + sc_, 1024, INP(11) + l * 128, (GAS bf16_t*)(lw + WS_WKVB) + (size_t)l * 1024 * 128, 128, 64 * kb, n0, scr, lane); continue; } r -= I_WKVB;
            if (r < 2 * I_WOA) {
                const int half = r >= I_WOA, r2 = r - half * I_WOA, kb = r2 / 32, nb = r2 % 32, n0 = 32 * nb;
                cvt_item<2>((half ? INP(15) : INP(8)) + (size_t)l * 512 * 1024 + pg8::col16_src(n0 + (lane & 31)), 1024, nullptr, (GAS bf16_t*)(lw + WS_WOA + (size_t)l * 1024 * 1024 + half * 512), 1024, 64 * kb, n0, scr, lane, W8S); continue; } r -= 2 * I_WOA;
            if (r < I_WO) { const int kb = r / 32, nb = r % 32, n0 = 32 * nb;
                cvt_item<2>(INP(16) + (size_t)l * 1024 * 1024 + pg8::col16_src(n0 + (lane & 31)), 1024, nullptr, (GAS bf16_t*)(lw + WS_WO + (size_t)l * 1024 * 1024), 1024, 64 * kb, n0, scr, lane, W8S); continue; } r -= I_WO;
            if (r < I_WR) {
                const int kb = r / 8, nb = r % 8, n0 = 32 * nb, np = n0 + (lane & 31);
                const GAS float* sp = nullptr; int ns = 32;
                if (np < 32) { sp = INP(20) + (size_t)l * 1024 * 32 + np; ns = 32; } else if (np < 36) { sp = INP(18) + (size_t)l * 1024 * 4 + (np - 32); ns = 4; }
                cvt_item(sp, ns, INP(17) + l * 1024, (GAS bf16_t*)(lw + WS_WR) + (size_t)l * 256 * 1024, 1024, 64 * kb, n0, scr, lane); continue; } r -= I_WR;
            if (r < I_WGU) {
                const int e = r / 256, r2 = r % 256, kb = r2 / 16, nb = r2 % 16, n0 = 32 * nb, np = n0 + (lane & 31);
                const int pn = np >> 8, q = np & 255, n = q >> 7;
                const int cc = 128 * pn + (q & 127);
                const GAS float* sp = (n ? INP(23) : INP(22)) + ((size_t)l * NEXP + e) * 1024 * 256 + cc;
                cvt_item<1>(sp, 256, INP(17) + l * 1024, (GAS bf16_t*)(lw + WS_WGU + ((size_t)l * NEXP + e) * 512 * 1024), 1024, 64 * kb, n0, scr, lane, (l ? qs_gu1 : qs_gu0)); continue; } r -= I_WGU;
            { const int e = r / 128, it2 = r % 128, kb = it2 / 32, nb = it2 % 32, n0 = 32 * nb;
              cvt_item(INP(24) + ((size_t)l * NEXP + e) * 256 * 1024 + pg8::col16_src(n0 + (lane & 31)), 1024, nullptr, (GAS bf16_t*)(lw + WS_WD) + ((size_t)l * NEXP + e) * 1024 * 256, 256, 64 * kb, n0, scr, lane); }
        }
    }
    SEAM(0);

    for (int l = 0; l < 2; ++l) {
        const int pb = 1 + NPH_LAYER * l;
        if (IN(pb + 0)) { PH_BEGIN
            pg8::Gemm g{(const GAS bf16_t*)XB8, (const GAS bf16_t*)(lw + WS_WIN1 + (size_t)l * 1280 * 1024), 512, 512, 512}; pg8::StaticOrder S; S.init(T, NPROJ1, G, bx);
            pg8::EpiProj1 E{PROJ1, SSQX, XSC, WDQ(l, 0), INP(4) + l * 64, INP(5) + l * 64, PCQ, PCKV, PKPE};
            pg8::gemm_phase<pg8::EpiProj1, pg8::StaticOrder, true>(L, g, S, E);
        }
        SEAM(pb + 0);
        if (IN(pb + 2)) { PH_BEGIN
            { pg8::Gemm g{PROJ1 + C_CQ, (const GAS bf16_t*)(lw + WS_WQB) + (size_t)l * 768 * 256, NPROJ1, 256, 256}; pg8::StaticOrder S; S.init(T, 768, G, bx);
              pg8::EpiRowNorm4 E{(GAS unsigned char*)QB, 768, PCQ, 1.0f / 256.0f};
              pg8::gemm_phase<pg8::EpiRowNorm4, pg8::StaticOrder>(L, g, S, E); }
            { pg8::Gemm g{PROJ1 + C_CKV, (const GAS bf16_t*)(lw + WS_WKVB) + (size_t)l * 1024 * 128, NPROJ1, 128, 128}; pg8::StaticOrder S; S.init(T, 1024, G, bx);
              pg8::EpiKv E{KB, KVB, PCKV, PKPE, PROJ1, INP(14) + l * 96, ROPE};
              pg8::gemm_phase<pg8::EpiKv, pg8::StaticOrder>(L, g, S, E); }
        }
        SEAM(pb + 2);
        if (IN(pb + 4)) { PH_BEGIN
            char* shm = (char*)lds;
            float mfixB, sboundA;
            { const GAS float* gq = INP(13) + l * 96; const GAS float* gk = INP(14) + l * 96; float a = 0.f, c = 0.f;
              for (int i = lane; i < 96; i += 64) { a = __builtin_fmaxf(a, __builtin_fabsf(gq[i])); c = __builtin_fmaxf(c, __builtin_fabsf(gk[i])); }
              a = wave_max(a); c = wave_max(c); mfixB = __uint_as_float(__builtin_amdgcn_readfirstlane(__float_as_uint(__builtin_fminf(96.0f * C2B * a * c + 0.5f, 60.0f)))); }
            { const GAS float* gq = INP(4) + l * 64; const GAS float* gk = INP(5) + l * 64; const GAS float* rel = INP(7);
              float a = __builtin_fabsf(gq[lane]), c = __builtin_fabsf(gk[lane]), bm = 0.f;
              for (int i = lane; i < 256; i += 64) bm = __builtin_fmaxf(bm, __builtin_fabsf(rel[i]));
              a = wave_max(a); c = wave_max(c); bm = wave_max(bm); sboundA = __uint_as_float(__builtin_amdgcn_readfirstlane(__float_as_uint(__builtin_fminf(64.0f * C2A * a * c + bm * LOG2E + 0.5f, 60.0f)))); }
            for (int v = vcu; v < 256; v += G) {
                const int bh = v >> 1, s0 = 2 * (v & 1);
                for (int i = 0; i < 4; ++i) { const int s = s0 + (i >> 1), qb = (i & 1) ? 7 - s : s; att::mla_unit(bh >> 3, bh & 7, qb, QB, KB, KVB, OB, shm, mfixB, INP(13) + l * 96, ROPE); }
            }
            { LAS float* biasl = (LAS float*)(L + att::S_LBIAS); const GAS float* rel = INP(7);
              for (int e = tid; e < 8 * 128; e += 512) { const int hd = e >> 7, d = e & 127; int bk = d;
                  if (d >= 16) { bk = 16 + (int)(__logf((float)d * (1.0f / 16.0f)) / 2.0794415416798357f * 16.0f); bk = bk > 31 ? 31 : bk; }
                  biasl[e] = rel[bk * 8 + hd] * LOG2E; }
              __syncthreads(); }
            for (int u = vcu; u < NB * 32 * 2; u += G) { const int g2 = u & 1, n = (u >> 1) & 31, b = u >> 6; att::swa_unit(b, n, g2, PROJ1, OB, INP(6) + l * 8, shm, sboundA); }
        }
        SEAM(pb + 4);
        if (IN(pb + 5)) { PH_BEGIN
            pg8::Gemm g{(const GAS bf16_t*)XB8, (const GAS bf16_t*)(lw + WS_WG + (size_t)l * 2048 * 1024), 512, 512, 512}; pg8::StaticOrder S; S.init(T, 2048, G, bx);
            pg8::EpiGates2 E{(GAS unsigned char*)GATES, SSQX, INP(3) + l * 2048, XSC, WDQ(l, 0)};
            pg8::gemm_phase<pg8::EpiGates2, pg8::StaticOrder, true>(L, g, S, E);
        }
        SEAM(pb + 5);
        if (IN(pb + 6)) { PH_BEGIN
            pg8::Gemm g{OB, (const GAS bf16_t*)(lw + WS_WOA + (size_t)l * 1024 * 1024), 512, 512, 512}; pg8::StaticOrder S; S.init(T, 1024, G, bx);
            pg8::EpiMerge E{MB, (const GAS unsigned char*)GATES};
            pg8::gemm_phase<pg8::EpiMerge, pg8::StaticOrder, false, true, true>(L, g, S, E);
        }
        SEAM(pb + 6);
        if (IN(pb + 7)) { PH_BEGIN
            pg8::Gemm g{MB, (const GAS bf16_t*)(lw + WS_WO + (size_t)l * 1024 * 1024), 512, 512, 512}; pg8::StaticOrder S; S.init(T, 1024, G, bx);
            pg8::EpiResid E{(l == 0) ? INP(0) : (const GAS float*)nullptr, XB, SSQP};
            pg8::gemm_phase<pg8::EpiResid, pg8::StaticOrder, false, false, true>(L, g, S, E);
        }
        SEAM(pb + 7);
        if (IN(pb + 9)) { PH_BEGIN
            pg8::Gemm g{XB, (const GAS bf16_t*)(lw + WS_WR) + (size_t)l * 256 * 1024, 1024, 1024, 1024}; pg8::StaticOrder S; S.init(T, 256, G, bx);
            pg8::EpiLogits E{LOGITS, SSQP};
            pg8::gemm_phase<pg8::EpiLogits, pg8::StaticOrder>(L, g, S, E);
            VM_WAIT(); __syncthreads();
            LAS int* cnt = (LAS int*)L; LAS int* basep = cnt + 32;
            const GAS float* brg = INP(19) + l * 4; const GAS float* bre = INP(21) + l * 32;
            GAS unsigned* gcnt = (GAS unsigned*)(lw + WS_CTL) + CW_CNT + 64 * l;
            pg8::Unit ru;
            LAS float* rsc = (LAS float*)(L + 4096);
            for (int iu = 0; S.next(iu, ru); ++iu) {
                if (tid < 32) cnt[tid] = 0;
                {
                    const int wv = tid >> 6;
                    for (int rr = 0; rr < 32; rr += 4) { u32x4 v0[4], v1[4]; float rsm[4];
#pragma unroll
                        for (int r = 0; r < 4; ++r) { const int t = ru.pm * 256 + wv * 32 + rr + r; const GAS u32x4* s = (const GAS u32x4*)(XB + (size_t)t * DM) + lane; v0[r] = s[0]; v1[r] = s[64];
                            const GAS f32x4* pp = (const GAS f32x4*)(SSQP + (size_t)t * 16); const f32x4 a = pp[0], b = pp[1], c = pp[2], d = pp[3];
                            rsm[r] = __builtin_amdgcn_rsqf((((a.x + a.y) + (a.z + a.w)) + ((b.x + b.y) + (b.z + b.w)) + ((c.x + c.y) + (c.z + c.w)) + ((d.x + d.y) + (d.z + d.w))) * (1.0f / 1024.0f) + EPS); }
#pragma unroll
                        for (int r = 0; r < 4; ++r) { const int t = ru.pm * 256 + wv * 32 + rr + r; const u32x4 a = v0[r], b = v1[r];
                            const float f[16] = {bflo(a.x), bfhi(a.x), bflo(a.y), bfhi(a.y), bflo(a.z), bfhi(a.z), bflo(a.w), bfhi(a.w), bflo(b.x), bfhi(b.x), bflo(b.y), bfhi(b.y), bflo(b.z), bfhi(b.z), bflo(b.w), bfhi(b.w)};
                            float mx = 0.f;
#pragma unroll
                            for (int i = 0; i < 16; ++i) mx = __builtin_fmaxf(mx, __builtin_fabsf(f[i]));
                            mx = wave_max(mx); mx = mx > 0.f ? mx : 1.f; const float qs = 127.0f / mx;
                            u32x2 q0, q1; q0.x = pk4_i8(f[0], f[1], f[2], f[3], qs); q0.y = pk4_i8(f[4], f[5], f[6], f[7], qs); q1.x = pk4_i8(f[8], f[9], f[10], f[11], qs); q1.y = pk4_i8(f[12], f[13], f[14], f[15], qs);
                            { GAS u32x2* d = (GAS u32x2*)(XM8 + (size_t)t * DM) + lane; d[0] = q0; d[64] = q1; }
                            if (lane == 0) rsc[wv * 32 + rr + r] = rsm[r] * mx * (1.0f / 127.0f); } }
                }
                __syncthreads();
                const bool act = tid < 256; const int t = ru.pm * 256 + (tid & 255); const GAS float* lg = LOGITS + (size_t)t * 64;
                float gl[4]; float gmx = -INFINITY; int gi = 0;
#pragma unroll
                for (int q = 0; q < 4; ++q) { gl[q] = lg[32 + q] + brg[q]; if (gl[q] > gmx) { gmx = gl[q]; gi = q; } }
                float gs = 0.f;
#pragma unroll
                for (int q = 0; q < 4; ++q) gs += __expf(gl[q] - gmx);
                const float gp = 1.0f / gs;
                float el[8]; float e0 = -INFINITY; int i0 = 0;
#pragma unroll
                for (int q = 0; q < 8; ++q) { el[q] = lg[8 * gi + q] + bre[8 * gi + q]; if (el[q] > e0) { e0 = el[q]; i0 = q; } }
                float e1 = -INFINITY; int i1 = 0;
#pragma unroll
                for (int q = 0; q < 8; ++q) if (q != i0 && el[q] > e1) { e1 = el[q]; i1 = q; }
                const float w1 = 1.0f / (1.0f + __expf(e0 - e1)), w0 = 1.0f - w1;
                const int ex0 = 8 * gi + i0, ex1 = 8 * gi + i1;
                int r0 = 0, r1 = 0;
                if (act) { r0 = __hip_atomic_fetch_add(&cnt[ex0], 1, __ATOMIC_RELAXED, __HIP_MEMORY_SCOPE_WORKGROUP); r1 = __hip_atomic_fetch_add(&cnt[ex1], 1, __ATOMIC_RELAXED, __HIP_MEMORY_SCOPE_WORKGROUP); }
                __syncthreads();
                if (tid < 32) basep[tid] = (int)__hip_atomic_fetch_add(gcnt + tid, (unsigned)cnt[tid], __ATOMIC_RELAXED, __HIP_MEMORY_SCOPE_AGENT);
                __syncthreads();
                if (act) { const unsigned sb = __float_as_uint(rsc[tid]);
                    *(GAS u32x4*)(TAB + (size_t)(ex0 * MOE_CAP + basep[ex0] + r0) * 4) = (u32x4){(unsigned)t, sb, (unsigned)(2 * t), __float_as_uint(gp * w0)};
                    *(GAS u32x4*)(TAB + (size_t)(ex1 * MOE_CAP + basep[ex1] + r1) * 4) = (u32x4){(unsigned)t, sb, (unsigned)(2 * t + 1), __float_as_uint(gp * w1)}; }
                __syncthreads();
            }
        }
        SEAM(pb + 10);
        if (IN(pb + 12) || IN(pb + 13)) {
            PH_BEGIN
            if (tid == 0) { const GAS unsigned* gcnt = (const GAS unsigned*)(lw + WS_CTL) + CW_CNT + 64 * l; int acc = 0;
                for (int e = 0; e < NEXP; ++e) { const int c = (int)__hip_atomic_load(gcnt + e, __ATOMIC_RELAXED, __HIP_MEMORY_SCOPE_AGENT); acc += (c + 255) >> 8; pend[e] = acc; pcnt[e] = c; } }
            __syncthreads();
        }
        if (IN(pb + 12)) { PH_BEGIN
            pg8::Gemm g{(const GAS bf16_t*)XM8, (const GAS bf16_t*)(lw + WS_WGU + (size_t)l * NEXP * 512 * 1024), 512, 512, 512};
            pg8::MoeGather S{pend[NEXP - 1] * 2, 2, G, bx, pend, (size_t)512 * 1024, TAB, pcnt};
            pg8::EpiGateUp E{ACT, (const GAS float*)TAB, pend, pcnt, WDQ(l, 1)};
            pg8::gemm_phase<pg8::EpiGateUp, pg8::MoeGather, true>(L, g, S, E);
        }
        SEAM(pb + 12);
        if (IN(pb + 13)) { PH_BEGIN
            pg8::Gemm g{ACT, (const GAS bf16_t*)(lw + WS_WD) + (size_t)l * NEXP * 1024 * 256, 256, 256, 256};
            pg8::MoeOrder S{pend[NEXP - 1] * 4, 4, G, bx, pend, (size_t)1024 * 256 * 2, TAB, pcnt};
            pg8::EpiDown E{YBUF, TAB, pend, pcnt};
            pg8::gemm_phase<pg8::EpiDown, pg8::MoeOrder>(L, g, S, E);
        }
        SEAM(pb + 13);
        if (IN(pb + 14)) { PH_BEGIN
            for (int m0 = gw * 4; m0 < T; m0 += NGW * 4) {
                u32x2 xm[4][4]; unsigned ya[4][4], yb[4][4]; f32x4 xv[4][4];
#pragma unroll
                for (int r = 0; r < 4; ++r) { const int m = m0 + r;
#pragma unroll
                    for (int j = 0; j < 4; ++j) { xm[r][j] = ((const GAS u32x2*)(XB + (size_t)m * DM) + lane)[64 * j];
                        ya[r][j] = ((const GAS unsigned*)((const GAS unsigned char*)YBUF + (size_t)(2 * m) * DM) + lane)[64 * j]; yb[r][j] = ((const GAS unsigned*)((const GAS unsigned char*)YBUF + (size_t)(2 * m + 1) * DM) + lane)[64 * j]; } }
#pragma unroll
                for (int r = 0; r < 4; ++r) { const int m = m0 + r; float s = 0.f, mx = 0.f;
#pragma unroll
                    for (int j = 0; j < 4; ++j) { const u32x2 x = xm[r][j]; const int a = (int)ya[r][j], b = (int)yb[r][j]; f32x4 v;
                        v.x = bflo(x.x) + (__builtin_amdgcn_cvt_f32_fp8(a, 0) + __builtin_amdgcn_cvt_f32_fp8(b, 0)) * Y8I; v.y = bfhi(x.x) + (__builtin_amdgcn_cvt_f32_fp8(a, 1) + __builtin_amdgcn_cvt_f32_fp8(b, 1)) * Y8I;
                        v.z = bflo(x.y) + (__builtin_amdgcn_cvt_f32_fp8(a, 2) + __builtin_amdgcn_cvt_f32_fp8(b, 2)) * Y8I; v.w = bfhi(x.y) + (__builtin_amdgcn_cvt_f32_fp8(a, 3) + __builtin_amdgcn_cvt_f32_fp8(b, 3)) * Y8I; xv[r][j] = v;
                        if (l == 1) ((GAS f32x4*)(out + (size_t)m * DM) + lane)[64 * j] = v;
                        else { u32x2 w; w.x = cvt_pk_bf16(v.x, v.y); w.y = cvt_pk_bf16(v.z, v.w); ((GAS u32x2*)(XB + (size_t)m * DM) + lane)[64 * j] = w; }
                        s += (v.x * v.x + v.y * v.y) + (v.z * v.z + v.w * v.w);
                        mx = __builtin_fmaxf(mx, __builtin_fmaxf(__builtin_fmaxf(__builtin_fabsf(v.x), __builtin_fabsf(v.y)), __builtin_fmaxf(__builtin_fabsf(v.z), __builtin_fabsf(v.w)))); }
                    if (l == 0) {
                    s = wave_sum(s); mx = wave_max(mx); mx = mx > 0.f ? mx : 1.f; const float qs = 127.0f / mx;
#pragma unroll
                    for (int j = 0; j < 4; ++j) { const f32x4 v = xv[r][j]; ((GAS unsigned*)(XB8 + (size_t)m * DM) + lane)[64 * j] = pk4_i8(v.x, v.y, v.z, v.w, qs); }
                    if (lane == 0) { SSQX[m] = s; XSC[m] = mx * (1.0f / 127.0f); } } }
            }
        }
        SEAM(pb + 14);
    }
}

extern "C" void kernel_launch(void* const* d_in, const GAS int* in_sizes, int n_in, void* d_out, int out_size, void* d_ws, size_t ws_size, hipStream_t stream) {
    static int grid = 0;
    if (grid == 0) {
        if (n_in != 25 || in_sizes[0] != T * DM || out_size != T * DM || ws_size < WS_END) { fprintf(stderr, "kernel_launch: unexpected shapes / workspace (%d inputs, ws %zu)\n", n_in, ws_size); grid = -1; return; }
        int dev = 0, cus = 0, per_cu = 0;
        if (hipGetDevice(&dev) != hipSuccess || hipDeviceGetAttribute(&cus, hipDeviceAttributeMultiprocessorCount, dev) != hipSuccess) { grid = -1; return; }
        if (hipFuncSetAttribute((const void*)fwd, hipFuncAttributeMaxDynamicSharedMemorySize, LDS_BYTES) != hipSuccess) { fprintf(stderr, "kernel_launch: hipFuncSetAttribute failed\n"); grid = -1; return; }
        if (hipOccupancyMaxActiveBlocksPerMultiprocessor(&per_cu, (const void*)fwd, 512, LDS_BYTES) != hipSuccess || per_cu < 1) fprintf(stderr, "kernel_launch: occupancy query reports %d\n", per_cu);
        (void)hipGetLastError();
        grid = cus;
    }
    if (grid < 0) return;
    if (hipMemsetAsync((char*)d_ws + WS_CTL, 0, CTL_ZERO_BYTES, stream) != hipSuccess) return;
    Args a{};
    for (int i = 0; i < 25; ++i) a.in[i] = (const GAS float*)d_in[i];
    a.out = (GAS float*)d_out; a.ws = (unsigned char*)d_ws;
#if ONE_LAUNCH
    a.ph_lo = 0; a.ph_hi = NPHASES;
    hipLaunchKernelGGL(fwd, dim3(grid), dim3(512), LDS_BYTES, stream, a);
#else
    for (int ph = 0; ph < NPHASES; ++ph) { a.ph_lo = ph; a.ph_hi = ph + 1; hipLaunchKernelGGL(fwd, dim3(grid), dim3(512), LDS_BYTES, stream, a); }
#endif
}
```
